# Optimizing an MI355X kernel written in HIP

```python
import jax
import jax.numpy as jnp
from jax import lax

D_MODEL = 1024
BATCH = 4
SEQ = 8192
DEPTH = 2

GRID_W = 64
CTX_LEN = 256
HEAD_DIM = 64
A_Q_HEADS = 8
A_KV_HEADS = 2
A_GROUP = A_Q_HEADS // A_KV_HEADS
A_WINDOW = 128
A_BLOCK = 128
B_HEADS = 4
NA_ROWS = 8
NA_COLS = 16
C_CHANNELS = 256
C_CONV_WIDTH = 31
A_Q_W = A_Q_HEADS * HEAD_DIM
A_KV_W = A_KV_HEADS * HEAD_DIM
B_W = B_HEADS * HEAD_DIM
MIX_WIDTH = A_Q_W + B_W + C_CHANNELS
IN_WIDTH = A_Q_W + 2 * A_KV_W + 3 * B_W + 2 * C_CHANNELS
OFF_AQ = 0
OFF_AK = OFF_AQ + A_Q_W
OFF_AV = OFF_AK + A_KV_W
OFF_BQ = OFF_AV + A_KV_W
OFF_BK = OFF_BQ + B_W
OFF_BV = OFF_BK + B_W
OFF_C = OFF_BV + B_W
N_EXPERTS = 16
EXPERT_FF = 1024
EC_CAPACITY = 2
ROPE_BASE = 10000.0
LN_EPS = 1e-6
N_MOD = 6
MOD_INIT = 0.5
DEEPNORM_ALPHA = (2 * DEPTH) ** 0.25
DEEPNORM_BETA = (8 * DEPTH) ** -0.25
NEG_INF = -1e30

kernel_name = 'hybrid_diffusion_parallel_heads_ec_moe'


def layer_norm(x, g=None, b=None):
    xf = x.astype(jnp.float32)
    mu = jnp.mean(xf, axis=-1, keepdims=True)
    var = jnp.mean(jnp.square(xf - mu), axis=-1, keepdims=True)
    y = (xf - mu) * lax.rsqrt(var + LN_EPS)
    if g is not None:
        y = y * g.astype(jnp.float32) + b.astype(jnp.float32)
    return y.astype(x.dtype)


def modulate(x, shift, scale):
    return layer_norm(x) * (1 + scale) + shift


def adaln(cond, w_mod_l, b_mod_l, n_chunks):
    m = jax.nn.silu(cond) @ w_mod_l[:, :n_chunks * D_MODEL] + b_mod_l[:n_chunks * D_MODEL]
    return jnp.split(m, n_chunks, axis=-1)


def split_heads(t, n_heads):
    return t.reshape(t.shape[:-1] + (n_heads, HEAD_DIM))


def axial_rope(n_tokens, dtype):
    t = jnp.arange(n_tokens, dtype=jnp.int32)
    row = (t // GRID_W).astype(jnp.float32)[:, None]
    col = (t % GRID_W).astype(jnp.float32)[:, None]
    n_freq = HEAD_DIM // 4
    inv_freq = ROPE_BASE ** (-jnp.arange(n_freq, dtype=jnp.float32) / n_freq)
    ang_r = row * inv_freq
    ang_c = col * inv_freq
    return (jnp.cos(ang_r)[:, None, :].astype(dtype), jnp.sin(ang_r)[:, None, :].astype(dtype),
            jnp.cos(ang_c)[:, None, :].astype(dtype), jnp.sin(ang_c)[:, None, :].astype(dtype))


def rope_half(x, cos, sin):
    x1, x2 = jnp.split(x, 2, axis=-1)
    return jnp.concatenate([x1 * cos - x2 * sin, x2 * cos + x1 * sin], axis=-1)


def apply_axial_rope(x, cos_r, sin_r, cos_c, sin_c):
    xr, xc = jnp.split(x, 2, axis=-1)
    return jnp.concatenate([rope_half(xr, cos_r, sin_r), rope_half(xc, cos_c, sin_c)], axis=-1)


def window_gqa_latent(q, k, v, kc, vc, sink):
    bsz, n_lat = q.shape[:2]
    n_blk = n_lat // A_BLOCK
    span = A_BLOCK + 2 * A_WINDOW
    pad = ((0, 0), (A_WINDOW, A_WINDOW), (0, 0), (0, 0))
    kp = jnp.pad(k, pad)
    vp = jnp.pad(v, pad)
    scale = HEAD_DIM ** -0.5
    sink_l = sink.reshape(1, A_KV_HEADS, A_GROUP, 1, 1).astype(jnp.float32)
    q_off = jnp.arange(A_BLOCK)
    k_off = jnp.arange(span) - A_WINDOW
    band = jnp.abs(k_off[None, :] - q_off[:, None]) <= A_WINDOW

    def block(i):
        start = i * A_BLOCK
        qb = lax.dynamic_slice_in_dim(q, start, A_BLOCK, axis=1)
        kb = lax.dynamic_slice_in_dim(kp, start, span, axis=1)
        vb = lax.dynamic_slice_in_dim(vp, start, span, axis=1)
        kpos = start + k_off
        valid = band & ((kpos >= 0) & (kpos < n_lat))[None, :]
        s_win = jnp.einsum('bqhgd,bkhd->bhgqk', qb, kb).astype(jnp.float32) * scale
        s_win = jnp.where(valid, s_win, NEG_INF)
        s_ctx = jnp.einsum('bqhgd,bkhd->bhgqk', qb, kc).astype(jnp.float32) * scale
        s_sink = jnp.broadcast_to(sink_l, s_win.shape[:-1] + (1,))
        p = jax.nn.softmax(jnp.concatenate([s_win, s_ctx, s_sink], axis=-1), axis=-1).astype(q.dtype)
        return (jnp.einsum('bhgqk,bkhd->bqhgd', p[..., :span], vb)
                + jnp.einsum('bhgqk,bkhd->bqhgd', p[..., span:span + kc.shape[1]], vc))

    out = lax.map(block, jnp.arange(n_blk))
    return jnp.moveaxis(out, 0, 1).reshape(bsz, n_lat, A_Q_W)


def context_gqa(qc, kc, vc, sink):
    s = jnp.einsum('bqhgd,bkhd->bhgqk', qc, kc).astype(jnp.float32) * HEAD_DIM ** -0.5
    s_sink = jnp.broadcast_to(sink.reshape(1, A_KV_HEADS, A_GROUP, 1, 1).astype(jnp.float32), s.shape[:-1] + (1,))
    p = jax.nn.softmax(jnp.concatenate([s, s_sink], axis=-1), axis=-1).astype(qc.dtype)
    o = jnp.einsum('bhgqk,bkhd->bqhgd', p[..., :-1], vc)
    return o.reshape(qc.shape[0], qc.shape[1], A_Q_W)


def neighbourhood_latent(q, k, v, kc, vc, rel_bias):
    bsz, n_lat = q.shape[:2]
    rows = n_lat // GRID_W
    kr_n = min(NA_ROWS, rows)
    n_keys = kr_n * GRID_W
    scale = HEAD_DIM ** -0.5
    qg = q.reshape(bsz, rows, GRID_W, B_HEADS, HEAD_DIM)
    kg = k.reshape(bsz, rows, GRID_W, B_HEADS, HEAD_DIM)
    vg = v.reshape(bsz, rows, GRID_W, B_HEADS, HEAD_DIM)
    cols = jnp.arange(GRID_W)
    c_start = jnp.clip(cols - NA_COLS // 2, 0, GRID_W - NA_COLS)
    col_mask = (cols[None, :] >= c_start[:, None]) & (cols[None, :] < c_start[:, None] + NA_COLS)
    mask = jnp.broadcast_to(col_mask[:, None, :], (GRID_W, kr_n, GRID_W)).reshape(GRID_W, n_keys)
    dc = jnp.clip(cols[None, :] - cols[:, None], -(NA_COLS - 1), NA_COLS - 1) + NA_COLS - 1

    def row(r):
        r_start = jnp.clip(r - kr_n // 2, 0, rows - kr_n)
        qr = lax.dynamic_index_in_dim(qg, r, axis=1, keepdims=False)
        kr = lax.dynamic_slice_in_dim(kg, r_start, kr_n, axis=1).reshape(bsz, n_keys, B_HEADS, HEAD_DIM)
        vr = lax.dynamic_slice_in_dim(vg, r_start, kr_n, axis=1).reshape(bsz, n_keys, B_HEADS, HEAD_DIM)
        dr = r_start + jnp.arange(kr_n) - r + NA_ROWS - 1
        bias = rel_bias[:, dr[None, :, None], dc[:, None, :]].reshape(B_HEADS, GRID_W, n_keys)
        s_nb = jnp.einsum('bqhd,bkhd->bhqk', qr, kr).astype(jnp.float32) * scale + bias.astype(jnp.float32)
        s_nb = jnp.where(mask, s_nb, NEG_INF)
        s_ctx = jnp.einsum('bqhd,bkhd->bhqk', qr, kc).astype(jnp.float32) * scale
        p = jax.nn.softmax(jnp.concatenate([s_nb, s_ctx], axis=-1), axis=-1).astype(q.dtype)
        return (jnp.einsum('bhqk,bkhd->bqhd', p[..., :n_keys], vr)
                + jnp.einsum('bhqk,bkhd->bqhd', p[..., n_keys:], vc))

    out = lax.map(row, jnp.arange(rows))
    return jnp.moveaxis(out, 0, 1).reshape(bsz, n_lat, B_W)


def context_mha(qc, kc, vc):
    s = jnp.einsum('bqhd,bkhd->bhqk', qc, kc).astype(jnp.float32) * HEAD_DIM ** -0.5
    p = jax.nn.softmax(s, axis=-1).astype(qc.dtype)
    o = jnp.einsum('bhqk,bkhd->bqhd', p, vc)
    return o.reshape(qc.shape[0], qc.shape[1], B_W)


def conformer_conv(u, conv_w, conv_b, ln_g, ln_b):
    a, gate = jnp.split(u, 2, axis=-1)
    h = a * jax.nn.sigmoid(gate)
    half = C_CONV_WIDTH // 2
    h = lax.conv_general_dilated(h, conv_w[:, None, :], window_strides=(1,), padding=((half, half),),
                                 dimension_numbers=('NWC', 'WIO', 'NWC'),
                                 feature_group_count=C_CHANNELS) + conv_b
    return jax.nn.silu(layer_norm(h, ln_g, ln_b))


def ec_moe(h, w_router, w_gate, w_up, w_down):
    bsz, n_tok, d = h.shape
    cap = EC_CAPACITY * n_tok // N_EXPERTS
    aff = jax.nn.softmax(jnp.einsum('bnd,de->bne', h, w_router).astype(jnp.float32), axis=-1)
    g, idx = lax.top_k(jnp.swapaxes(aff, 1, 2), cap)
    xs = jax.vmap(lambda hb, ib: hb[ib])(h, idx)
    hid = jax.nn.silu(jnp.einsum('becd,edf->becf', xs, w_gate)) * jnp.einsum('becd,edf->becf', xs, w_up)
    ye = jnp.einsum('becf,efd->becd', hid, w_down) * g[..., None].astype(h.dtype)
    return jax.vmap(lambda yb, ib: jnp.zeros((n_tok, d), h.dtype).at[ib.reshape(-1)].add(yb.reshape(-1, d)))(ye, idx)


def context_kv(hc, w_in_l):
    ka, va = jnp.split(hc @ w_in_l[:, OFF_AK:OFF_BQ], 2, axis=-1)
    kb, vb = jnp.split(hc @ w_in_l[:, OFF_BK:OFF_C], 2, axis=-1)
    return (split_heads(ka, A_KV_HEADS), split_heads(va, A_KV_HEADS),
            split_heads(kb, B_HEADS), split_heads(vb, B_HEADS))


def setup_inputs(seed: int = 0) -> dict:
    key = jax.random.key(seed)
    ks = jax.random.split(key, 22)
    L, D = DEPTH, D_MODEL

    def nrm(k, shape, s):
        return s * jax.random.normal(k, shape, jnp.float32)

    return {
        'x': nrm(ks[0], (BATCH, SEQ, D), 1.0),
        'c': nrm(ks[1], (BATCH, D), 1.0),
        'ctx': nrm(ks[2], (BATCH, CTX_LEN, D), 1.0),
        'c_ctx': nrm(ks[3], (D,), 1.0),
        'w_mod': nrm(ks[4], (L, D, N_MOD * D), MOD_INIT * D ** -0.5),
        'b_mod': nrm(ks[5], (L, N_MOD * D), 0.02),
        'w_in': nrm(ks[6], (L, D, IN_WIDTH), D ** -0.5),
        'a_sink': nrm(ks[7], (L, A_Q_HEADS), 0.5),
        'nat_bias': nrm(ks[8], (L, B_HEADS, 2 * NA_ROWS - 1, 2 * NA_COLS - 1), 0.1),
        'conv_w': nrm(ks[9], (L, C_CONV_WIDTH, C_CHANNELS), C_CONV_WIDTH ** -0.5),
        'conv_b': nrm(ks[10], (L, C_CHANNELS), 0.02),
        'conv_ln_g': 1.0 + nrm(ks[11], (L, C_CHANNELS), 0.05),
        'conv_ln_b': nrm(ks[12], (L, C_CHANNELS), 0.02),
        'w_out': nrm(ks[13], (L, MIX_WIDTH, D), DEEPNORM_BETA * MIX_WIDTH ** -0.5),
        'ln1_g': 1.0 + nrm(ks[14], (L, D), 0.05),
        'ln1_b': nrm(ks[15], (L, D), 0.02),
        'w_router': nrm(ks[16], (L, D, N_EXPERTS), D ** -0.5),
        'w_gate': nrm(ks[17], (L, N_EXPERTS, D, EXPERT_FF), D ** -0.5),
        'w_up': nrm(ks[18], (L, N_EXPERTS, D, EXPERT_FF), D ** -0.5),
        'w_down': nrm(ks[19], (L, N_EXPERTS, EXPERT_FF, D), DEEPNORM_BETA * EXPERT_FF ** -0.5),
        'ln2_g': 1.0 + nrm(ks[20], (L, D), 0.05),
        'ln2_b': nrm(ks[21], (L, D), 0.02),
    }


def reference(x, c, ctx, c_ctx, w_mod, b_mod, w_in, a_sink, nat_bias, conv_w, conv_b, conv_ln_g, conv_ln_b,
              w_out, ln1_g, ln1_b, w_router, w_gate, w_up, w_down, ln2_g, ln2_b):
    bsz, n_lat, _ = x.shape
    n_ctx = ctx.shape[1]
    rope = axial_rope(n_lat, x.dtype)
    for l in range(DEPTH):
        last = l == DEPTH - 1
        w_in_l = w_in[l]
        sh1, sc1, g1, sh2, sc2, g2 = [m[:, None, :] for m in adaln(c, w_mod[l], b_mod[l], N_MOD)]

        ctx_mod = adaln(c_ctx, w_mod[l], b_mod[l], 2 if last else N_MOD)
        hc = modulate(ctx, ctx_mod[0], ctx_mod[1])
        kc_a, vc_a, kc_b, vc_b = context_kv(hc, w_in_l)
        if not last:
            qc_a = split_heads(hc @ w_in_l[:, OFF_AQ:OFF_AK], A_Q_HEADS).reshape(bsz, n_ctx, A_KV_HEADS, A_GROUP, HEAD_DIM)
            qc_b = split_heads(hc @ w_in_l[:, OFF_BQ:OFF_BK], B_HEADS)
            oc = jnp.concatenate([
                context_gqa(qc_a, kc_a, vc_a, a_sink[l]),
                context_mha(qc_b, kc_b, vc_b),
                conformer_conv(hc @ w_in_l[:, OFF_C:], conv_w[l], conv_b[l], conv_ln_g[l], conv_ln_b[l]),
            ], axis=-1) @ w_out[l]
            ctx_new = layer_norm(DEEPNORM_ALPHA * ctx + ctx_mod[2] * oc, ln1_g[l], ln1_b[l])
            hc2 = modulate(ctx_new, ctx_mod[3], ctx_mod[4])
            ctx_new = layer_norm(DEEPNORM_ALPHA * ctx_new + ctx_mod[5] * ec_moe(hc2, w_router[l], w_gate[l], w_up[l], w_down[l]),
                                 ln2_g[l], ln2_b[l])

        h = modulate(x, sh1, sc1)
        u = h @ w_in_l
        q_a = apply_axial_rope(split_heads(u[..., OFF_AQ:OFF_AK], A_Q_HEADS), *rope)
        k_a = apply_axial_rope(split_heads(u[..., OFF_AK:OFF_AV], A_KV_HEADS), *rope)
        v_a = split_heads(u[..., OFF_AV:OFF_BQ], A_KV_HEADS)
        q_b = split_heads(u[..., OFF_BQ:OFF_BK], B_HEADS)
        k_b = split_heads(u[..., OFF_BK:OFF_BV], B_HEADS)
        v_b = split_heads(u[..., OFF_BV:OFF_C], B_HEADS)
        o_a = window_gqa_latent(q_a.reshape(bsz, n_lat, A_KV_HEADS, A_GROUP, HEAD_DIM), k_a, v_a, kc_a, vc_a, a_sink[l])
        o_b = neighbourhood_latent(q_b, k_b, v_b, kc_b, vc_b, nat_bias[l])
        o_c = conformer_conv(u[..., OFF_C:], conv_w[l], conv_b[l], conv_ln_g[l], conv_ln_b[l])
        o = jnp.concatenate([o_a, o_b, o_c], axis=-1) @ w_out[l]
        x = layer_norm(DEEPNORM_ALPHA * x + g1 * o, ln1_g[l], ln1_b[l])
        h2 = modulate(x, sh2, sc2)
        x = layer_norm(DEEPNORM_ALPHA * x + g2 * ec_moe(h2, w_router[l], w_gate[l], w_up[l], w_down[l]),
                       ln2_g[l], ln2_b[l])
        if not last:
            ctx = ctx_new
    return x
```

```cpp
#include <hip/hip_runtime.h>
#include <cstdio>
#include <cstdint>

#ifndef MK_PER_PHASE
#define MK_PER_PHASE 0
#endif

#define LAS __attribute__((address_space(3)))
#define GAS __attribute__((address_space(1)))
typedef unsigned short bf16_t;
typedef short bf16x8 __attribute__((ext_vector_type(8)));
typedef float f32x4 __attribute__((ext_vector_type(4)));
typedef float f32x2 __attribute__((ext_vector_type(2)));
typedef unsigned u32x4 __attribute__((ext_vector_type(4)));
typedef unsigned u32x2 __attribute__((ext_vector_type(2)));

constexpr int D = 1024, NB = 4, SEQ = 8192, NCTX = 256, RL = NB * SEQ, RC = NB * NCTX, R = RL + RC;
constexpr int INW = 2048, NE = 16, FF = 1024;
constexpr int OFF_AQ = 0, OFF_AK = 512, OFF_AV = 640, OFF_BQ = 768, OFF_BK = 1024, OFF_BV = 1280, OFF_C = 1536;
constexpr int CAP_L = 1024, CAP_C = 32, EROWS = 4352, EMT = 17;
constexpr float LN_EPS = 1e-6f, ALPHA = 1.41421356237309515f;
constexpr float LOG2E = 1.4426950408889634f;
constexpr float C2 = 0.125f * LOG2E;

constexpr size_t MiB = 1u << 20;
constexpr size_t WS_CTL = 0, CTL_ZERO_BYTES = 1 * MiB;
constexpr size_t WS_MOD = 1 * MiB;
constexpr size_t WS_ROPE = 1 * MiB + 512 * 1024;
constexpr size_t WS_AFF = 2 * MiB;
constexpr size_t WS_AFFC = 4 * MiB;
constexpr size_t WS_INV = 5 * MiB;
constexpr size_t WS_RIDX = 8 * MiB;
constexpr size_t WS_GATEW = 8 * MiB + 512 * 1024;
constexpr size_t WS_RIDENT = 4 * MiB + 512 * 1024;
constexpr size_t WS_XC = 9 * MiB;
constexpr size_t WS_WIN = 13 * MiB;
constexpr size_t WS_WOUT = 17 * MiB;
constexpr size_t WS_WGU = 19 * MiB;
constexpr size_t WS_WD = 83 * MiB;
constexpr size_t WS_XA = 115 * MiB;
constexpr size_t WS_P = 247 * MiB;
constexpr size_t WS_Q = 383 * MiB;
constexpr size_t REGION = 136 * MiB, HALFREG = 68 * MiB;
constexpr size_t WS_W1 = 519 * MiB;
constexpr size_t WS_END = 573 * MiB;
__host__ __device__ constexpr size_t wsw(int l, size_t off) { return l == 0 ? off : (off == 13 * MiB ? WS_W1 : off == 17 * MiB ? WS_W1 + 4 * MiB : off == 19 * MiB ? WS_W1 + 6 * MiB : WS_W1 + 38 * MiB); }
constexpr int CW_BAR = 4096;

constexpr int RING_BYTES = 131072;
constexpr int RIDX_OFF = 143360;
constexpr int LDSCTL_OFF = RIDX_OFF + 2048, MISC_OFF = LDSCTL_OFF + 320, PTR_OFF = LDSCTL_OFF + 512;
constexpr int LDS_BYTES = 147456;
constexpr int NWAVES = 8, NTHR = 512;

__device__ __forceinline__ unsigned f2bf(float f) { unsigned u = __builtin_bit_cast(unsigned, f); return (u + 0x7fffu + ((u >> 16) & 1u)) >> 16; }
__device__ __forceinline__ unsigned pk2(float lo, float hi) { return f2bf(lo) | (f2bf(hi) << 16); }
__device__ __forceinline__ float bf2f(unsigned short b) { return __builtin_bit_cast(float, (unsigned)b << 16); }
__device__ __forceinline__ float bflo(unsigned w) { return __builtin_bit_cast(float, w << 16); }
__device__ __forceinline__ float bfhi(unsigned w) { return __builtin_bit_cast(float, w & 0xffff0000u); }
__device__ __forceinline__ unsigned pk4_fp8(float a, float b, float c, float d) { int w = 0; w = __builtin_amdgcn_cvt_pk_fp8_f32(a, b, w, false); w = __builtin_amdgcn_cvt_pk_fp8_f32(c, d, w, true); return (unsigned)w; }
__device__ __forceinline__ unsigned cvt_pk_bf16(float lo, float hi) { unsigned r; asm volatile("v_cvt_pk_bf16_f32 %0, %1, %2" : "=v"(r) : "v"(lo), "v"(hi)); return r; }
template <int O> __device__ __forceinline__ float swz_xor(float v) { return __builtin_bit_cast(float, __builtin_amdgcn_ds_swizzle(__builtin_bit_cast(int, v), (O << 10) | 0x1f)); }
__device__ __forceinline__ void swap_halves(float v, float& lo_everywhere, float& hi_everywhere) {
    unsigned a = __builtin_bit_cast(unsigned, v), b = a;
    asm volatile("s_nop 1\n\tv_permlane32_swap_b32 %0, %1\n\ts_nop 0" : "+v"(a), "+v"(b));
    lo_everywhere = __builtin_bit_cast(float, a); hi_everywhere = __builtin_bit_cast(float, b);
}
__device__ __forceinline__ float sum_halves(float v) { float x, y; swap_halves(v, x, y); return x + y; }
__device__ __forceinline__ float max_halves(float v) { float x, y; swap_halves(v, x, y); return fmaxf(x, y); }
__device__ __forceinline__ float other_half(float v, int hi) { float x, y; swap_halves(v, x, y); return hi ? x : y; }
template <int CTRL> __device__ __forceinline__ float dppf(float v) { return __builtin_bit_cast(float, __builtin_amdgcn_update_dpp(0, __builtin_bit_cast(int, v), CTRL, 0xf, 0xf, true)); }
__device__ __forceinline__ float row16_sum(float v) { v += dppf<0xB1>(v); v += dppf<0x4E>(v); v += dppf<0x141>(v); v += dppf<0x140>(v); return v; }
__device__ __forceinline__ float row16_max(float v) { v = fmaxf(v, dppf<0xB1>(v)); v = fmaxf(v, dppf<0x4E>(v)); v = fmaxf(v, dppf<0x141>(v)); v = fmaxf(v, dppf<0x140>(v)); return v; }
__device__ __forceinline__ float wave_sum(float v) { v = row16_sum(v); v += swz_xor<16>(v); return sum_halves(v); }
__device__ __forceinline__ void wave_sum2(float& a, float& b) {
    a = row16_sum(a); b = row16_sum(b); const float a2 = swz_xor<16>(a), b2 = swz_xor<16>(b); a += a2; b += b2; a = sum_halves(a); b = sum_halves(b);
}
__device__ __forceinline__ unsigned lane_get(unsigned v, int srclane) { return (unsigned)__builtin_amdgcn_ds_bpermute(srclane << 2, (int)v); }
#define LDS_WAIT() asm volatile("s_waitcnt lgkmcnt(0)" ::: "memory")
#define VM_WAIT() asm volatile("s_waitcnt vmcnt(0)" ::: "memory")

#define XB_TMO      128
#define XB_XCNT(j)  (256  + 64 * (j))
#define XB_XSUB(j)  (1280 + 64 * (j))
#define XB_XGEN(j)  (2304 + 64 * (j))
#define XB_TOP      3328
#define XB_TOPGEN   3392
#define XCD_BAR_WORDS 3456
#define XB_SPIN_CAP (1u << 24)
__device__ __forceinline__ unsigned xb_ld(unsigned* p)              { return __hip_atomic_load(p, __ATOMIC_RELAXED, __HIP_MEMORY_SCOPE_AGENT); }
__device__ __forceinline__ unsigned xb_add(unsigned* p, unsigned v) { return __hip_atomic_fetch_add(p, v, __ATOMIC_RELAXED, __HIP_MEMORY_SCOPE_AGENT); }
__device__ __forceinline__ unsigned xb_xcc_id() { return (unsigned)__builtin_amdgcn_s_getreg((3 << 11) | 20) & 0xFu; }
#define XB_SPIN(cond, bar) do { unsigned _sp = 0; while (cond) { __builtin_amdgcn_s_sleep(1); \
    if ((++_sp & 255u) == 0u) { if (xb_ld(&(bar)[XB_TMO])) break; if (_sp > XB_SPIN_CAP) { atomicAdd(&(bar)[XB_TMO], 1u); break; } } } } while (0)
struct XcdBarrier { unsigned* bar; unsigned x; volatile LAS unsigned* st; };
__device__ __forceinline__ XcdBarrier xcd_barrier_post(unsigned* bar, volatile LAS unsigned* st) {
    XcdBarrier b; b.bar = bar; b.x = xb_xcc_id(); b.st = st;
    if (threadIdx.x == 0) (void)xb_add(&bar[XB_XCNT(b.x)], 1u);
    return b;
}
__device__ __forceinline__ int xb_row16_isum(int v) {
    v += __builtin_amdgcn_update_dpp(0, v, 0xB1, 0xf, 0xf, true); v += __builtin_amdgcn_update_dpp(0, v, 0x4E, 0xf, 0xf, true);
    v += __builtin_amdgcn_update_dpp(0, v, 0x141, 0xf, 0xf, true); v += __builtin_amdgcn_update_dpp(0, v, 0x140, 0xf, 0xf, true); return v;
}
__device__ __forceinline__ void xcd_barrier_complete_w0(unsigned* bar, unsigned x, unsigned& nloc, unsigned& nx) {
    const unsigned G = gridDim.x * gridDim.y * gridDim.z;
    const unsigned ln = threadIdx.x & 63u;
    unsigned c = 0u, sp = 0u;
    for (;;) {
        c = (ln < 16u) ? xb_ld(&bar[XB_XCNT(ln)]) : 0u;
        const unsigned sum = (unsigned)__builtin_amdgcn_readfirstlane(xb_row16_isum((int)c));
        if (sum == G) break;
        __builtin_amdgcn_s_sleep(1);
        if ((++sp & 255u) == 0u) { if (xb_ld(&bar[XB_TMO])) break; if (sp > XB_SPIN_CAP) { if (ln == 0u) atomicAdd(&bar[XB_TMO], 1u); break; } }
    }
    const unsigned cnt = (unsigned)__builtin_popcountll(__ballot(c > 0u));
    const unsigned mine = (unsigned)__builtin_amdgcn_readlane((int)c, (int)x);
    nloc = mine > 0u ? mine : 1u; nx = cnt > 0u ? cnt : 1u;
}
__device__ __forceinline__ void xcd_barrier(const XcdBarrier& b) {
    asm volatile("s_waitcnt vmcnt(0)" ::: "memory");
    __syncthreads();
    if (threadIdx.x < 64) {
        unsigned* bar = b.bar; unsigned bx_ = b.x; asm volatile("" : "+s"(bar), "+s"(bx_));
        __builtin_amdgcn_s_waitcnt(0);
        unsigned nloc = b.st[0], nx = b.st[1];
        if (nloc == 0u) { xcd_barrier_complete_w0(bar, bx_, nloc, nx); if (threadIdx.x == 0) { b.st[0] = nloc; b.st[1] = nx; } }
        if (threadIdx.x == 0) {
        const unsigned old = xb_add(&bar[XB_XSUB(bx_)], 1u);
        const unsigned gen = old / nloc;
        if (old + 1u == (gen + 1u) * nloc) {
            __builtin_amdgcn_fence(__ATOMIC_RELEASE, "agent");
            asm volatile("s_waitcnt vmcnt(0)" ::: "memory");
            const unsigned og = xb_add(&bar[XB_TOP], 1u);
            const unsigned tg = og / nx;
            if (og + 1u == (tg + 1u) * nx) xb_add(&bar[XB_TOPGEN], 1u);
            else XB_SPIN(xb_ld(&bar[XB_TOPGEN]) == tg, bar);
            __builtin_amdgcn_fence(__ATOMIC_ACQUIRE, "agent");
            xb_add(&bar[XB_XGEN(bx_)], 1u);
            asm volatile("s_waitcnt vmcnt(0)" ::: "memory");
        } else {
            XB_SPIN(xb_ld(&bar[XB_XGEN(bx_)]) == gen, bar);
            __builtin_amdgcn_fence(__ATOMIC_ACQUIRE, "agent");
            asm volatile("s_waitcnt vmcnt(0)" ::: "memory");
        }
        }
    }
    __syncthreads();
}

namespace pg8 {
constexpr int BM = 256, BK = 64, HALF = 128, HTB = HALF * BK * 2, STAGE_BYTES = 8 * HTB, NXCD = 8, WGM = 8, ROWVEC_OFF = STAGE_BYTES;
__host__ __device__ constexpr __forceinline__ int lds_byte(int r, int c) { const int st = (r >> 4) * 2 + (c >> 5), rr = r & 15, cc = c & 31, ob = rr * 64 + cc * 2; return st * 1024 + (ob ^ (((ob >> 9) & 1) << 5)); }
__host__ __device__ __forceinline__ void stage_rc(int b, int& Rr, int& C) { const int st = b / 1024, sb = b % 1024, swz = sb ^ (((sb >> 9) & 1) << 5); Rr = (st >> 1) * 16 + swz / 64; C = (st & 1) * 32 + (swz % 64) / 2; }
__host__ __device__ __forceinline__ int perm32(int rho) { const int n = rho >> 4, i = rho & 15; return 8 * (i >> 2) + 4 * n + (i & 3); }

struct Unit { int pm, pn, am, bn; };
struct Gemm { const bf16_t* A; const bf16_t* Bt; int K; const int* ridx; };

struct TileOrder {
    int nM, nN, nwg, G, c, mt, special, sidx;
    __device__ void init(int nM_, int nN_, int G_, int c_, int mt_) { nM = nM_; nN = nN_; nwg = nM * nN; G = G_; c = c_; mt = mt_; special = 0; sidx = 0; }
    __device__ void init_special(int kind, int idx) { nM = nN = nwg = G = 1; c = 0; mt = 0; special = kind; sidx = idx; }
    __device__ bool next(int i, Unit& u) const {
        int pm, pn, am, bn; bool ok;
        if (special) { ok = (i == 0); const int t = sidx >> 2; pm = am = RL / BM + (sidx & 3); pn = bn = (special == 1) ? t : (t == 0 ? 2 : 3 + t); }
        else {
            const long L = (long)i * G + c; ok = L < nwg;
            int wgid = ok ? (int)L : 0; { const int q = nwg / NXCD, r = nwg % NXCD, xcd = wgid % NXCD, off = wgid / NXCD; wgid = (xcd < r ? xcd * (q + 1) : r * (q + 1) + (xcd - r) * q) + off; }
            const int nig = WGM * nN, gid = wgid / nig, fm = gid * WGM, gsz = (nM - fm) < WGM ? (nM - fm) : WGM;
            pm = fm + ((wgid % nig) % gsz); pn = (wgid % nig) / gsz;
            if (mt > 0) { const int e = pm / mt; am = e * EMT + (pm - e * mt); bn = e * nN + pn; } else { am = pm; bn = pn; }
        }
        u.pm = pm; u.pn = pn; u.am = am; u.bn = bn;
        return ok;
    }
};

struct EpiBf16 {
    static constexpr bool ROWVEC = false;
    bf16_t* O; int ldc;
    __device__ __forceinline__ void operator()(const f32x4 (&acc)[2][2][4][2], const Unit& u, int wr, int wc, int fr, int fq, int ui) const {
        const int row0 = u.am * BM + wr * 64 + fr, col0 = u.pn * BM + wc * 32 + 8 * fq;
#pragma unroll
        for (int ai = 0; ai < 2; ++ai)
#pragma unroll
            for (int m = 0; m < 4; ++m) { bf16_t* rowp = O + (size_t)(row0 + ai * HALF + m * 16) * ldc + col0;
#pragma unroll
                for (int bj = 0; bj < 2; ++bj) { const f32x4 v0 = acc[ai][bj][m][0], v1 = acc[ai][bj][m][1];
                    u32x4 w; w.x = cvt_pk_bf16(v0[0], v0[1]); w.y = cvt_pk_bf16(v0[2], v0[3]); w.z = cvt_pk_bf16(v1[0], v1[1]); w.w = cvt_pk_bf16(v1[2], v1[3]);
                    *(u32x4*)(rowp + bj * HALF) = w; } }
    }
};
struct EpiInProj {
    static constexpr bool ROWVEC = false;
    bf16_t* O; const float* ropec; const float* ropes;
    __device__ __forceinline__ void operator()(const f32x4 (&acc)[2][2][4][2], const Unit& u, int wr, int wc, int fr, int fq, int ui) const {
        const int row0 = u.am * BM + wr * 64 + fr;
        if (u.pn >= 6) {
            const int col0 = OFF_C + (u.pn - 6) * HALF + wc * 32 + 8 * fq;
#pragma unroll
            for (int ai = 0; ai < 2; ++ai)
#pragma unroll
                for (int m = 0; m < 4; ++m) { bf16_t* rowp = O + (size_t)(row0 + ai * HALF + m * 16) * INW + col0;
                    float h[8];
#pragma unroll
                    for (int n = 0; n < 2; ++n)
#pragma unroll
                        for (int i = 0; i < 4; ++i) { const float a = acc[ai][0][m][n][i], g = acc[ai][1][m][n][i]; h[n * 4 + i] = a * __builtin_amdgcn_rcpf(1.0f + __builtin_amdgcn_exp2f(-g * LOG2E)); }
                    u32x4 w; w.x = cvt_pk_bf16(h[0], h[1]); w.y = cvt_pk_bf16(h[2], h[3]); w.z = cvt_pk_bf16(h[4], h[5]); w.w = cvt_pk_bf16(h[6], h[7]);
                    *(u32x4*)rowp = w; }
            return;
        }
        const int col0 = u.pn * BM + wc * 32 + 8 * fq;
        const bool latent = (u.am * BM) < RL;
        const float sc = (u.pn < 2 || u.pn == 3) ? C2 : 1.0f;
        const float sgn = (fq < 2) ? -1.0f : 1.0f;
        const int f0 = 8 * (fq & 1);
#pragma unroll
        for (int ai = 0; ai < 2; ++ai)
#pragma unroll
            for (int m = 0; m < 4; ++m) {
                const int row = row0 + ai * HALF + m * 16;
                bf16_t* rowp = O + (size_t)row * INW + col0;
                const int t = row & (SEQ - 1);
                const int pos = (wc & 1) ? (t & 63) : (t >> 6);
#pragma unroll
                for (int bj = 0; bj < 2; ++bj) {
                    f32x4 v0 = acc[ai][bj][m][0], v1 = acc[ai][bj][m][1];
                    const bool rope = latent && (u.pn < 2 || (u.pn == 2 && bj == 0));
                    if (rope) {
                        const f32x4 c0 = *(const f32x4*)(ropec + pos * 16 + f0), c1 = *(const f32x4*)(ropec + pos * 16 + f0 + 4);
                        const f32x4 s0 = *(const f32x4*)(ropes + pos * 16 + f0), s1 = *(const f32x4*)(ropes + pos * 16 + f0 + 4);
                        f32x4 p0, p1;
#pragma unroll
                        for (int i = 0; i < 4; ++i) { p0[i] = other_half(v0[i], fq >> 1); p1[i] = other_half(v1[i], fq >> 1); }
                        v0 = v0 * c0 + (p0 * s0) * sgn; v1 = v1 * c1 + (p1 * s1) * sgn;
                    }
                    v0 = v0 * sc; v1 = v1 * sc;
                    u32x4 w; w.x = cvt_pk_bf16(v0[0], v0[1]); w.y = cvt_pk_bf16(v0[2], v0[3]); w.z = cvt_pk_bf16(v1[0], v1[1]); w.w = cvt_pk_bf16(v1[2], v1[3]);
                    *(u32x4*)(rowp + bj * HALF) = w;
                }
            }
    }
};
struct EpiSwiGLU {
    static constexpr bool ROWVEC = false;
    unsigned char* O;
    __device__ __forceinline__ void operator()(const f32x4 (&acc)[2][2][4][2], const Unit& u, int wr, int wc, int fr, int fq, int ui) const {
        const int row0 = u.am * BM + wr * 64 + fr, col0 = u.pn * HALF + wc * 32 + 8 * fq;
#pragma unroll
        for (int ai = 0; ai < 2; ++ai)
#pragma unroll
            for (int m = 0; m < 4; ++m) { unsigned char* rowp = O + (size_t)(row0 + ai * HALF + m * 16) * FF + col0;
                float h[8];
#pragma unroll
                for (int n = 0; n < 2; ++n)
#pragma unroll
                    for (int i = 0; i < 4; ++i) { const float g = acc[ai][0][m][n][i], up = acc[ai][1][m][n][i];
                        const float sg = g * __builtin_amdgcn_rcpf(1.0f + __builtin_amdgcn_exp2f(-g * LOG2E)); h[n * 4 + i] = sg * up; }
                u32x2 w; w.x = pk4_fp8(h[0], h[1], h[2], h[3]); w.y = pk4_fp8(h[4], h[5], h[6], h[7]);
                *(u32x2*)rowp = w; }
    }
};
struct EpiRowScale {
    static constexpr bool ROWVEC = true;
    unsigned char* O; const float* gw; const LAS float* lgw;
    __device__ __forceinline__ void operator()(const f32x4 (&acc)[2][2][4][2], const Unit& u, int wr, int wc, int fr, int fq, int ui) const {
        const int row0 = u.am * BM + wr * 64 + fr, col0 = u.pn * BM + wc * 32 + 8 * fq;
#pragma unroll
        for (int ai = 0; ai < 2; ++ai)
#pragma unroll
            for (int m = 0; m < 4; ++m) { const int row = row0 + ai * HALF + m * 16; const float g = lgw[(ui & 1) * BM + wr * 64 + fr + ai * HALF + m * 16] * 16.0f; unsigned char* rowp = O + (size_t)row * D + col0;
#pragma unroll
                for (int bj = 0; bj < 2; ++bj) { const f32x4 v0 = acc[ai][bj][m][0] * g, v1 = acc[ai][bj][m][1] * g;
                    u32x2 w; w.x = pk4_fp8(v0[0], v0[1], v0[2], v0[3]); w.y = pk4_fp8(v1[0], v1[1], v1[2], v1[3]);
                    *(u32x2*)(rowp + bj * HALF) = w; } }
    }
};

typedef int v8i_t __attribute__((ext_vector_type(8)));
template <class Epi, bool GATHER, bool FP8>
__device__ __forceinline__ void gemm_phase(const int tid, LAS unsigned char* lds, LAS unsigned char* lds_ridx, const Gemm g, const TileOrder& S, const Epi& E) {
    const int wid = __builtin_amdgcn_readfirstlane(tid >> 6), lane = tid & 63, wr = wid >> 2, wc = wid & 3, fr = lane & 15, fq = lane >> 4;
    constexpr int ESZ = FP8 ? 1 : 2;
    const int K = g.K, nt = K * ESZ / (BK * 2);
    int RA[2], CA[2]; unsigned voffB[2];
#pragma unroll
    for (int i = 0; i < 2; ++i) { int Rr, C; stage_rc(tid * 16 + i * 8192, Rr, C); const int Rb = (Rr & ~31) + perm32(Rr & 31);
        RA[i] = Rr; CA[i] = C; voffB[i] = (unsigned)(Rb * K * ESZ + C * 2); }
    const size_t kstep = (size_t)(BK * 2);
    const size_t hstep = (size_t)HALF * K * ESZ;
    const size_t tstep = 2 * hstep;
    const unsigned ldsw = (unsigned)wid * 1024u;
    const int aoff = lds_byte(wr * 64 + fr, fq * 8), boff = lds_byte(wc * 32 + fr, fq * 8);
#define PG8_SA(b, h) (((b) * 2 + (h)) * HTB)
#define PG8_SB(b, h) ((4 + (b) * 2 + (h)) * HTB)
#define PG8_STAGE(bufoff, gbase, voff) do { _Pragma("unroll") for (int _i = 0; _i < 2; ++_i) \
        __builtin_amdgcn_global_load_lds((const unsigned*)((const char*)(gbase) + (voff)[_i]), (LAS unsigned*)(lds + (bufoff) + ldsw + _i * 8192), 16, 0, 0); } while (0)
#define PG8_STAGE_H1(bufoff, gbase) do { if constexpr (GATHER) PG8_STAGE(bufoff, gbase, v1); else PG8_STAGE(bufoff, (gbase) + hstep, v0); } while (0)
#define PG8_LD8(p0_, p1_) __builtin_bit_cast(v8i_t, __builtin_shufflevector(*(const LAS f32x4*)(p0_), *(const LAS f32x4*)(p1_), 0, 1, 2, 3, 4, 5, 6, 7))
#define PG8_LDA(dst, b, h) do { _Pragma("unroll") for (int m = 0; m < 4; ++m) { \
        if constexpr (FP8) dst##8[m] = PG8_LD8(lds + PG8_SA(b, h) + aoff + m * 2048, lds + PG8_SA(b, h) + aoff + 1024 + m * 2048); \
        else { _Pragma("unroll") for (int k = 0; k < 2; ++k) dst[m][k] = *(const LAS bf16x8*)(lds + PG8_SA(b, h) + aoff + k * 1024 + m * 2048); } } } while (0)
#define PG8_LDB(dst, b, h) do { _Pragma("unroll") for (int n = 0; n < 2; ++n) { \
        if constexpr (FP8) dst##8[n] = PG8_LD8(lds + PG8_SB(b, h) + boff + n * 2048, lds + PG8_SB(b, h) + boff + 1024 + n * 2048); \
        else { _Pragma("unroll") for (int k = 0; k < 2; ++k) dst[n][k] = *(const LAS bf16x8*)(lds + PG8_SB(b, h) + boff + k * 1024 + n * 2048); } } } while (0)
#define PG8_MMA(ai, bj, At, Bt) do { __builtin_amdgcn_s_setprio(1); _Pragma("unroll") for (int m = 0; m < 4; ++m) _Pragma("unroll") for (int n = 0; n < 2; ++n) { \
        if constexpr (FP8) acc[ai][bj][m][n] = __builtin_amdgcn_mfma_scale_f32_16x16x128_f8f6f4(Bt##8[n], At##8[m], acc[ai][bj][m][n], 0, 0, 0, mx_sw, 0, mx_sa); \
        else { _Pragma("unroll") for (int k = 0; k < 2; ++k) acc[ai][bj][m][n] = __builtin_amdgcn_mfma_f32_16x16x32_bf16(Bt[n][k], At[m][k], acc[ai][bj][m][n], 0, 0, 0); } } __builtin_amdgcn_s_setprio(0); } while (0)
#define PG8_WAIT_V(n) asm volatile("s_waitcnt vmcnt(" #n ")" ::: "memory")
#define PG8_WAIT_L(n) asm volatile("s_waitcnt lgkmcnt(" #n ")" ::: "memory")
#define PG8_BAR __builtin_amdgcn_s_barrier()
#define PG8_SCHED __builtin_amdgcn_sched_barrier(0)
#define PG8_PIN do { if constexpr (FP8) __builtin_amdgcn_sched_barrier(0); } while (0)
    int mx_sw = 0x79797979, mx_sa = 0x7F7F7F7F;
    if constexpr (FP8) asm volatile("" : "+v"(mx_sw), "+v"(mx_sa));
    Unit cur, nxt; int ui = 0;
    if (!S.next(0, cur)) return;
    f32x4 acc[2][2][4][2];
#pragma unroll
    for (int a = 0; a < 2; ++a)
#pragma unroll
        for (int b = 0; b < 2; ++b)
#pragma unroll
            for (int m = 0; m < 4; ++m)
#pragma unroll
                for (int n = 0; n < 2; ++n) acc[a][b][m][n] = (f32x4){0.f, 0.f, 0.f, 0.f};
    bf16x8 At[4][2], B0[2][2], B1[2][2]; v8i_t At8[4], B08[2], B18[2];
    unsigned v0[2], v1[2];
    const char* cA; const char* cB = (const char*)g.Bt + (size_t)cur.bn * tstep;
    if constexpr (GATHER) {
        cA = (const char*)g.A;
#pragma unroll
        for (int i = 0; i < 2; ++i) { const int r0 = g.ridx[cur.am * BM + RA[i]], r1 = g.ridx[cur.am * BM + HALF + RA[i]];
            v0[i] = (unsigned)(r0 * K * ESZ + CA[i] * 2); v1[i] = (unsigned)(r1 * K * ESZ + CA[i] * 2); }
    } else {
        cA = (const char*)g.A + (size_t)cur.am * tstep;
#pragma unroll
        for (int i = 0; i < 2; ++i) { v0[i] = (unsigned)(RA[i] * K * ESZ + CA[i] * 2); v1[i] = 0u; }
    }
    if constexpr (Epi::ROWVEC) { if (wid >= 4) __builtin_amdgcn_global_load_lds((const unsigned*)(E.gw + cur.am * BM + (tid - 256)), (LAS unsigned*)(lds + ROWVEC_OFF + (wid - 4) * 256), 4, 0, 0); }
    PG8_STAGE(PG8_SB(0, 0), cB, voffB); PG8_STAGE(PG8_SB(0, 1), cB + hstep, voffB); PG8_STAGE(PG8_SA(0, 0), cA, v0); PG8_STAGE_H1(PG8_SA(0, 1), cA);
    if (wr == 1) PG8_BAR;
    PG8_WAIT_V(2); PG8_BAR;
    PG8_STAGE(PG8_SB(1, 0), cB + kstep, voffB); PG8_STAGE(PG8_SA(1, 0), cA + kstep, v0); PG8_STAGE(PG8_SB(1, 1), cB + hstep + kstep, voffB);
    PG8_WAIT_V(6); PG8_BAR;
    for (;;) {
        const bool has_next = S.next(ui + 1, nxt);
        const char* nA; const char* nB = has_next ? (const char*)g.Bt + (size_t)nxt.bn * tstep : cB;
        if constexpr (GATHER) {
            nA = cA;
            if (has_next && wid < 4)
                __builtin_amdgcn_global_load_lds((const unsigned*)(g.ridx + nxt.am * BM + tid), (LAS unsigned*)(lds_ridx + ((ui + 1) & 1) * 1024 + wid * 256), 4, 0, 0);
            if constexpr (Epi::ROWVEC) { if (has_next && wid >= 4)
                __builtin_amdgcn_global_load_lds((const unsigned*)(E.gw + nxt.am * BM + (tid - 256)), (LAS unsigned*)(lds + ROWVEC_OFF + ((ui + 1) & 1) * 1024 + (wid - 4) * 256), 4, 0, 0); }
        } else {
            nA = has_next ? (const char*)g.A + (size_t)nxt.am * tstep : cA;
        }
#pragma unroll 1
        for (int t = 0; t < nt; t += 2) {
            const bool last = (t == nt - 2);
            const char* a1 = cA + (size_t)(t + 1) * kstep;
            const char* a2 = last ? nA : cA + (size_t)(t + 2) * kstep; const char* b2 = last ? nB : cB + (size_t)(t + 2) * kstep;
            const char* a3 = a2 + kstep; const char* b3 = b2 + kstep;
            PG8_LDB(B0, 0, 0); PG8_LDB(B1, 0, 1); PG8_SCHED; PG8_LDA(At, 0, 0); PG8_STAGE_H1(PG8_SA(1, 1), a1);
            if constexpr (GATHER) {
                if (last && has_next) {
                    const LAS int* rp = (const LAS int*)(lds_ridx + ((ui + 1) & 1) * 1024);
#pragma unroll
                    for (int i = 0; i < 2; ++i) { const int r0 = rp[RA[i]], r1 = rp[HALF + RA[i]];
                        v0[i] = (unsigned)(r0 * K * ESZ + CA[i] * 2); v1[i] = (unsigned)(r1 * K * ESZ + CA[i] * 2); }
                }
            }
            PG8_WAIT_V(8); PG8_WAIT_L(0); PG8_BAR; PG8_PIN; PG8_MMA(0, 0, At, B0); PG8_MMA(0, 1, At, B1); PG8_PIN; PG8_BAR; PG8_SCHED;
            PG8_LDA(At, 0, 1); PG8_STAGE(PG8_SB(0, 0), b2, voffB); PG8_STAGE(PG8_SB(0, 1), b2 + hstep, voffB); PG8_STAGE(PG8_SA(0, 0), a2, v0);
            PG8_WAIT_V(8); PG8_WAIT_L(0); PG8_BAR; PG8_PIN; PG8_MMA(1, 0, At, B0); PG8_MMA(1, 1, At, B1); PG8_PIN; PG8_BAR; PG8_SCHED;
            PG8_LDB(B0, 1, 0); PG8_LDB(B1, 1, 1); PG8_SCHED; PG8_LDA(At, 1, 0); PG8_STAGE_H1(PG8_SA(0, 1), a2);
            PG8_WAIT_V(8); PG8_WAIT_L(0); PG8_BAR; PG8_PIN; PG8_MMA(0, 0, At, B0); PG8_MMA(0, 1, At, B1); PG8_PIN; PG8_BAR; PG8_SCHED;
            PG8_LDA(At, 1, 1); PG8_STAGE(PG8_SB(1, 0), b3, voffB); PG8_STAGE(PG8_SB(1, 1), b3 + hstep, voffB); PG8_STAGE(PG8_SA(1, 0), a3, v0);
            PG8_WAIT_V(8); PG8_WAIT_L(0); PG8_BAR; PG8_PIN; PG8_MMA(1, 0, At, B0); PG8_MMA(1, 1, At, B1); PG8_PIN; PG8_BAR; PG8_SCHED;
        }
        if (wr == 0) PG8_BAR;
        E(acc, cur, wr, wc, fr, fq, ui);
        if (!has_next) break;
#pragma unroll
        for (int a = 0; a < 2; ++a)
#pragma unroll
            for (int b = 0; b < 2; ++b)
#pragma unroll
                for (int m = 0; m < 4; ++m)
#pragma unroll
                    for (int n = 0; n < 2; ++n) acc[a][b][m][n] = (f32x4){0.f, 0.f, 0.f, 0.f};
        cur = nxt; cA = nA; cB = nB; ++ui;
        if (wr == 1) PG8_BAR;
    }
    PG8_WAIT_V(0);
    PG8_BAR;
#undef PG8_SA
#undef PG8_SB
#undef PG8_STAGE
#undef PG8_LDA
#undef PG8_LDB
#undef PG8_MMA
#undef PG8_LD8
#undef PG8_STAGE_H1
#undef PG8_WAIT_V
#undef PG8_WAIT_L
#undef PG8_BAR
#undef PG8_SCHED
#undef PG8_PIN
}
static_assert(lds_byte(9, 16) + 16 == lds_byte(9, 24) && lds_byte(3, 48) + 16 == lds_byte(3, 56) && lds_byte(12, 0) + 16 == lds_byte(12, 8), "fp8 fragment halves are adjacent");
}

struct Args { const float* in[22]; float* out; unsigned char* ws; int ph_lo, ph_hi; };
struct Frame {
    LAS unsigned char* lds;
    int lane, wave, vcu, G, bx;
    __device__ __forceinline__ int tid_() const { return wave * 64 + lane; }
    unsigned char* ws;
};
__device__ __forceinline__ const float* inp(const Frame& F, int k) {
    const unsigned long long v = ((const LAS unsigned long long*)(F.lds + PTR_OFF))[k];
    const unsigned lo = __builtin_amdgcn_readfirstlane((unsigned)v), hi = __builtin_amdgcn_readfirstlane((unsigned)(v >> 32));
    return (const float*)(((unsigned long long)hi << 32) | lo);
}
#define F_x (inp(F, 0))
#define F_c (inp(F, 1))
#define F_ctx (inp(F, 2))
#define F_c_ctx (inp(F, 3))
#define F_w_mod (inp(F, 4))
#define F_b_mod (inp(F, 5))
#define F_w_in (inp(F, 6))
#define F_a_sink (inp(F, 7))
#define F_nat_bias (inp(F, 8))
#define F_conv_w (inp(F, 9))
#define F_conv_b (inp(F, 10))
#define F_conv_ln_g (inp(F, 11))
#define F_conv_ln_b (inp(F, 12))
#define F_w_out (inp(F, 13))
#define F_ln1_g (inp(F, 14))
#define F_ln1_b (inp(F, 15))
#define F_w_router (inp(F, 16))
#define F_w_gate (inp(F, 17))
#define F_w_up (inp(F, 18))
#define F_w_down (inp(F, 19))
#define F_ln2_g (inp(F, 20))
#define F_ln2_b (inp(F, 21))
#define F_out ((float*)inp(F, 22))
__device__ __forceinline__ const float* modp(const Frame& F, int l, int cond, int which) { return (const float*)(F.ws + WS_MOD) + ((size_t)(l * 5 + cond) * 6 + which) * D; }
__device__ __forceinline__ int row_cond(int m) { return m < RL ? (m >> 13) : 4; }

__device__ __forceinline__ void conv_item_load(const float* W, int N, int k0, int n0, int lane, f32x4 (&t)[8]) {
    const float* src = W + (size_t)(k0 + (lane >> 3)) * N + n0 + (lane & 7) * 4;
#pragma unroll
    for (int i = 0; i < 8; ++i) t[i] = *(const GAS f32x4*)(src + (size_t)(8 * i) * N);
}
__device__ __forceinline__ void conv_item_to_lds(const f32x4 (&t)[8], LAS float* scr, int lane) {
#pragma unroll
    for (int i = 0; i < 8; ++i) { LAS float* d = scr + (8 * i + (lane >> 3)) * 33 + (lane & 7) * 4; d[0] = t[i][0]; d[1] = t[i][1]; d[2] = t[i][2]; d[3] = t[i][3]; }
    LDS_WAIT(); asm volatile("" ::: "memory");
}
__device__ __forceinline__ void conv_item_store_bf16(bf16_t* WT, int Kd, int trow, LAS float* scr, int k0, int lane) {
    const int c = lane & 7;
#pragma unroll
    for (int j = 0; j < 4; ++j) { const int n = (lane >> 3) + 8 * j; const LAS float* sp = scr + (8 * c) * 33 + n;
        u32x4 o; o.x = pk2(sp[0 * 33], sp[1 * 33]); o.y = pk2(sp[2 * 33], sp[3 * 33]); o.z = pk2(sp[4 * 33], sp[5 * 33]); o.w = pk2(sp[6 * 33], sp[7 * 33]);
        *(GAS u32x4*)(WT + (size_t)(trow + n) * Kd + k0 + 8 * c) = o; }
    LDS_WAIT(); asm volatile("" ::: "memory");
}
__device__ __forceinline__ void conv_item_store_fp8(unsigned char* WT, int Kd, int trow, LAS float* scr, int k0, int lane) {
    const int n = lane >> 1, kh = (lane & 1) * 32; const LAS float* sp = scr + kh * 33 + n;
    unsigned w[8];
#pragma unroll
    for (int q = 0; q < 8; ++q) w[q] = pk4_fp8(sp[(4 * q) * 33] * 64.0f, sp[(4 * q + 1) * 33] * 64.0f, sp[(4 * q + 2) * 33] * 64.0f, sp[(4 * q + 3) * 33] * 64.0f);
    unsigned char* dst = WT + (size_t)(trow + n) * Kd + k0 + kh;
    *(GAS u32x4*)dst = (u32x4){w[0], w[1], w[2], w[3]}; *(GAS u32x4*)(dst + 16) = (u32x4){w[4], w[5], w[6], w[7]};
    LDS_WAIT(); asm volatile("" ::: "memory");
}
constexpr int CONV_NITEMS = 16 * 64 + 16 * 32 + 3 * NE * 16 * 32, CONV_S1 = (CONV_NITEMS * 56) / 100, CONV_S2 = (CONV_NITEMS * 74) / 100;
__device__ __forceinline__ void conv_decode(const Frame& F, int l, int it, const float*& W, int& N, int& k0, int& n0, int& kind, unsigned char*& WT, int& Kd, int& trow) {
    constexpr int I_IN = 16 * 64, I_OUT = 16 * 32, I_E = 16 * 32;
    int r = it;
    if (r < I_IN) { const int kb = r / 64, nb = r % 64; n0 = 32 * nb; k0 = 64 * kb; trow = n0;
        if (n0 >= OFF_C) { const int c = n0 - OFF_C, gate = c >> 8, ch = c & 255; trow = OFF_C + (ch >> 7) * 256 + gate * 128 + (ch & 127); }
        W = F_w_in + (size_t)l * D * INW; N = INW; kind = 0; WT = F.ws + wsw(l, WS_WIN); Kd = D; return; }
    r -= I_IN;
    if (r < I_OUT) { const int kb = r / 32, nb = r % 32; n0 = 32 * nb; k0 = 64 * kb; trow = n0; W = F_w_out + (size_t)l * D * D; N = D; kind = 0; WT = F.ws + wsw(l, WS_WOUT); Kd = D; return; }
    r -= I_OUT;
    const int mat = r / (NE * I_E); r -= mat * (NE * I_E);
    const int e = r / I_E; r -= e * I_E;
    const int kb = r / 32, nb = r % 32; n0 = 32 * nb; k0 = 64 * kb;
    const size_t woff = ((size_t)l * NE + e) * (size_t)D * FF;
    kind = 1; N = (mat == 2) ? D : FF; Kd = (mat == 2) ? FF : D;
    W = (mat == 0 ? F_w_gate : mat == 1 ? F_w_up : F_w_down) + woff;
    WT = (mat == 2) ? F.ws + wsw(l, WS_WD) : F.ws + wsw(l, WS_WGU);
    trow = (mat == 0) ? e * 2048 + (n0 >> 7) * 256 + (n0 & 127) : (mat == 1) ? e * 2048 + (n0 >> 7) * 256 + 128 + (n0 & 127) : e * 1024 + n0;
}
__device__ __forceinline__ void convert_weights(Frame& F, int l, int it_lo, int it_hi, int worker, int nworkers) {
    LAS float* scr = (LAS float*)(F.lds + F.wave * 16384);
    const int gw = worker * NWAVES + F.wave, NGW = nworkers * NWAVES;
    f32x4 ta[8], tb[8];
#pragma unroll
    for (int i = 0; i < 8; ++i) { ta[i] = (f32x4){0.f, 0.f, 0.f, 0.f}; tb[i] = ta[i]; }
#pragma unroll 1
    for (int it = it_lo + gw - NGW; it < it_hi; it += NGW) {
        const float* W; int N, k0, n0, kind, Kd, trow; unsigned char* WT;
        if (it + NGW < it_hi) { conv_decode(F, l, it + NGW, W, N, k0, n0, kind, WT, Kd, trow); conv_item_load(W, N, k0, n0, F.lane, tb); }
        if (it >= it_lo) { conv_decode(F, l, it, W, N, k0, n0, kind, WT, Kd, trow);
            conv_item_to_lds(ta, scr, F.lane);
            if (kind == 0) conv_item_store_bf16((bf16_t*)WT, Kd, trow, scr, k0, F.lane); else conv_item_store_fp8(WT, Kd, trow, scr, k0, F.lane); }
        __builtin_amdgcn_sched_barrier(0);
#pragma unroll
        for (int i = 0; i < 8; ++i) ta[i] = tb[i];
        __builtin_amdgcn_sched_barrier(0);
    }
}

__device__ __forceinline__ void mod_items(Frame& F) {
    LAS float* sl = (LAS float*)F.lds;
    LAS float* part = sl + 5 * 1024;
    bool have = false;
    for (int it = F.vcu; it < 48; it += F.G) {
        if (!have) {
            for (int i = F.tid_(); i < 5 * 1024; i += NTHR) { const int cd = i >> 10, k = i & 1023; const float v = cd < 4 ? F_c[cd * D + k] : F_c_ctx[k];
                sl[i] = v / (1.0f + expf(-v)); }
            have = true;
        }
        __syncthreads();
        const int l = it / 24, ch = it % 24;
        const float* W = F_w_mod + (size_t)l * D * 6 * D + ch * 256 + 4 * F.lane;
        f32x4 a[5];
#pragma unroll
        for (int cd = 0; cd < 5; ++cd) a[cd] = (f32x4){0.f, 0.f, 0.f, 0.f};
        const int kbase = F.wave * 128;
#pragma unroll 8
        for (int kk = 0; kk < 128; ++kk) { const int k = kbase + kk; const f32x4 w = *(const f32x4*)(W + (size_t)k * 6 * D);
#pragma unroll
            for (int cd = 0; cd < 5; ++cd) a[cd] += w * sl[cd * 1024 + k]; }
#pragma unroll
        for (int cd = 0; cd < 5; ++cd) *(LAS f32x4*)(part + (F.wave * 5 + cd) * 256 + 4 * F.lane) = a[cd];
        __syncthreads();
        for (int i = F.tid_(); i < 5 * 256; i += NTHR) { const int cd = i >> 8, cc = i & 255; float s = F_b_mod[(size_t)l * 6 * D + ch * 256 + cc];
#pragma unroll
            for (int w = 0; w < 8; ++w) s += part[(w * 5 + cd) * 256 + cc];
            ((float*)(F.ws + WS_MOD))[(size_t)(l * 5 + cd) * 6 * D + ch * 256 + cc] = s; }
        __syncthreads();
    }
}
__device__ __forceinline__ void rope_table(Frame& F) {
    if (F.vcu != F.G - 1) return;
    float* rc = (float*)(F.ws + WS_ROPE); float* rs = rc + 128 * 16;
    for (int i = F.tid_(); i < 128 * 16; i += NTHR) { const int pos = i >> 4, f = i & 15;
        const float inv = exp2f(-(float)f * (13.287712379549449f / 16.0f)), ang = (float)pos * inv;
        rc[i] = cosf(ang); rs[i] = sinf(ang); }
}

struct RowVec { f32x4 v[4]; };
__device__ __forceinline__ void ld_vec(const float* p, int lane, RowVec& r) {
#pragma unroll
    for (int j = 0; j < 4; ++j) r.v[j] = *(const GAS f32x4*)(p + 4 * lane + 256 * j);
}
__device__ __forceinline__ void ld_row_f32(const float* p, int lane, f32x4 (&v)[4]) {
#pragma unroll
    for (int j = 0; j < 4; ++j) v[j] = *(const GAS f32x4*)(p + 4 * lane + 256 * j);
}
__device__ __forceinline__ void st_row_f32(float* p, int lane, const f32x4 (&v)[4]) {
#pragma unroll
    for (int j = 0; j < 4; ++j) *(GAS f32x4*)(p + 4 * lane + 256 * j) = v[j];
}
__device__ __forceinline__ void ld_row_bf16raw(const bf16_t* p, int lane, u32x2 (&w)[4]) {
#pragma unroll
    for (int j = 0; j < 4; ++j) w[j] = *(const GAS u32x2*)(p + 4 * lane + 256 * j);
}
typedef _Float16 h16x2 __attribute__((ext_vector_type(2)));
__device__ __forceinline__ void ld_row_f16raw(const _Float16* p, int lane, u32x2 (&w)[4]) {
#pragma unroll
    for (int j = 0; j < 4; ++j) w[j] = *(const GAS u32x2*)(p + 4 * lane + 256 * j);
}
__device__ __forceinline__ f32x4 h4(u32x2 w) { const unsigned wx = w.x, wy = w.y;
    const h16x2 a = __builtin_bit_cast(h16x2, wx), b = __builtin_bit_cast(h16x2, wy); return (f32x4){(float)a[0], (float)a[1], (float)b[0], (float)b[1]}; }
__device__ __forceinline__ void st_row_f16(_Float16* p, int lane, const f32x4 (&v)[4]) {
#pragma unroll
    for (int j = 0; j < 4; ++j) { const h16x2 a = {(_Float16)v[j][0], (_Float16)v[j][1]}, b = {(_Float16)v[j][2], (_Float16)v[j][3]};
        u32x2 w; w.x = __builtin_bit_cast(unsigned, a); w.y = __builtin_bit_cast(unsigned, b); *(GAS u32x2*)(p + 4 * lane + 256 * j) = w; }
}
__device__ __forceinline__ f32x4 fp8x4(unsigned w) { const f32x2 lo = __builtin_amdgcn_cvt_pk_f32_fp8((int)w, false), hi = __builtin_amdgcn_cvt_pk_f32_fp8((int)w, true); return (f32x4){lo[0], lo[1], hi[0], hi[1]}; }
__device__ __forceinline__ f32x4 bf4(u32x2 w) { return (f32x4){bflo(w.x), bfhi(w.x), bflo(w.y), bfhi(w.y)}; }
__device__ __forceinline__ void st_row_bf16(bf16_t* p, int lane, const f32x4 (&v)[4]) {
#pragma unroll
    for (int j = 0; j < 4; ++j) { u32x2 w; w.x = cvt_pk_bf16(v[j][0], v[j][1]); w.y = cvt_pk_bf16(v[j][2], v[j][3]); *(GAS u32x2*)(p + 4 * lane + 256 * j) = w; }
}
__device__ __forceinline__ void ln_stats(const f32x4 (&v)[4], float& mean, float& rstd) {
    float s = 0.f, q = 0.f;
#pragma unroll
    for (int j = 0; j < 4; ++j) { s += (v[j][0] + v[j][1]) + (v[j][2] + v[j][3]); q += (v[j][0] * v[j][0] + v[j][1] * v[j][1]) + (v[j][2] * v[j][2] + v[j][3] * v[j][3]); }
    wave_sum2(s, q);
    mean = s * (1.0f / D);
    rstd = 1.0f / sqrtf(fmaxf(q * (1.0f / D) - mean * mean, 0.f) + LN_EPS);
}
__device__ __forceinline__ const float* xsrc_row(const Frame& F, int l, int m) {
    (void)l; return m < RL ? F_x + (size_t)m * D : F_ctx + (size_t)(m - RL) * D;
}

constexpr int CW_CIA = 8192;
__device__ __forceinline__ void row_segment(const Frame& F, int nc, int nrows, int seg, int& m0, int& m1) {
    if (nc == 0) { const int gw = F.vcu * NWAVES + F.wave, NGW = F.G * NWAVES, per = (nrows + NGW - 1) / NGW; m0 = seg == 0 ? nrows : gw * per; m1 = seg == 0 ? nrows : min(nrows, m0 + per); return; }
    const int wid = (F.vcu - nc) * NWAVES + F.wave, NW = (F.G - nc) * NWAVES;
    if (seg == 0) { m0 = RL + wid; m1 = (nrows > RL && m0 < R) ? m0 + 1 : m0; }
    else { const int per = (RL + NW - 1) / NW; m0 = wid * per; m1 = min(RL, m0 + per); }
}
__device__ __forceinline__ void cia_publish(const Frame& F, int nc, int which) {
    asm volatile("s_waitcnt vmcnt(0)" ::: "memory");
    __syncthreads();
    if (F.tid_() == 0) { const int w0 = (F.vcu - nc) * NWAVES, cnt = min(max(RC - w0, 0), NWAVES);
        if (cnt > 0) { __builtin_amdgcn_fence(__ATOMIC_RELEASE, "agent"); asm volatile("s_waitcnt vmcnt(0)" ::: "memory");
            __hip_atomic_fetch_add((unsigned*)(F.ws + WS_CTL) + CW_CIA + 64 * which, (unsigned)cnt, __ATOMIC_RELAXED, __HIP_MEMORY_SCOPE_AGENT); } }
}
__device__ __forceinline__ void cia_wait(const Frame& F, int which) {
    if (F.tid_() == 0) { unsigned* p = (unsigned*)(F.ws + WS_CTL) + CW_CIA + 64 * which; unsigned sp = 0;
        while (__hip_atomic_load(p, __ATOMIC_RELAXED, __HIP_MEMORY_SCOPE_AGENT) < (unsigned)RC) { __builtin_amdgcn_s_sleep(2); if (++sp > (1u << 24)) break; }
        __builtin_amdgcn_fence(__ATOMIC_ACQUIRE, "agent"); asm volatile("s_waitcnt vmcnt(0)" ::: "memory"); }
    __syncthreads();
}

__device__ __forceinline__ void phase_h0(Frame& F, bf16_t* H, int nc) {
    int cur = -1; RowVec sh, sc; f32x4 xa0[4], xa1[4], xb0[4], xb1[4];
#pragma unroll 1
    for (int seg = 0; seg < 2; ++seg) {
        int m0, m1; row_segment(F, nc, R, seg, m0, m1);
        if (m0 < m1) {
#pragma unroll
            for (int j = 0; j < 4; ++j) { xa0[j] = (f32x4){0.f, 0.f, 0.f, 0.f}; xa1[j] = xa0[j]; xb0[j] = xa0[j]; xb1[j] = xa0[j]; }
#pragma unroll 1
            for (int m = m0 - 2; m < m1; m += 2) {
                if (m >= m0) { const int cd = row_cond(m), cd1 = (m + 1 < m1) ? row_cond(m + 1) : cd;
                    if (cd != cur) { cur = cd; ld_vec(modp(F, 0, cd, 0), F.lane, sh); ld_vec(modp(F, 0, cd, 1), F.lane, sc);
                        asm volatile("" :: "v"(sh.v[0]), "v"(sh.v[1]), "v"(sh.v[2]), "v"(sh.v[3]), "v"(sc.v[0]), "v"(sc.v[1]), "v"(sc.v[2]), "v"(sc.v[3])); }
                    (void)cd1; }
                if (m + 2 < m1) ld_row_f32(xsrc_row(F, 0, m + 2), F.lane, xb0);
                if (m + 3 < m1) ld_row_f32(xsrc_row(F, 0, m + 3), F.lane, xb1);
                if (m >= m0) {
                    { float mean, rstd; ln_stats(xa0, mean, rstd); f32x4 h[4];
#pragma unroll
                      for (int j = 0; j < 4; ++j) h[j] = ((xa0[j] - mean) * rstd) * (sc.v[j] + 1.0f) + sh.v[j];
                      st_row_bf16(H + (size_t)m * D, F.lane, h); }
                    if (m + 1 < m1) {
                        const int cd1 = row_cond(m + 1);
                        if (cd1 != cur) { cur = cd1; ld_vec(modp(F, 0, cd1, 0), F.lane, sh); ld_vec(modp(F, 0, cd1, 1), F.lane, sc);
                            asm volatile("" :: "v"(sh.v[0]), "v"(sh.v[1]), "v"(sh.v[2]), "v"(sh.v[3]), "v"(sc.v[0]), "v"(sc.v[1]), "v"(sc.v[2]), "v"(sc.v[3])); }
                        float mean, rstd; ln_stats(xa1, mean, rstd); f32x4 h[4];
#pragma unroll
                        for (int j = 0; j < 4; ++j) h[j] = ((xa1[j] - mean) * rstd) * (sc.v[j] + 1.0f) + sh.v[j];
                        st_row_bf16(H + (size_t)(m + 1) * D, F.lane, h); }
                }
                __builtin_amdgcn_sched_barrier(0);
#pragma unroll
                for (int j = 0; j < 4; ++j) { xa0[j] = xb0[j]; xa1[j] = xb1[j]; }
                __builtin_amdgcn_sched_barrier(0);
            }
        }
        if (seg == 0 && nc > 0) cia_publish(F, nc, 0);
    }
}

typedef float f32x4_t __attribute__((ext_vector_type(4)));
constexpr int RP1_LD = 1028;
template <bool L0>
__device__ __forceinline__ void phase_rowpass1(Frame& F, int l, const bf16_t* O, unsigned char* H2, int nrows) {
    LAS float* Wl = (LAS float*)F.lds;
    LAS float* Hs = Wl + 16 * RP1_LD;
    LAS float* Pt = Hs + 16 * RP1_LD;
    { const f32x4* wr4 = (const f32x4*)(F_w_router + (size_t)l * D * NE); f32x4 t[8];
#pragma unroll
      for (int k = 0; k < 8; ++k) t[k] = wr4[F.tid_() + k * NTHR];
#pragma unroll
      for (int k = 0; k < 8; ++k) { const int i = 4 * (F.tid_() + k * NTHR);
#pragma unroll
          for (int q = 0; q < 4; ++q) Wl[((i & 15) + q) * RP1_LD + (i >> 4)] = t[k][q]; } }
    __syncthreads();
    const int lane = F.lane, wv = F.wave;
    const int perwg = (nrows + F.G - 1) / F.G, r0 = F.vcu * perwg, r1 = min(nrows, r0 + perwg);
    const int niter = r0 < r1 ? 2 * ((r1 - r0 + 15) / 16) : 0;
    _Float16* XA = (_Float16*)(F.ws + WS_XA); int* inv = (int*)(F.ws + WS_INV);
    RowVec lg, lb, g1, sh2, sc2;
    ld_vec(F_ln1_g + (size_t)l * D, lane, lg); ld_vec(F_ln1_b + (size_t)l * D, lane, lb);
    int cur = -1;
    f32x4 xa[4], xb[4]; u32x2 ha[4], hb[4]; u32x2 oa[4], ob[4];
#define RP1_LOAD(X, H_, O_, m_) do { if ((m_) < r1) { if (L0) ld_row_f32(xsrc_row(F, 0, (m_)), lane, X); else ld_row_f16raw(XA + (size_t)(m_) * D, lane, H_); ld_row_bf16raw(O + (size_t)(m_) * D, lane, O_); } } while (0)
#pragma unroll 1
    for (int it = -1; it < niter; ++it) {
        const int m = r0 + 8 * it + wv;
        if (it >= 0 && m < r1) { const int cd = row_cond(m); if (cd != cur) { cur = cd; ld_vec(modp(F, l, cd, 2), lane, g1); ld_vec(modp(F, l, cd, 3), lane, sh2); ld_vec(modp(F, l, cd, 4), lane, sc2);
            asm volatile("" :: "v"(g1.v[0]), "v"(g1.v[1]), "v"(g1.v[2]), "v"(g1.v[3]), "v"(sh2.v[0]), "v"(sh2.v[1]), "v"(sh2.v[2]), "v"(sh2.v[3]), "v"(sc2.v[0]), "v"(sc2.v[1]), "v"(sc2.v[2]), "v"(sc2.v[3])); } }
        RP1_LOAD(xb, hb, ob, m + 8);
        LAS float* hrow = Hs + ((it & 1) * 8 + wv) * RP1_LD;
        if (it >= 0) {
        if (m < r1) {
            if (!L0) {
#pragma unroll
                for (int j = 0; j < 4; ++j) xa[j] = h4(ha[j]); }
            f32x4 v[4];
#pragma unroll
            for (int j = 0; j < 4; ++j) v[j] = xa[j] * ALPHA + g1.v[j] * bf4(oa[j]);
            float mean, rstd; ln_stats(v, mean, rstd);
#pragma unroll
            for (int j = 0; j < 4; ++j) v[j] = ((v[j] - mean) * rstd) * lg.v[j] + lb.v[j];
            st_row_f16(XA + (size_t)m * D, lane, v);
            ln_stats(v, mean, rstd);
#pragma unroll
            for (int j = 0; j < 4; ++j) { const f32x4 h = ((v[j] - mean) * rstd) * (sc2.v[j] + 1.0f) + sh2.v[j];
                *(GAS unsigned*)(H2 + (size_t)m * D + 4 * lane + 256 * j) = pk4_fp8(h[0], h[1], h[2], h[3]);
                *(LAS f32x4*)(hrow + 4 * lane + 256 * j) = h; }
        } else {
#pragma unroll
            for (int j = 0; j < 4; ++j) *(LAS f32x4*)(hrow + 4 * lane + 256 * j) = (f32x4){0.f, 0.f, 0.f, 0.f};
        }
        if (it & 1) {
            __syncthreads();
            f32x4_t acc = {0.f, 0.f, 0.f, 0.f};
            { const LAS float* ap = Hs + (lane & 15) * RP1_LD + 128 * wv + 4 * (lane >> 4); const LAS float* bp = Wl + (lane & 15) * RP1_LD + 128 * wv + 4 * (lane >> 4);
#pragma unroll
              for (int ks = 0; ks < 8; ++ks) { const f32x4 a = *(const LAS f32x4*)(ap + 16 * ks), w = *(const LAS f32x4*)(bp + 16 * ks);
#pragma unroll
                  for (int i = 0; i < 4; ++i) acc = __builtin_amdgcn_mfma_f32_16x16x4f32(a[i], w[i], acc, 0, 0, 0); } }
#pragma unroll
            for (int r = 0; r < 4; ++r) Pt[(wv * 16 + 4 * (lane >> 4) + r) * 16 + (lane & 15)] = acc[r];
            __syncthreads();
            const int t = F.tid_();
            if (t < 256) { const int ri = t >> 4, e = t & 15; float lgt = 0.f;
#pragma unroll
                for (int w8 = 0; w8 < 8; ++w8) lgt += Pt[(w8 * 16 + ri) * 16 + e];
                const float mx = row16_max(lgt), ex = expf(lgt - mx), den = row16_sum(ex), aff = ex / den;
                const int mr = r0 + 8 * (it - 1) + (ri & 7) + 8 * (ri >> 3);
                if (mr < r1) {
                    if (mr < RL) ((float*)(F.ws + WS_AFF))[((size_t)((mr >> 13) * 16 + e)) * SEQ + (mr & (SEQ - 1))] = aff;
                    else { const int mc = mr - RL; ((float*)(F.ws + WS_AFFC))[((size_t)((mc >> 8) * 16 + e)) * NCTX + (mc & (NCTX - 1))] = aff; }
                    inv[(size_t)mr * 16 + e] = -1; } }
        }
        }
        __builtin_amdgcn_sched_barrier(0);
#pragma unroll
        for (int j = 0; j < 4; ++j) { if (L0) xa[j] = xb[j]; else ha[j] = hb[j]; oa[j] = ob[j]; }
        __builtin_amdgcn_sched_barrier(0);
    }
#undef RP1_LOAD
    __syncthreads();
}

template <int PER>
__device__ __forceinline__ void topk_item(Frame& F, const float* aff, int nact, int cap, int rowbase, int slotbase, int e) {
    LAS unsigned* hist = (LAS unsigned*)F.lds;
    LAS unsigned* wt = hist + 256;
    LAS unsigned* ctl = wt + 16;
    int* rowidx = (int*)(F.ws + WS_RIDX) + e * EROWS; float* gatew = (float*)(F.ws + WS_GATEW) + e * EROWS; int* inv = (int*)(F.ws + WS_INV);
    const int tid = F.tid_(), lane = F.lane, wave = F.wave;
    const bool act = tid * PER < nact;
    unsigned key[PER];
    if constexpr (PER == 16) {
#pragma unroll
        for (int q = 0; q < 4; ++q) { const u32x4 w = *(const u32x4*)(aff + tid * 16 + q * 4); key[q * 4 + 0] = w.x; key[q * 4 + 1] = w.y; key[q * 4 + 2] = w.z; key[q * 4 + 3] = w.w; }
    } else {
        key[0] = act ? __builtin_bit_cast(unsigned, aff[tid]) : 0u;
    }
    unsigned prefix = 0u, mask = 0u, remaining = (unsigned)cap;
#pragma unroll 1
    for (int pass = 0; pass < 4; ++pass) {
        const int shift = 24 - 8 * pass;
        if (tid < 256) hist[tid] = 0u;
        __syncthreads();
        if (act) {
#pragma unroll
            for (int i = 0; i < PER; ++i) if ((key[i] & mask) == prefix) __hip_atomic_fetch_add(&hist[(key[i] >> shift) & 255u], 1u, __ATOMIC_RELAXED, __HIP_MEMORY_SCOPE_WORKGROUP);
        }
        __syncthreads();
        unsigned hv = 0u, sfx = 0u;
        if (tid < 256) { hv = hist[tid]; sfx = hv;
#pragma unroll
            for (int o = 1; o < 64; o <<= 1) { const unsigned t2 = lane_get(sfx, (lane + o) & 63); if (lane + o < 64) sfx += t2; }
            if (lane == 0) wt[wave] = sfx; }
        __syncthreads();
        if (tid < 256) { for (int w = wave + 1; w < 4; ++w) sfx += wt[w];
            if (sfx >= remaining && sfx - hv < remaining) { ctl[0] = (unsigned)tid; ctl[1] = remaining - (sfx - hv); } }
        __syncthreads();
        prefix |= ctl[0] << shift; mask |= 255u << shift; remaining = ctl[1];
        __syncthreads();
    }
    const unsigned T = prefix, need_eq = remaining;
    unsigned cgt = 0u, ceq = 0u;
    if (act) {
#pragma unroll
        for (int i = 0; i < PER; ++i) { cgt += key[i] > T ? 1u : 0u; ceq += key[i] == T ? 1u : 0u; }
    }
    unsigned v = cgt | (ceq << 16), inc = v;
#pragma unroll
    for (int o = 1; o < 64; o <<= 1) { const unsigned t2 = lane_get(inc, (lane - o) & 63); if (lane >= o) inc += t2; }
    if (lane == 63) wt[wave] = inc;
    __syncthreads();
    unsigned base = 0u, total = 0u;
    for (int w = 0; w < 8; ++w) { const unsigned t2 = wt[w]; if (w < wave) base += t2; total += t2; }
    unsigned pgt = (base + inc - v) & 0xffffu, peq = (base + inc - v) >> 16;
    const unsigned total_gt = total & 0xffffu;
    if (act) {
#pragma unroll
        for (int i = 0; i < PER; ++i) {
            int slot = -1;
            if (key[i] > T) { slot = (int)pgt; ++pgt; }
            else if (key[i] == T) { if (peq < need_eq) slot = (int)(total_gt + peq); ++peq; }
            if (slot >= 0) { const int n = tid * PER + i; rowidx[slotbase + slot] = rowbase + n; gatew[slotbase + slot] = __builtin_bit_cast(float, key[i]); inv[(size_t)(rowbase + n) * 16 + e] = slotbase + slot; }
        }
    }
    __syncthreads();
}
__device__ __forceinline__ void phase_topk(Frame& F, bool with_ctx) {
    const int nitems = with_ctx ? 128 : 64;
    for (int it = F.vcu; it < nitems; it += F.G) {
        if (it < 64) { const int b = it >> 4, e = it & 15;
            topk_item<16>(F, (const float*)(F.ws + WS_AFF) + (size_t)(b * 16 + e) * SEQ, SEQ, CAP_L, b * SEQ, b * CAP_L, e);
        } else { const int b = (it - 64) >> 4, e = it & 15;
            topk_item<1>(F, (const float*)(F.ws + WS_AFFC) + (size_t)(b * 16 + e) * NCTX, NCTX, CAP_C, RL + b * NCTX, 4096 + b * CAP_C, e);
            if (b == 0 && F.tid_() < 128) { ((int*)(F.ws + WS_RIDX))[e * EROWS + 4224 + F.tid_()] = 0; ((float*)(F.ws + WS_GATEW))[e * EROWS + 4224 + F.tid_()] = 0.f; }
        }
    }
}

template <bool L0>
__device__ __forceinline__ void phase_rowpass2(Frame& F, int l, const unsigned char* slab, bf16_t* Hn, int nrows, int nc) {
    const int lane = F.lane;
    _Float16* XA = (_Float16*)(F.ws + WS_XA); const int* inv = (const int*)(F.ws + WS_INV);
    RowVec lg, lb, g2, sh, sc;
    ld_vec(F_ln2_g + (size_t)l * D, lane, lg); ld_vec(F_ln2_b + (size_t)l * D, lane, lb);
    int cur = -1;
#pragma unroll 1
    for (int seg = 0; seg < 2; ++seg) {
    int m0, m1; row_segment(F, nc, nrows, seg, m0, m1);
    if (m0 < m1) {
    u32x2 ha[2][4], hb[2][4]; int inva[2] = {-1, -1}, invb[2] = {-1, -1}, invc[2] = {-1, -1};
    unsigned ya0[2][4], ya1[2][4], yb0[2][4], yb1[2][4];
#pragma unroll
    for (int q = 0; q < 2; ++q)
#pragma unroll
        for (int j = 0; j < 4; ++j) { ha[q][j] = (u32x2){0u, 0u}; hb[q][j] = (u32x2){0u, 0u}; ya0[q][j] = 0u; ya1[q][j] = 0u; yb0[q][j] = 0u; yb1[q][j] = 0u; }
#pragma unroll 1
    for (int m = m0 - 4; m < m1; m += 2) {
        if (m >= m0) { const int cd = row_cond(m);
            if (cd != cur) { cur = cd; ld_vec(modp(F, l, cd, 5), lane, g2);
                if (L0) { ld_vec(modp(F, 1, cd, 0), lane, sh); ld_vec(modp(F, 1, cd, 1), lane, sc);
                    asm volatile("" :: "v"(sh.v[0]), "v"(sh.v[1]), "v"(sh.v[2]), "v"(sh.v[3]), "v"(sc.v[0]), "v"(sc.v[1]), "v"(sc.v[2]), "v"(sc.v[3])); }
                asm volatile("" :: "v"(g2.v[0]), "v"(g2.v[1]), "v"(g2.v[2]), "v"(g2.v[3])); } }
#pragma unroll
        for (int q = 0; q < 2; ++q) { const int r = m + 4 + q; if (r < m1) invc[q] = (lane < 16) ? inv[(size_t)r * 16 + lane] : -1; }
#pragma unroll
        for (int q = 0; q < 2; ++q) { const int r = m + 2 + q;
            if (r >= m0 && r < m1) {
                ld_row_f16raw(XA + (size_t)r * D, lane, hb[q]);
                unsigned long long mk = __ballot(invb[q] >= 0);
                if (mk) { const int e0 = __builtin_ctzll(mk); mk &= mk - 1; const bool two = mk != 0ull; const int e1 = two ? __builtin_ctzll(mk) : e0;
                    const int s0 = __builtin_amdgcn_readlane(invb[q], e0), s1 = __builtin_amdgcn_readlane(invb[q], e1);
                    { const unsigned char* p0 = slab + ((size_t)e0 * EROWS + s0) * D + 4 * lane;
#pragma unroll
                      for (int j = 0; j < 4; ++j) yb0[q][j] = *(const GAS unsigned*)(p0 + 256 * j); }
                    if (two) { const unsigned char* p1 = slab + ((size_t)e1 * EROWS + s1) * D + 4 * lane;
#pragma unroll
                      for (int j = 0; j < 4; ++j) yb1[q][j] = *(const GAS unsigned*)(p1 + 256 * j); } }
            } }
#pragma unroll
        for (int q = 0; q < 2; ++q) { const int r = m + q;
        if (r >= m0 && r < m1) {
        if (q == 1) { const int cd1 = row_cond(r);
            if (cd1 != cur) { cur = cd1; ld_vec(modp(F, l, cd1, 5), lane, g2);
                if (L0) { ld_vec(modp(F, 1, cd1, 0), lane, sh); ld_vec(modp(F, 1, cd1, 1), lane, sc);
                    asm volatile("" :: "v"(sh.v[0]), "v"(sh.v[1]), "v"(sh.v[2]), "v"(sh.v[3]), "v"(sc.v[0]), "v"(sc.v[1]), "v"(sc.v[2]), "v"(sc.v[3])); }
                asm volatile("" :: "v"(g2.v[0]), "v"(g2.v[1]), "v"(g2.v[2]), "v"(g2.v[3])); } }
        f32x4 xa[4];
#pragma unroll
        for (int j = 0; j < 4; ++j) xa[j] = h4(ha[q][j]);
        f32x4 acc[4];
#pragma unroll
        for (int j = 0; j < 4; ++j) acc[j] = (f32x4){0.f, 0.f, 0.f, 0.f};
        unsigned long long msk = __ballot(inva[q] >= 0);
        if (msk) { msk &= msk - 1; const bool two = msk != 0ull; if (two) msk &= msk - 1;
#pragma unroll
            for (int j = 0; j < 4; ++j) acc[j] += fp8x4(ya0[q][j]);
            if (two) {
#pragma unroll
                for (int j = 0; j < 4; ++j) acc[j] += fp8x4(ya1[q][j]); } }
#pragma unroll 1
        while (msk) {
            const int e0 = __builtin_ctzll(msk); msk &= msk - 1;
            const bool two = msk != 0ull; const int e1 = two ? __builtin_ctzll(msk) : e0; if (two) msk &= msk - 1;
            const int s0 = __builtin_amdgcn_readlane(inva[q], e0), s1 = __builtin_amdgcn_readlane(inva[q], e1);
            unsigned y0[4], y1[4];
            { const unsigned char* p0 = slab + ((size_t)e0 * EROWS + s0) * D + 4 * lane;
#pragma unroll
              for (int j = 0; j < 4; ++j) y0[j] = *(const GAS unsigned*)(p0 + 256 * j); }
            if (two) { const unsigned char* p1 = slab + ((size_t)e1 * EROWS + s1) * D + 4 * lane;
#pragma unroll
              for (int j = 0; j < 4; ++j) y1[j] = *(const GAS unsigned*)(p1 + 256 * j); }
#pragma unroll
            for (int j = 0; j < 4; ++j) acc[j] += fp8x4(y0[j]);
            if (two) {
#pragma unroll
                for (int j = 0; j < 4; ++j) acc[j] += fp8x4(y1[j]); }
        }
        f32x4 v[4];
#pragma unroll
        for (int j = 0; j < 4; ++j) v[j] = xa[j] * ALPHA + g2.v[j] * (acc[j] * 0.0625f);
        float mean, rstd; ln_stats(v, mean, rstd);
#pragma unroll
        for (int j = 0; j < 4; ++j) v[j] = ((v[j] - mean) * rstd) * lg.v[j] + lb.v[j];
        if (L0) st_row_f16(XA + (size_t)r * D, lane, v);
        else st_row_f32(F_out + (size_t)r * D, lane, v);
        if (L0) { ln_stats(v, mean, rstd); f32x4 h[4];
#pragma unroll
            for (int j = 0; j < 4; ++j) h[j] = ((v[j] - mean) * rstd) * (sc.v[j] + 1.0f) + sh.v[j];
            st_row_bf16(Hn + (size_t)r * D, lane, h); }
        } }
        __builtin_amdgcn_sched_barrier(0);
#pragma unroll
        for (int q = 0; q < 2; ++q) {
#pragma unroll
            for (int j = 0; j < 4; ++j) { ha[q][j] = hb[q][j]; ya0[q][j] = yb0[q][j]; ya1[q][j] = yb1[q][j]; }
            inva[q] = invb[q]; invb[q] = invc[q]; }
        __builtin_amdgcn_sched_barrier(0);
    }
    }
    if (seg == 0 && nc > 0) cia_publish(F, nc, 1);
    }
}

__device__ __forceinline__ void conv_unit_rows(int un, int& rowbase, int& t0, int& slen) {
    if (un < RL / 64) { const int b = un / (SEQ / 64); t0 = (un % (SEQ / 64)) * 64; rowbase = b * SEQ; slen = SEQ; }
    else { const int uc = un - RL / 64; const int b = uc / (NCTX / 64); t0 = (uc % (NCTX / 64)) * 64; rowbase = RL + b * NCTX; slen = NCTX; }
}
__device__ __forceinline__ void conv_fetch(const bf16_t* U, int un, int tid, u32x4 (&pf)[6]) {
    int rowbase, t0, slen; conv_unit_rows(un, rowbase, t0, slen);
#pragma unroll
    for (int q = 0; q < 6; ++q) { const int i = tid + q * NTHR, tt = i >> 5, c8 = (i & 31) * 8, t = t0 - 15 + tt;
        pf[q] = (u32x4){0u, 0u, 0u, 0u};
        if (tt < 94 && t >= 0 && t < slen) pf[q] = *(const GAS u32x4*)(U + (size_t)(rowbase + t) * INW + OFF_C + c8); }
}
__device__ __forceinline__ void phase_conv(Frame& F, int l, const bf16_t* U, bf16_t* MIX, bool with_ctx) {
    LAS float* g = (LAS float*)F.lds;
    const int nunits = (RL / 64) + (with_ctx ? RC / 64 : 0);
    const int ch = F.tid_() & 255, half = F.tid_() >> 8;
    float w[31];
    { const float* cw = F_conv_w + (size_t)l * 31 * 256;
#pragma unroll
      for (int j = 0; j < 31; ++j) w[j] = cw[j * 256 + ch]; }
    const float cb = F_conv_b[l * 256 + ch];
    const f32x4 lng = *(const f32x4*)(F_conv_ln_g + l * 256 + 4 * F.lane), lnb = *(const f32x4*)(F_conv_ln_b + l * 256 + 4 * F.lane);
    u32x4 pf[6];
    const int cv0 = F.G - 1 - F.vcu;
    if (cv0 < nunits) conv_fetch(U, cv0, F.tid_(), pf);
#pragma unroll 1
    for (int un = cv0; un < nunits; un += F.G) {
        int rowbase, t0, slen; conv_unit_rows(un, rowbase, t0, slen);
        __syncthreads();
#pragma unroll
        for (int q = 0; q < 6; ++q) { const int i = F.tid_() + q * NTHR, tt = i >> 5, c8 = (i & 31) * 8;
            if (tt < 94) { *(LAS f32x4*)(g + tt * 256 + c8) = (f32x4){bflo(pf[q].x), bfhi(pf[q].x), bflo(pf[q].y), bfhi(pf[q].y)};
                           *(LAS f32x4*)(g + tt * 256 + c8 + 4) = (f32x4){bflo(pf[q].z), bfhi(pf[q].z), bflo(pf[q].w), bfhi(pf[q].w)}; } }
        if (un + F.G < nunits) conv_fetch(U, un + F.G, F.tid_(), pf);
        __syncthreads();
        float out[32];
        { const LAS float* gp = g + (32 * half) * 256 + ch;
          float in[62];
#pragma unroll
          for (int i = 0; i < 62; ++i) in[i] = gp[i * 256];
#pragma unroll
          for (int t = 0; t < 32; ++t) { float sacc = cb;
#pragma unroll
              for (int j = 0; j < 31; ++j) sacc += w[j] * in[t + j];
              out[t] = sacc; } }
        __syncthreads();
#pragma unroll
        for (int t = 0; t < 32; ++t) g[(32 * half + t) * 256 + ch] = out[t];
        __syncthreads();
#pragma unroll 1
        for (int q = 0; q < 8; ++q) { const int tl = F.wave * 8 + q;
            const f32x4 v = *(const LAS f32x4*)(g + tl * 256 + 4 * F.lane);
            float s1 = (v[0] + v[1]) + (v[2] + v[3]), s2 = (v[0] * v[0] + v[1] * v[1]) + (v[2] * v[2] + v[3] * v[3]);
            wave_sum2(s1, s2);
            const float mean = s1 * (1.0f / 256.0f), rstd = 1.0f / sqrtf(fmaxf(s2 * (1.0f / 256.0f) - mean * mean, 0.f) + LN_EPS);
            f32x4 y = ((v - mean) * rstd) * lng + lnb;
#pragma unroll
            for (int i = 0; i < 4; ++i) y[i] = y[i] * __builtin_amdgcn_rcpf(1.0f + __builtin_amdgcn_exp2f(-y[i] * LOG2E));
            u32x2 o; o.x = cvt_pk_bf16(y[0], y[1]); o.y = cvt_pk_bf16(y[2], y[3]);
            *(GAS u32x2*)(MIX + (size_t)(rowbase + t0 + tl) * D + 768 + 4 * F.lane) = o; }
    }
    __syncthreads();
}

namespace att {
typedef float f32x16 __attribute__((ext_vector_type(16)));
typedef short s16x4 __attribute__((ext_vector_type(4)));
typedef short v4i16_t __attribute__((ext_vector_type(4)));
typedef float f32x2_t __attribute__((ext_vector_type(2)));
typedef __bf16 bf16x2_t __attribute__((ext_vector_type(2)));
constexpr int SLOTB = 16384, LDS_WS = 2 * SLOTB, LDS_OST = LDS_WS + 2048, LDS_BIAS = LDS_OST + 8 * 4096, LDS_ULIST = LDS_BIAS + 15 * 16 * 48 * 4, LDS_TOTAL = LDS_ULIST + 8192;
constexpr float THR = 8.0f;
__device__ __forceinline__ int crow(int r, int hi) { return (r & 3) + 8 * (r >> 2) + 4 * hi; }
__device__ __forceinline__ unsigned cvtpk_s(float lo, float hi) { f32x2_t v = {lo, hi}; bf16x2_t b = __builtin_convertvector(v, bf16x2_t); return __builtin_bit_cast(unsigned, b); }
__device__ __forceinline__ s16x4 vtr(const LAS unsigned char* p) { return __builtin_bit_cast(s16x4, __builtin_amdgcn_ds_read_tr16_b64_v4i16((LAS v4i16_t*)p)); }

struct AGeo { int qrow, qcol, kcol, vcol, ocol, nt, wrow0, jlo, R0, ctxrow0, alo, ahi, blk, hd, sinkh, ctxq; };
template <int TYPE>
__device__ __forceinline__ AGeo att_geo(int wid, int u) {
    AGeo g; int b, hd, blk; bool ctxq;
    if (TYPE == 0) { ctxq = u >= 1024; const int uc = u - 1024; b = ctxq ? uc >> 3 : u >> 8; hd = ctxq ? (uc >> 2) & 1 : (u >> 7) & 1; blk = ctxq ? uc & 3 : u & 127; }
    else { ctxq = u >= 512; const int uc = u - 512; b = ctxq ? uc >> 2 : u >> 7; hd = ctxq ? uc & 3 : (u >> 5) & 3; blk = ctxq ? 0 : u & 31; }
    if (TYPE == 0) { const int qh = hd * 4 + (wid >> 1); g.qcol = OFF_AQ + qh * 64; g.kcol = OFF_AK + hd * 64; g.vcol = OFF_AV + hd * 64; g.ocol = qh * 64; g.sinkh = qh;
        const int tok = 64 * blk + 32 * (wid & 1); g.qrow = ctxq ? RL + b * NCTX + tok : b * SEQ + tok; }
    else { g.qcol = OFF_BQ + hd * 64; g.kcol = OFF_BK + hd * 64; g.vcol = OFF_BV + hd * 64; g.ocol = 512 + hd * 64; g.sinkh = 0;
        const int tok = ctxq ? 32 * wid : (4 * blk + (wid >> 1)) * 64 + 32 * (wid & 1); g.qrow = ctxq ? RL + b * NCTX + tok : b * SEQ + tok; }
    int nwin = 0, wrow0 = 0, jlo = 0, R0 = 0;
    if (!ctxq) {
        if (TYPE == 0) { const int s0 = 64 * blk; jlo = s0 >= 128 ? 0 : (128 - s0) >> 6; const int jhi = min(4, (SEQ + 64 - s0) >> 6); nwin = jhi - jlo + 1; wrow0 = b * SEQ + s0 - 128 + 64 * jlo; }
        else { R0 = min(max(4 * blk - 4, 0), 120); const int R1 = min(max(4 * blk - 1, 0), 120) + 7; nwin = R1 - R0 + 1; wrow0 = b * SEQ + R0 * 64; }
    }
    g.nt = 4 + nwin; g.wrow0 = wrow0; g.jlo = jlo; g.R0 = R0; g.ctxrow0 = RL + b * NCTX; g.blk = blk; g.hd = hd; g.ctxq = ctxq ? 1 : 0;
    int alo = 4, ahi = g.nt;
    if (TYPE == 1 && !ctxq) { const int qg = 4 * blk + (wid >> 1), rs = min(max(qg - 4, 0), 120); alo = 4 + rs - R0; ahi = alo + 8; }
    g.alo = alo; g.ahi = ahi;
    return g;
}

template <int TYPE>
__device__ __forceinline__ void attn_stream(const Frame& F, int l, const bf16_t* U, bf16_t* MIX, LAS unsigned char* shm, int nun) {
    const int lane = F.lane, wid = F.wave;
    const LAS int* ul = (const LAS int*)(shm + LDS_ULIST) + 1;
    const char* Ub = (const char*)U;
    float NEGBIG = -1e30f; asm volatile("" : "+v"(NEGBIG));
    LAS float* wsf = (LAS float*)(shm + LDS_WS) + wid * 64;
#define ATT_TROW(G_, ti_) ((ti_) < 4 ? G_.ctxrow0 + 64 * (ti_) : G_.wrow0 + 64 * ((ti_) - 4))
#define ATT_DMA_K(G_, P_, ti_) __builtin_amdgcn_global_load_lds((const unsigned*)(Ub + (size_t)ATT_TROW(G_, ti_) * (INW * 2) + (unsigned)(ln_ * INW + G_.kcol + wid * 8) * 2u), (LAS unsigned*)(shm + (((ti_) + P_) & 1) * 8192 + wid * 1024), 16, 0, 0)
#define ATT_DMA_V(G_, P_, ti_) __builtin_amdgcn_global_load_lds((const unsigned*)(Ub + (size_t)ATT_TROW(G_, ti_) * (INW * 2) + (unsigned)((16 * (wid & 3) + (ln_ >> 2)) * INW + G_.vcol + (wid >> 2) * 32 + (ln_ & 3) * 8) * 2u), (LAS unsigned*)(shm + 16384 + (((ti_) + P_) & 1) * 8192 + wid * 1024), 16, 0, 0)
#define ATT_LOADQ(G_) do { const char* qb_ = Ub + (size_t)G_.qrow * (INW * 2); const unsigned qo_ = (unsigned)((ln_ & 31) * INW + G_.qcol + (ln_ >> 5) * 8) * 2u; \
        _Pragma("unroll") for (int d0 = 0; d0 < 4; ++d0) qr[d0] = *(const bf16x8*)(qb_ + qo_ + d0 * 32); } while (0)
    int par = 0, tblh = -1;
    bf16x8 qr[4];
    AGeo g = att_geo<TYPE>(wid, __builtin_amdgcn_readfirstlane(ul[0]));
    { const int ln_ = lane; ATT_DMA_K(g, par, 0); ATT_DMA_V(g, par, 0); ATT_DMA_K(g, par, 1); ATT_LOADQ(g); }
#pragma unroll 1
    for (int ui = 0; ui < nun; ++ui) {
        const bool hasn = ui + 1 < nun;
        const AGeo gn = att_geo<TYPE>(wid, __builtin_amdgcn_readfirstlane(ul[hasn ? ui + 1 : ui]));
        const int nt = g.nt, parn = (par + nt) & 1;
        if (TYPE == 1) { if (!g.ctxq && tblh != g.hd) { tblh = g.hd; const float* nb = F_nat_bias + (size_t)(l * 4 + g.hd) * 15 * 31; LAS float* bl = (LAS float*)(shm + LDS_BIAS); LAS float* raw = (LAS float*)(shm + LDS_ULIST + 4096);
            for (int i = F.tid_(); i < 15 * 31; i += NTHR) raw[i] = nb[i] * LOG2E;
            __syncthreads();
            for (int i = F.tid_(); i < 15 * 16 * 48; i += NTHR) { const int dr = i / 768, rem = i - dr * 768, dl_ = rem / 48, w = rem - dl_ * 48 - 16;
                bl[i] = (w >= 0 && w < 16) ? raw[dr * 31 + (w - dl_ + 15)] : -1e30f; } } }
        float sinkv = 0.f; if (TYPE == 0) sinkv = F_a_sink[l * 8 + g.sinkh] * LOG2E;
        float mrun = 0.f, lrun = 0.f; f32x16 o[2], pc0, pc1, negm;
#pragma unroll
        for (int r = 0; r < 16; ++r) { o[0][r] = 0.f; o[1][r] = 0.f; negm[r] = 0.f; }
        if (ui == 0) { asm volatile("s_waitcnt vmcnt(0) lgkmcnt(0)" ::: "memory"); __builtin_amdgcn_s_barrier(); asm volatile("" ::: "memory"); }
#define ATT_QK(P0, P1, ti_) do { const LAS unsigned char* kb = shm + (((ti_) + par) & 1) * 8192 + hi * 1024 + r32 * 16; \
        _Pragma("unroll") for (int d0 = 0; d0 < 4; ++d0) { const bf16x8 b0 = *(const LAS bf16x8*)(kb + d0 * 2048), b1 = *(const LAS bf16x8*)(kb + d0 * 2048 + 512); \
            if (d0 == 0) { P0 = __builtin_amdgcn_mfma_f32_32x32x16_bf16(b0, qr[0], negm, 0, 0, 0); P1 = __builtin_amdgcn_mfma_f32_32x32x16_bf16(b1, qr[0], negm, 0, 0, 0); } \
            else { P0 = __builtin_amdgcn_mfma_f32_32x32x16_bf16(b0, qr[d0], P0, 0, 0, 0); P1 = __builtin_amdgcn_mfma_f32_32x32x16_bf16(b1, qr[d0], P1, 0, 0, 0); } } } while (0)
        { int l0_ = lane; asm volatile("" : "+v"(l0_)); const int r32 = l0_ & 31, hi = l0_ >> 5; ATT_QK(pc0, pc1, 0); }
        asm volatile("s_waitcnt vmcnt(0) lgkmcnt(0)" ::: "memory"); __builtin_amdgcn_s_barrier(); asm volatile("" ::: "memory");
#pragma unroll 1
        for (int ti = 0; ti < nt; ++ti) {
            int ln_ = lane; asm volatile("" : "+v"(ln_));
            const int r32 = ln_ & 31, hi = ln_ >> 5;
            if (ti + 2 < nt) ATT_DMA_K(g, par, ti + 2);
            if (ti + 1 < nt) ATT_DMA_V(g, par, ti + 1);
            if (ti + 1 == nt && hasn) { ATT_DMA_K(gn, parn, 0); ATT_DMA_V(gn, parn, 0); ATT_DMA_K(gn, parn, 1); ATT_LOADQ(gn); }
            bf16x8 kf[8];
            { const LAS unsigned char* kb = shm + ((ti + 1 + par) & 1) * 8192 + hi * 1024 + r32 * 16;
#pragma unroll
              for (int d0 = 0; d0 < 4; ++d0) { kf[2 * d0] = *(const LAS bf16x8*)(kb + d0 * 2048); kf[2 * d0 + 1] = *(const LAS bf16x8*)(kb + d0 * 2048 + 512); } }
            __builtin_amdgcn_sched_barrier(0);
            const bool act = TYPE == 0 || ti < 4 || (ti >= g.alo && ti < g.ahi), actn = (ti + 1 < nt) && (TYPE == 0 || ti + 1 < 4 || (ti + 1 >= g.alo && ti + 1 < g.ahi));
            int mode = 0, aux = 0;
            if (ti >= 4) {
                if (TYPE == 0) { const int j = g.jlo + (ti - 4); if (j == 0 || j == 4) { mode = 1; aux = 64 * j - 128 - 32 * (wid & 1); } }
                else { mode = 2; aux = (g.R0 + (ti - 4)) - (4 * g.blk + (wid >> 1)) + 7; }
            }
            if (act) {
                if (mode == 1) {
                    const int dbase = aux - r32 + 4 * hi;
#pragma unroll
                    for (int r = 0; r < 16; ++r) { const int d0_ = dbase + (r & 3) + 8 * (r >> 2); if (abs(d0_) > 128) pc0[r] = NEGBIG; if (abs(d0_ + 32) > 128) pc1[r] = NEGBIG; }
                } else if (mode == 2) {
                    const int qc = 32 * (wid & 1) + r32, cs = min(max(qc - 8, 0), 48);
                    const LAS float* tb = (const LAS float*)(shm + LDS_BIAS) + aux * 768 + (qc - cs) * 48;
                    const int off = 16 - cs + 4 * hi;
#define ATT_TB(P, r, kadd) P[r] += tb[min(max(off + ((r) & 3) + 8 * ((r) >> 2) + (kadd), 0), 47)]
                    if ((wid & 1) == 0) {
#pragma unroll
                        for (int r = 0; r < 16; ++r) ATT_TB(pc0, r, 0);
#pragma unroll
                        for (int r = 0; r < 4; ++r) ATT_TB(pc1, r, 32);
#pragma unroll
                        for (int r = 4; r < 16; ++r) pc1[r] = NEGBIG;
                    } else {
#pragma unroll
                        for (int r = 0; r < 12; ++r) pc0[r] = NEGBIG;
#pragma unroll
                        for (int r = 12; r < 16; ++r) ATT_TB(pc0, r, 0);
#pragma unroll
                        for (int r = 0; r < 16; ++r) ATT_TB(pc1, r, 32);
                    }
#undef ATT_TB
                }
                float rm = fmaxf(fmaxf(pc0[0], pc0[1]), pc0[2]), rm1 = fmaxf(fmaxf(pc1[0], pc1[1]), pc1[2]);
#pragma unroll
                for (int r = 3; r < 15; r += 2) { rm = fmaxf(fmaxf(rm, pc0[r]), pc0[r + 1]); rm1 = fmaxf(fmaxf(rm1, pc1[r]), pc1[r + 1]); }
                rm = fmaxf(fmaxf(rm, pc0[15]), fmaxf(rm1, pc1[15]));
                if (ti == 0 || __any(rm > THR)) {
                    rm = max_halves(rm);
                    const float dl = (ti == 0) ? rm : fmaxf(rm, 0.f); mrun += dl;
#pragma unroll
                    for (int r = 0; r < 16; ++r) { pc0[r] -= dl; pc1[r] -= dl; negm[r] = -mrun; }
                    if (ti != 0) {
                        const float f = __builtin_amdgcn_exp2f(-dl); lrun *= f;
                        if (hi == 0) wsf[r32] = f;
#pragma unroll
                        for (int r = 0; r < 16; ++r) { const float fr_ = wsf[crow(r, hi)]; o[0][r] *= fr_; o[1][r] *= fr_; }
                    }
                }
            }
            u32x4 pw[4];
            if (act) {
                f32x2_t sa = {0.f, 0.f}, sb = {0.f, 0.f};
#pragma unroll
                for (int r = 0; r < 16; r += 2) { pc0[r] = __builtin_amdgcn_exp2f(pc0[r]); pc0[r + 1] = __builtin_amdgcn_exp2f(pc0[r + 1]); pc1[r] = __builtin_amdgcn_exp2f(pc1[r]); pc1[r + 1] = __builtin_amdgcn_exp2f(pc1[r + 1]);
                    sa += (f32x2_t){pc0[r], pc0[r + 1]}; sb += (f32x2_t){pc1[r], pc1[r + 1]}; }
                sa += sb; lrun += sa[0] + sa[1];
#pragma unroll
                for (int q = 0; q < 4; ++q) { pw[0][q] = cvtpk_s(pc0[2 * q], pc0[2 * q + 1]); pw[1][q] = cvtpk_s(pc0[8 + 2 * q], pc0[8 + 2 * q + 1]); pw[2][q] = cvtpk_s(pc1[2 * q], pc1[2 * q + 1]); pw[3][q] = cvtpk_s(pc1[8 + 2 * q], pc1[8 + 2 * q + 1]); }
                asm volatile("" : "+v"(pw[0]), "+v"(pw[1]), "+v"(pw[2]), "+v"(pw[3]), "+v"(lrun));
            }
            s16x4 vl[8], vh[8];
            if (act) {
                const LAS unsigned char* vp = shm + 16384 + ((ti + par) & 1) * 8192 + ((r32 >> 4) & 1) * 32 + (r32 & 3) * 8 + (4 * hi + ((r32 & 15) >> 2)) * 64;
#pragma unroll
                for (int d0 = 0; d0 < 2; ++d0)
#pragma unroll
                    for (int ks = 0; ks < 4; ++ks) { vl[d0 * 4 + ks] = vtr(vp + d0 * 4096 + ks * 1024); vh[d0 * 4 + ks] = vtr(vp + d0 * 4096 + ks * 1024 + 512); }
            }
            __builtin_amdgcn_sched_barrier(0);
            if (actn) {
#pragma unroll
                for (int d0 = 0; d0 < 4; ++d0) {
                    if (d0 == 0) { pc0 = __builtin_amdgcn_mfma_f32_32x32x16_bf16(kf[0], qr[0], negm, 0, 0, 0); pc1 = __builtin_amdgcn_mfma_f32_32x32x16_bf16(kf[1], qr[0], negm, 0, 0, 0); }
                    else { pc0 = __builtin_amdgcn_mfma_f32_32x32x16_bf16(kf[2 * d0], qr[d0], pc0, 0, 0, 0); pc1 = __builtin_amdgcn_mfma_f32_32x32x16_bf16(kf[2 * d0 + 1], qr[d0], pc1, 0, 0, 0); } }
            }
            if (act) {
#pragma unroll
                for (int d0 = 0; d0 < 2; ++d0)
#pragma unroll
                    for (int ks = 0; ks < 4; ++ks) { const s16x4 lo = vl[d0 * 4 + ks], hh = vh[d0 * 4 + ks];
                        const bf16x8 vf = (bf16x8){lo[0], lo[1], lo[2], lo[3], hh[0], hh[1], hh[2], hh[3]};
                        o[d0] = __builtin_amdgcn_mfma_f32_32x32x16_bf16(__builtin_bit_cast(bf16x8, pw[ks]), vf, o[d0], 0, 0, 0); }
            }
            asm volatile("s_waitcnt vmcnt(0) lgkmcnt(0)" ::: "memory"); __builtin_amdgcn_s_barrier(); asm volatile("" ::: "memory");
        }
        lrun = sum_halves(lrun);
        if (TYPE == 0) lrun += __builtin_amdgcn_exp2f(sinkv - mrun);
        int le_ = lane; asm volatile("" : "+v"(le_));
        const int r32 = le_ & 31, hi = le_ >> 5;
        if (hi == 0) wsf[32 + r32] = 1.0f / lrun;
        LAS bf16_t* stg3 = (LAS bf16_t*)(shm + LDS_OST) + wid * 2048;
        f32x4 rl4[4];
#pragma unroll
        for (int j = 0; j < 4; ++j) rl4[j] = *(const LAS f32x4*)(wsf + 32 + 8 * j + 4 * hi);
#pragma unroll
        for (int r = 0; r < 16; ++r) { const int orow = crow(r, hi); const float rl_ = rl4[r >> 2][r & 3];
            stg3[orow * 64 + r32] = (bf16_t)cvtpk_s(o[0][r] * rl_, 0.f); stg3[orow * 64 + 32 + r32] = (bf16_t)cvtpk_s(o[1][r] * rl_, 0.f); }
        asm volatile("s_waitcnt lgkmcnt(0)" ::: "memory");
        { char* ob_ = (char*)MIX + (size_t)g.qrow * (D * 2) + g.ocol * 2;
#pragma unroll
          for (int i = 0; i < 4; ++i) { const int row = i * 8 + (le_ >> 3), ch = le_ & 7; const u32x4 v = *(const LAS u32x4*)(stg3 + row * 64 + ch * 8); *(u32x4*)(ob_ + (unsigned)(row * D + ch * 8) * 2u) = v; } }
        asm volatile("s_waitcnt lgkmcnt(0)" ::: "memory");
        g = gn; par = parn;
    }
    __builtin_amdgcn_s_barrier(); asm volatile("" ::: "memory");
#undef ATT_DMA_K
#undef ATT_DMA_V
#undef ATT_TROW
#undef ATT_QK
#undef ATT_LOADQ
}
}

__device__ __forceinline__ void phase_attn(Frame& F, int l, const bf16_t* U, bf16_t* MIX, bool with_ctx) {
    LAS unsigned char* shm = F.lds;
    const int nA = 1024 + (with_ctx ? 32 : 0), nB = 512 + (with_ctx ? 16 : 0);
#ifndef DBG_MIX
#define DBG_MIX 0
#endif
    LAS int* ul = (LAS int*)(shm + att::LDS_ULIST);
    if (F.tid_() == 0) { int n = 0;
#pragma unroll 1
        for (int j = 0; j < ((DBG_MIX & 1) ? 10 : 5); ++j) { const int jj = j % 5;
#pragma unroll 1
            for (int ua = (jj < 4 ? F.vcu * 4 + jj : 1024 + F.vcu); ua < (jj < 4 ? min(1024, nA) : nA); ua += (jj < 4 ? F.G * 4 : F.G)) ul[1 + n++] = ua; }
        ul[0] = n; }
    __syncthreads();
    { const int n = __builtin_amdgcn_readfirstlane(ul[0]); if (n > 0) att::attn_stream<0>(F, l, U, MIX, shm, n); }
    __syncthreads();
    if (F.tid_() == 0) { int n = 0;
#pragma unroll 1
        for (int j = 0; j < ((DBG_MIX & 2) ? 6 : 3); ++j) { const int jj = j % 3;
#pragma unroll 1
            for (int ub = (jj < 2 ? F.vcu * 2 + jj : 512 + ((F.vcu + F.G - 32) % F.G)); ub < (jj < 2 ? min(512, nB) : nB); ub += (jj < 2 ? F.G * 2 : F.G)) ul[1 + n++] = ub; }
        ul[0] = n; }
    __syncthreads();
    { const int n = __builtin_amdgcn_readfirstlane(ul[0]); if (n > 0) att::attn_stream<1>(F, l, U, MIX, shm, n); }
    __syncthreads();
}


constexpr int NPHASE = 18;
__global__ void __launch_bounds__(NTHR, 2) hybrid_fwd(Args args) {
    extern __shared__ __attribute__((aligned(16))) unsigned char lds_raw[];
    Frame F;
    F.lds = (LAS unsigned char*)lds_raw;
    F.lane = threadIdx.x & 63; F.wave = __builtin_amdgcn_readfirstlane(threadIdx.x >> 6);
    F.G = gridDim.x; { const int bx = blockIdx.x; F.vcu = (F.G % 8 == 0) ? (bx % 8) * (F.G / 8) + bx / 8 : bx; }
    F.ws = args.ws;
    for (int u = F.tid_(); u < (LDS_BYTES - LDSCTL_OFF) / 4; u += NTHR) ((LAS unsigned*)(F.lds + LDSCTL_OFF))[u] = 0u;
    __syncthreads();
    if (F.tid_() < 24) ((LAS unsigned long long*)(F.lds + PTR_OFF))[F.tid_()] = ((const unsigned long long*)&args)[F.tid_()];
    __syncthreads();
    volatile LAS unsigned* MISC = (volatile LAS unsigned*)(F.lds + MISC_OFF);
    XcdBarrier bar; bar.bar = (unsigned*)(F.ws + WS_CTL) + CW_BAR; bar.x = 0; bar.st = nullptr;
    if (!MK_PER_PHASE) bar = xcd_barrier_post((unsigned*)(F.ws + WS_CTL) + CW_BAR, MISC + 8);
    const int lo = args.ph_lo, hi = args.ph_hi;
    const int wave0 = F.wave; LAS unsigned char* const lds_base = F.lds;
    bool repeated = false;
#pragma unroll 1
    for (int ph = lo; ph < hi; ++ph) {
        { unsigned char* w = (unsigned char*)inp(F, 23); asm volatile("" : "+s"(w)); F.ws = w;
          unsigned z_ = 0u; asm volatile("" : "+v"(z_));
          int w_ = wave0, l_ = (int)__builtin_amdgcn_mbcnt_hi(~0u, __builtin_amdgcn_mbcnt_lo(~0u, z_)); asm volatile("" : "+s"(w_), "+v"(l_)); F.wave = w_; F.lane = l_;
          unsigned lb_ = (unsigned)(uintptr_t)lds_base; asm volatile("" : "+s"(lb_)); F.lds = (LAS unsigned char*)(uintptr_t)lb_;
          int bx_ = blockIdx.x, g_ = gridDim.x; asm volatile("" : "+s"(bx_), "+s"(g_)); F.G = g_; F.bx = bx_; F.vcu = (g_ % 8 == 0) ? (bx_ % 8) * (g_ / 8) + bx_ / 8 : bx_; }
#ifndef DBG_REP
#define DBG_REP 0
#endif
        const int ptype = ph == 0 ? 8 : ph == 1 ? 9 : ((ph - 2) & 7);
        const bool cia = F.G >= 64;
        const int NC0 = cia ? 32 : 0, NC1 = cia ? 12 : 0;
        int inproj = 0, il = 0;
        const int l = ph >= 2 ? (ph - 2) >> 3 : 0, p = ph >= 2 ? (ph - 2) & 7 : -1;
        unsigned char* rA = F.ws + (l == 0 ? WS_P : WS_Q); unsigned char* rB = F.ws + (l == 0 ? WS_Q : WS_P);
        const bool wc = (l == 0);
        const int nrows = wc ? R : RL, mt = wc ? 17 : 16;
        if (ph == 0) { mod_items(F); __syncthreads(); rope_table(F);
            { int* rid = (int*)(F.ws + WS_RIDENT); for (int i = F.vcu * NTHR + F.tid_(); i < NE * EROWS; i += F.G * NTHR) rid[i] = i; }
            { const int nmod = F.G > 96 ? 48 : 0, cut = (CONV_NITEMS * 86) / 100;
              convert_weights(F, 0, 0, cut, F.vcu, F.G); if (F.vcu >= nmod) convert_weights(F, 0, cut, CONV_NITEMS, F.vcu - nmod, F.G - nmod); } }
        else if (ph == 1) { if (F.vcu >= NC0) phase_h0(F, (bf16_t*)(F.ws + WS_P), NC0); else { inproj = 2; il = 0; } }
        else if (p == 0) { inproj = 1; il = l; }
        else if (p == 1) {
            phase_attn(F, l, (const bf16_t*)rB, (bf16_t*)(rA + HALFREG), wc); phase_conv(F, l, (const bf16_t*)rB, (bf16_t*)(rA + HALFREG), wc);
        } else if (p == 2) {
            pg8::Gemm g{(const bf16_t*)(rA + HALFREG), (const bf16_t*)(F.ws + wsw(l, WS_WOUT)), D, nullptr}; pg8::TileOrder S; S.init(nrows / 256, D / 256, F.G, F.bx, 0);
            pg8::EpiBf16 E{(bf16_t*)rA, D};
            pg8::gemm_phase<pg8::EpiBf16, false, false>(F.tid_(), F.lds, F.lds + RIDX_OFF, g, S, E);
            if (l == 0) { const int nu = (nrows / 256) * (D / 256), nlast = nu - (nu / F.G) * F.G; if (F.bx >= nlast) { __syncthreads(); convert_weights(F, 1, 0, CONV_S1, F.bx - nlast, F.G - nlast); } }
        } else if (p == 3) { if (l == 0) phase_rowpass1<true>(F, l, (const bf16_t*)rA, rA + HALFREG, nrows); else phase_rowpass1<false>(F, l, (const bf16_t*)rA, rA + HALFREG, nrows);
        } else if (p == 4) { phase_topk(F, wc);
        } else if (p == 5) {
            pg8::Gemm g{(const bf16_t*)(rA + HALFREG), (const bf16_t*)(F.ws + wsw(l, WS_WGU)), D, (const int*)(F.ws + WS_RIDX)}; pg8::TileOrder S; S.init(NE * mt, 8, F.G, F.bx, mt);
            pg8::EpiSwiGLU E{rB};
            pg8::gemm_phase<pg8::EpiSwiGLU, true, true>(F.tid_(), F.lds, F.lds + RIDX_OFF, g, S, E);
            if (l == 0) { const int nu = NE * mt * 8, nlast = nu - (nu / F.G) * F.G; if (nlast > 0 && F.bx >= nlast) { __syncthreads(); convert_weights(F, 1, CONV_S1, CONV_S2, F.bx - nlast, F.G - nlast); } }
        } else if (p == 6) {
            pg8::Gemm g{(const bf16_t*)rB, (const bf16_t*)(F.ws + wsw(l, WS_WD)), FF, (const int*)(F.ws + WS_RIDENT)}; pg8::TileOrder S; S.init(NE * mt, 4, F.G, F.bx, mt);
            pg8::EpiRowScale E{rA, (const float*)(F.ws + WS_GATEW), (const LAS float*)(F.lds + pg8::ROWVEC_OFF)};
            pg8::gemm_phase<pg8::EpiRowScale, true, true>(F.tid_(), F.lds, F.lds + RIDX_OFF, g, S, E);
            if (l == 0) { const int nu = NE * mt * 4, nlast = nu - (nu / F.G) * F.G; if (nlast > 0 && F.bx >= nlast) { __syncthreads(); convert_weights(F, 1, CONV_S2, CONV_NITEMS, F.bx - nlast, F.G - nlast); } }
        } else {
            if (l == 0 && F.vcu < NC1) { inproj = 3; il = 1; } else { if (l == 0) phase_rowpass2<true>(F, l, rA, (bf16_t*)rB, nrows, NC1); else phase_rowpass2<false>(F, l, rA, (bf16_t*)rB, nrows, 0); }
        }
        if (inproj) {
            unsigned char* hA = F.ws + (il == 0 ? WS_P : WS_Q); unsigned char* uB = F.ws + (il == 0 ? WS_Q : WS_P);
            pg8::Gemm g{(const bf16_t*)hA, (const bf16_t*)(F.ws + wsw(il, WS_WIN)), D, nullptr}; pg8::TileOrder S;
            if (inproj == 1) S.init((cia ? RL : R) / 256, INW / 256, F.G, F.bx, 0); else { S.init_special(inproj - 1, F.vcu); cia_wait(F, inproj - 2); }
            pg8::EpiInProj E{(bf16_t*)uB, (const float*)(F.ws + WS_ROPE), (const float*)(F.ws + WS_ROPE) + 128 * 16};
            pg8::gemm_phase<pg8::EpiInProj, false, false>(F.tid_(), F.lds, F.lds + RIDX_OFF, g, S, E);
        }
        if (DBG_REP && ((DBG_REP >> ptype) & 1) && !repeated) { repeated = true; __syncthreads(); --ph; continue; }
        repeated = false;
#ifdef DBG_BAR2
        if (ph + 1 < hi) xcd_barrier(bar);
#endif
        if (ph + 1 < hi) xcd_barrier(bar);
    }
}

extern "C" void kernel_launch(void* const* d_in, const int* in_sizes, int n_in, void* d_out, int out_size, void* d_ws, size_t ws_size, hipStream_t stream) {
    static int grid = 0;
    if (grid == 0) {
        if (n_in != 22 || out_size != RL * D || ws_size < WS_END) { fprintf(stderr, "kernel_launch: unexpected shapes (n_in %d out %d ws %zu)\n", n_in, out_size, ws_size); grid = -1; return; }
        int dev = 0, cus = 0, per_cu = 0;
        if (hipGetDevice(&dev) != hipSuccess || hipDeviceGetAttribute(&cus, hipDeviceAttributeMultiprocessorCount, dev) != hipSuccess) { grid = -1; return; }
        if (hipFuncSetAttribute((const void*)hybrid_fwd, hipFuncAttributeMaxDynamicSharedMemorySize, LDS_BYTES) != hipSuccess) { fprintf(stderr, "kernel_launch: hipFuncSetAttribute failed\n"); grid = -1; return; }
        if (hipOccupancyMaxActiveBlocksPerMultiprocessor(&per_cu, (const void*)hybrid_fwd, NTHR, LDS_BYTES) != hipSuccess || per_cu < 1) { fprintf(stderr, "kernel_launch: occupancy query says %d blocks/CU\n", per_cu); grid = -1; (void)hipGetLastError(); return; }
        grid = cus;
    }
    if (grid < 0) return;
    (void)hipMemsetAsync((char*)d_ws + WS_CTL, 0, CTL_ZERO_BYTES, stream);
    Args a{};
    for (int i = 0; i < 22; ++i) a.in[i] = (const float*)d_in[i];
    a.out = (float*)d_out; a.ws = (unsigned char*)d_ws;
#if MK_PER_PHASE
    for (int p = 0; p < NPHASE; ++p) { a.ph_lo = p; a.ph_hi = p + 1; hipLaunchKernelGGL(hybrid_fwd, dim3(grid), dim3(NTHR), LDS_BYTES, stream, a); }
#else
    a.ph_lo = 0; a.ph_hi = NPHASE;
    hipLaunchKernelGGL(hybrid_fwd, dim3(grid), dim3(NTHR), LDS_BYTES, stream, a);
#endif
}
```

```cpp
#include <hip/hip_runtime.h>
#include <cstdio>
#include <cstdint>

#ifndef MK_PER_PHASE
#define MK_PER_PHASE 0
#endif

#define LAS __attribute__((address_space(3)))
#define GAS __attribute__((address_space(1)))
typedef unsigned short bf16_t;
typedef short bf16x8 __attribute__((ext_vector_type(8)));
typedef float f32x4 __attribute__((ext_vector_type(4)));
typedef float f32x2 __attribute__((ext_vector_type(2)));
typedef unsigned u32x4 __attribute__((ext_vector_type(4)));
typedef unsigned u32x2 __attribute__((ext_vector_type(2)));

constexpr int D = 1024, NB = 4, SEQ = 8192, NCTX = 256, RL = NB * SEQ, RC = NB * NCTX, R = RL + RC;
constexpr int INW = 2048, NE = 16, FF = 1024;
constexpr int OFF_AQ = 0, OFF_AK = 512, OFF_AV = 640, OFF_BQ = 768, OFF_BK = 1024, OFF_BV = 1280, OFF_C = 1536;
constexpr int CAP_L = 1024, CAP_C = 32, EROWS = 4352, EMT = 17;
constexpr float LN_EPS = 1e-6f, ALPHA = 1.41421356237309515f;
constexpr float LOG2E = 1.4426950408889634f;
constexpr float C2 = 0.125f * LOG2E;

constexpr size_t MiB = 1u << 20;
constexpr size_t WS_CTL = 0, CTL_ZERO_BYTES = 1 * MiB;
constexpr size_t WS_MOD = 1 * MiB;
constexpr size_t WS_ROPE = 1 * MiB + 512 * 1024;
constexpr size_t WS_AFF = 2 * MiB;
constexpr size_t WS_AFFC = 4 * MiB;
constexpr size_t WS_INV = 5 * MiB;
constexpr size_t WS_RIDX = 8 * MiB;
constexpr size_t WS_GATEW = 8 * MiB + 512 * 1024;
constexpr size_t WS_RIDENT = 4 * MiB + 512 * 1024;
constexpr size_t WS_XC = 9 * MiB;
constexpr size_t WS_WIN = 13 * MiB;
constexpr size_t WS_WOUT = 17 * MiB;
constexpr size_t WS_WGU = 19 * MiB;
constexpr size_t WS_WD = 83 * MiB;
constexpr size_t WS_XA = 115 * MiB;
constexpr size_t WS_P = 247 * MiB;
constexpr size_t WS_Q = 383 * MiB;
constexpr size_t REGION = 136 * MiB, HALFREG = 68 * MiB;
constexpr size_t WS_W1 = 519 * MiB;
constexpr size_t WS_END = 573 * MiB;
__host__ __device__ constexpr size_t wsw(int l, size_t off) { return l == 0 ? off : (off == 13 * MiB ? WS_W1 : off == 17 * MiB ? WS_W1 + 4 * MiB : off == 19 * MiB ? WS_W1 + 6 * MiB : WS_W1 + 38 * MiB); }
constexpr int CW_BAR = 4096;

constexpr int RING_BYTES = 131072;
constexpr int RIDX_OFF = 143360;
constexpr int LDSCTL_OFF = RIDX_OFF + 2048, MISC_OFF = LDSCTL_OFF + 320, PTR_OFF = LDSCTL_OFF + 512;
constexpr int LDS_BYTES = 147456;
constexpr int NWAVES = 8, NTHR = 512;

__device__ __forceinline__ unsigned f2bf(float f) { unsigned u = __builtin_bit_cast(unsigned, f); return (u + 0x7fffu + ((u >> 16) & 1u)) >> 16; }
__device__ __forceinline__ unsigned pk2(float lo, float hi) { return f2bf(lo) | (f2bf(hi) << 16); }
__device__ __forceinline__ float bf2f(unsigned short b) { return __builtin_bit_cast(float, (unsigned)b << 16); }
__device__ __forceinline__ float bflo(unsigned w) { return __builtin_bit_cast(float, w << 16); }
__device__ __forceinline__ float bfhi(unsigned w) { return __builtin_bit_cast(float, w & 0xffff0000u); }
__device__ __forceinline__ unsigned pk4_fp8(float a, float b, float c, float d) { int w = 0; w = __builtin_amdgcn_cvt_pk_fp8_f32(a, b, w, false); w = __builtin_amdgcn_cvt_pk_fp8_f32(c, d, w, true); return (unsigned)w; }
__device__ __forceinline__ unsigned cvt_pk_bf16(float lo, float hi) { unsigned r; asm volatile("v_cvt_pk_bf16_f32 %0, %1, %2" : "=v"(r) : "v"(lo), "v"(hi)); return r; }
template <int O> __device__ __forceinline__ float swz_xor(float v) { return __builtin_bit_cast(float, __builtin_amdgcn_ds_swizzle(__builtin_bit_cast(int, v), (O << 10) | 0x1f)); }
__device__ __forceinline__ void swap_halves(float v, float& lo_everywhere, float& hi_everywhere) {
    unsigned a = __builtin_bit_cast(unsigned, v), b = a;
    asm volatile("s_nop 1\n\tv_permlane32_swap_b32 %0, %1\n\ts_nop 0" : "+v"(a), "+v"(b));
    lo_everywhere = __builtin_bit_cast(float, a); hi_everywhere = __builtin_bit_cast(float, b);
}
__device__ __forceinline__ float sum_halves(float v) { float x, y; swap_halves(v, x, y); return x + y; }
__device__ __forceinline__ float max_halves(float v) { float x, y; swap_halves(v, x, y); return fmaxf(x, y); }
__device__ __forceinline__ float other_half(float v, int hi) { float x, y; swap_halves(v, x, y); return hi ? x : y; }
template <int CTRL> __device__ __forceinline__ float dppf(float v) { return __builtin_bit_cast(float, __builtin_amdgcn_update_dpp(0, __builtin_bit_cast(int, v), CTRL, 0xf, 0xf, true)); }
__device__ __forceinline__ float row16_sum(float v) { v += dppf<0xB1>(v); v += dppf<0x4E>(v); v += dppf<0x141>(v); v += dppf<0x140>(v); return v; }
__device__ __forceinline__ float row16_max(float v) { v = fmaxf(v, dppf<0xB1>(v)); v = fmaxf(v, dppf<0x4E>(v)); v = fmaxf(v, dppf<0x141>(v)); v = fmaxf(v, dppf<0x140>(v)); return v; }
__device__ __forceinline__ float wave_sum(float v) { v = row16_sum(v); v += swz_xor<16>(v); return sum_halves(v); }
__device__ __forceinline__ void wave_sum2(float& a, float& b) {
    a = row16_sum(a); b = row16_sum(b); const float a2 = swz_xor<16>(a), b2 = swz_xor<16>(b); a += a2; b += b2; a = sum_halves(a); b = sum_halves(b);
}
__device__ __forceinline__ unsigned lane_get(unsigned v, int srclane) { return (unsigned)__builtin_amdgcn_ds_bpermute(srclane << 2, (int)v); }
#define LDS_WAIT() asm volatile("s_waitcnt lgkmcnt(0)" ::: "memory")
#define VM_WAIT() asm volatile("s_waitcnt vmcnt(0)" ::: "memory")

#define XB_TMO      128
#define XB_XCNT(j)  (256  + 64 * (j))
#define XB_XSUB(j)  (1280 + 64 * (j))
#define XB_XGEN(j)  (2304 + 64 * (j))
#define XB_TOP      3328
#define XB_TOPGEN   3392
#define XCD_BAR_WORDS 3456
#define XB_SPIN_CAP (1u << 24)
__device__ __forceinline__ unsigned xb_ld(unsigned* p)              { return __hip_atomic_load(p, __ATOMIC_RELAXED, __HIP_MEMORY_SCOPE_AGENT); }
__device__ __forceinline__ unsigned xb_add(unsigned* p, unsigned v) { return __hip_atomic_fetch_add(p, v, __ATOMIC_RELAXED, __HIP_MEMORY_SCOPE_AGENT); }
__device__ __forceinline__ unsigned xb_xcc_id() { return (unsigned)__builtin_amdgcn_s_getreg((3 << 11) | 20) & 0xFu; }
#define XB_SPIN(cond, bar) do { unsigned _sp = 0; while (cond) { __builtin_amdgcn_s_sleep(1); \
    if ((++_sp & 255u) == 0u) { if (xb_ld(&(bar)[XB_TMO])) break; if (_sp > XB_SPIN_CAP) { atomicAdd(&(bar)[XB_TMO], 1u); break; } } } } while (0)
struct XcdBarrier { unsigned* bar; unsigned x; volatile LAS unsigned* st; };
__device__ __forceinline__ XcdBarrier xcd_barrier_post(unsigned* bar, volatile LAS unsigned* st) {
    XcdBarrier b; b.bar = bar; b.x = xb_xcc_id(); b.st = st;
    if (threadIdx.x == 0) (void)xb_add(&bar[XB_XCNT(b.x)], 1u);
    return b;
}
__device__ __forceinline__ int xb_row16_isum(int v) {
    v += __builtin_amdgcn_update_dpp(0, v, 0xB1, 0xf, 0xf, true); v += __builtin_amdgcn_update_dpp(0, v, 0x4E, 0xf, 0xf, true);
    v += __builtin_amdgcn_update_dpp(0, v, 0x141, 0xf, 0xf, true); v += __builtin_amdgcn_update_dpp(0, v, 0x140, 0xf, 0xf, true); return v;
}
__device__ __forceinline__ void xcd_barrier_complete_w0(unsigned* bar, unsigned x, unsigned& nloc, unsigned& nx) {
    const unsigned G = gridDim.x * gridDim.y * gridDim.z;
    const unsigned ln = threadIdx.x & 63u;
    unsigned c = 0u, sp = 0u;
    for (;;) {
        c = (ln < 16u) ? xb_ld(&bar[XB_XCNT(ln)]) : 0u;
        const unsigned sum = (unsigned)__builtin_amdgcn_readfirstlane(xb_row16_isum((int)c));
        if (sum == G) break;
        __builtin_amdgcn_s_sleep(1);
        if ((++sp & 255u) == 0u) { if (xb_ld(&bar[XB_TMO])) break; if (sp > XB_SPIN_CAP) { if (ln == 0u) atomicAdd(&bar[XB_TMO], 1u); break; } }
    }
    const unsigned cnt = (unsigned)__builtin_popcountll(__ballot(c > 0u));
    const unsigned mine = (unsigned)__builtin_amdgcn_readlane((int)c, (int)x);
    nloc = mine > 0u ? mine : 1u; nx = cnt > 0u ? cnt : 1u;
}
__device__ __forceinline__ void xcd_barrier(const XcdBarrier& b) {
    asm volatile("s_waitcnt vmcnt(0)" ::: "memory");
    __syncthreads();
    if (threadIdx.x < 64) {
        unsigned* bar = b.bar; unsigned bx_ = b.x; asm volatile("" : "+s"(bar), "+s"(bx_));
        __builtin_amdgcn_s_waitcnt(0);
        unsigned nloc = b.st[0], nx = b.st[1];
        if (nloc == 0u) { xcd_barrier_complete_w0(bar, bx_, nloc, nx); if (threadIdx.x == 0) { b.st[0] = nloc; b.st[1] = nx; } }
        if (threadIdx.x == 0) {
        const unsigned old = xb_add(&bar[XB_XSUB(bx_)], 1u);
        const unsigned gen = old / nloc;
        if (old + 1u == (gen + 1u) * nloc) {
            __builtin_amdgcn_fence(__ATOMIC_RELEASE, "agent");
            asm volatile("s_waitcnt vmcnt(0)" ::: "memory");
            const unsigned og = xb_add(&bar[XB_TOP], 1u);
            const unsigned tg = og / nx;
            if (og + 1u == (tg + 1u) * nx) xb_add(&bar[XB_TOPGEN], 1u);
            else XB_SPIN(xb_ld(&bar[XB_TOPGEN]) == tg, bar);
            __builtin_amdgcn_fence(__ATOMIC_ACQUIRE, "agent");
            xb_add(&bar[XB_XGEN(bx_)], 1u);
            asm volatile("s_waitcnt vmcnt(0)" ::: "memory");
        } else {
            XB_SPIN(xb_ld(&bar[XB_XGEN(bx_)]) == gen, bar);
            __builtin_amdgcn_fence(__ATOMIC_ACQUIRE, "agent");
            asm volatile("s_waitcnt vmcnt(0)" ::: "memory");
        }
        }
    }
    __syncthreads();
}

namespace pg8 {
constexpr int BM = 256, BK = 64, HALF = 128, HTB = HALF * BK * 2, STAGE_BYTES = 8 * HTB, NXCD = 8, WGM = 8, ROWVEC_OFF = STAGE_BYTES;
__host__ __device__ constexpr __forceinline__ int lds_byte(int r, int c) { const int st = (r >> 4) * 2 + (c >> 5), rr = r & 15, cc = c & 31, ob = rr * 64 + cc * 2; return st * 1024 + (ob ^ (((ob >> 9) & 1) << 5)); }
__host__ __device__ __forceinline__ void stage_rc(int b, int& Rr, int& C) { const int st = b / 1024, sb = b % 1024, swz = sb ^ (((sb >> 9) & 1) << 5); Rr = (st >> 1) * 16 + swz / 64; C = (st & 1) * 32 + (swz % 64) / 2; }
__host__ __device__ __forceinline__ int perm32(int rho) { const int n = rho >> 4, i = rho & 15; return 8 * (i >> 2) + 4 * n + (i & 3); }

struct Unit { int pm, pn, am, bn; };
struct Gemm { const bf16_t* A; const bf16_t* Bt; int K; const int* ridx; };

struct TileOrder {
    int nM, nN, nwg, G, c, mt, special, sidx;
    __device__ void init(int nM_, int nN_, int G_, int c_, int mt_) { nM = nM_; nN = nN_; nwg = nM * nN; G = G_; c = c_; mt = mt_; special = 0; sidx = 0; }
    __device__ void init_special(int kind, int idx) { nM = nN = nwg = G = 1; c = 0; mt = 0; special = kind; sidx = idx; }
    __device__ bool next(int i, Unit& u) const {
        int pm, pn, am, bn; bool ok;
        if (special) { ok = (i == 0); const int t = sidx >> 2; pm = am = RL / BM + (sidx & 3); pn = bn = (special == 1) ? t : (t == 0 ? 2 : 3 + t); }
        else {
            const long L = (long)i * G + c; ok = L < nwg;
            int wgid = ok ? (int)L : 0; { const int q = nwg / NXCD, r = nwg % NXCD, xcd = wgid % NXCD, off = wgid / NXCD; wgid = (xcd < r ? xcd * (q + 1) : r * (q + 1) + (xcd - r) * q) + off; }
            const int nig = WGM * nN, gid = wgid / nig, fm = gid * WGM, gsz = (nM - fm) < WGM ? (nM - fm) : WGM;
            pm = fm + ((wgid % nig) % gsz); pn = (wgid % nig) / gsz;
            if (mt > 0) { const int e = pm / mt; am = e * EMT + (pm - e * mt); bn = e * nN + pn; } else { am = pm; bn = pn; }
        }
        u.pm = pm; u.pn = pn; u.am = am; u.bn = bn;
        return ok;
    }
};

struct EpiBf16 {
    static constexpr bool ROWVEC = false;
    bf16_t* O; int ldc;
    __device__ __forceinline__ void operator()(const f32x4 (&acc)[2][2][4][2], const Unit& u, int wr, int wc, int fr, int fq, int ui) const {
        const int row0 = u.am * BM + wr * 64 + fr, col0 = u.pn * BM + wc * 32 + 8 * fq;
#pragma unroll
        for (int ai = 0; ai < 2; ++ai)
#pragma unroll
            for (int m = 0; m < 4; ++m) { bf16_t* rowp = O + (size_t)(row0 + ai * HALF + m * 16) * ldc + col0;
#pragma unroll
                for (int bj = 0; bj < 2; ++bj) { const f32x4 v0 = acc[ai][bj][m][0], v1 = acc[ai][bj][m][1];
                    u32x4 w; w.x = cvt_pk_bf16(v0[0], v0[1]); w.y = cvt_pk_bf16(v0[2], v0[3]); w.z = cvt_pk_bf16(v1[0], v1[1]); w.w = cvt_pk_bf16(v1[2], v1[3]);
                    *(u32x4*)(rowp + bj * HALF) = w; } }
    }
};
struct EpiInProj {
    static constexpr bool ROWVEC = false;
    bf16_t* O; const float* ropec; const float* ropes;
    __device__ __forceinline__ void operator()(const f32x4 (&acc)[2][2][4][2], const Unit& u, int wr, int wc, int fr, int fq, int ui) const {
        const int row0 = u.am * BM + wr * 64 + fr;
        if (u.pn >= 6) {
            const int col0 = OFF_C + (u.pn - 6) * HALF + wc * 32 + 8 * fq;
#pragma unroll
            for (int ai = 0; ai < 2; ++ai)
#pragma unroll
                for (int m = 0; m < 4; ++m) { bf16_t* rowp = O + (size_t)(row0 + ai * HALF + m * 16) * INW + col0;
                    float h[8];
#pragma unroll
                    for (int n = 0; n < 2; ++n)
#pragma unroll
                        for (int i = 0; i < 4; ++i) { const float a = acc[ai][0][m][n][i], g = acc[ai][1][m][n][i]; h[n * 4 + i] = a * __builtin_amdgcn_rcpf(1.0f + __builtin_amdgcn_exp2f(-g * LOG2E)); }
                    u32x4 w; w.x = cvt_pk_bf16(h[0], h[1]); w.y = cvt_pk_bf16(h[2], h[3]); w.z = cvt_pk_bf16(h[4], h[5]); w.w = cvt_pk_bf16(h[6], h[7]);
                    *(u32x4*)rowp = w; }
            return;
        }
        const int col0 = u.pn * BM + wc * 32 + 8 * fq;
        const bool latent = (u.am * BM) < RL;
        const float sc = (u.pn < 2 || u.pn == 3) ? C2 : 1.0f;
        const float sgn = (fq < 2) ? -1.0f : 1.0f;
        const int f0 = 8 * (fq & 1);
#pragma unroll
        for (int ai = 0; ai < 2; ++ai)
#pragma unroll
            for (int m = 0; m < 4; ++m) {
                const int row = row0 + ai * HALF + m * 16;
                bf16_t* rowp = O + (size_t)row * INW + col0;
                const int t = row & (SEQ - 1);
                const int pos = (wc & 1) ? (t & 63) : (t >> 6);
#pragma unroll
                for (int bj = 0; bj < 2; ++bj) {
                    f32x4 v0 = acc[ai][bj][m][0], v1 = acc[ai][bj][m][1];
                    const bool rope = latent && (u.pn < 2 || (u.pn == 2 && bj == 0));
                    if (rope) {
                        const f32x4 c0 = *(const f32x4*)(ropec + pos * 16 + f0), c1 = *(const f32x4*)(ropec + pos * 16 + f0 + 4);
                        const f32x4 s0 = *(const f32x4*)(ropes + pos * 16 + f0), s1 = *(const f32x4*)(ropes + pos * 16 + f0 + 4);
                        f32x4 p0, p1;
#pragma unroll
                        for (int i = 0; i < 4; ++i) { p0[i] = other_half(v0[i], fq >> 1); p1[i] = other_half(v1[i], fq >> 1); }
                        v0 = v0 * c0 + (p0 * s0) * sgn; v1 = v1 * c1 + (p1 * s1) * sgn;
                    }
                    v0 = v0 * sc; v1 = v1 * sc;
                    u32x4 w; w.x = cvt_pk_bf16(v0[0], v0[1]); w.y = cvt_pk_bf16(v0[2], v0[3]); w.z = cvt_pk_bf16(v1[0], v1[1]); w.w = cvt_pk_bf16(v1[2], v1[3]);
                    *(u32x4*)(rowp + bj * HALF) = w;
                }
            }
    }
};
struct EpiSwiGLU {
    static constexpr bool ROWVEC = false;
    unsigned char* O;
    __device__ __forceinline__ void operator()(const f32x4 (&acc)[2][2][4][2], const Unit& u, int wr, int wc, int fr, int fq, int ui) const {
        const int row0 = u.am * BM + wr * 64 + fr, col0 = u.pn * HALF + wc * 32 + 8 * fq;
#pragma unroll
        for (int ai = 0; ai < 2; ++ai)
#pragma unroll
            for (int m = 0; m < 4; ++m) { unsigned char* rowp = O + (size_t)(row0 + ai * HALF + m * 16) * FF + col0;
                float h[8];
#pragma unroll
                for (int n = 0; n < 2; ++n)
#pragma unroll
                    for (int i = 0; i < 4; ++i) { const float g = acc[ai][0][m][n][i], up = acc[ai][1][m][n][i];
                        const float sg = g * __builtin_amdgcn_rcpf(1.0f + __builtin_amdgcn_exp2f(-g * LOG2E)); h[n * 4 + i] = sg * up; }
                u32x2 w; w.x = pk4_fp8(h[0], h[1], h[2], h[3]); w.y = pk4_fp8(h[4], h[5], h[6], h[7]);
                *(u32x2*)rowp = w; }
    }
};
struct EpiRowScale {
    static constexpr bool ROWVEC = true;
    unsigned char* O; const float* gw; const LAS float* lgw;
    __device__ __forceinline__ void operator()(const f32x4 (&acc)[2][2][4][2], const Unit& u, int wr, int wc, int fr, int fq, int ui) const {
        const int row0 = u.am * BM + wr * 64 + fr, col0 = u.pn * BM + wc * 32 + 8 * fq;
#pragma unroll
        for (int ai = 0; ai < 2; ++ai)
#pragma unroll
            for (int m = 0; m < 4; ++m) { const int row = row0 + ai * HALF + m * 16; const float g = lgw[(ui & 1) * BM + wr * 64 + fr + ai * HALF + m * 16] * 16.0f; unsigned char* rowp = O + (size_t)row * D + col0;
#pragma unroll
                for (int bj = 0; bj < 2; ++bj) { const f32x4 v0 = acc[ai][bj][m][0] * g, v1 = acc[ai][bj][m][1] * g;
                    u32x2 w; w.x = pk4_fp8(v0[0], v0[1], v0[2], v0[3]); w.y = pk4_fp8(v1[0], v1[1], v1[2], v1[3]);
                    *(u32x2*)(rowp + bj * HALF) = w; } }
    }
};

typedef int v8i_t __attribute__((ext_vector_type(8)));
template <class Epi, bool GATHER, bool FP8>
__device__ __forceinline__ void gemm_phase(const int tid, LAS unsigned char* lds, LAS unsigned char* lds_ridx, const Gemm g, const TileOrder& S, const Epi& E) {
    const int wid = __builtin_amdgcn_readfirstlane(tid >> 6), lane = tid & 63, wr = wid >> 2, wc = wid & 3, fr = lane & 15, fq = lane >> 4;
    constexpr int ESZ = FP8 ? 1 : 2;
    const int K = g.K, nt = K * ESZ / (BK * 2);
    int RA[2], CA[2]; unsigned voffB[2];
#pragma unroll
    for (int i = 0; i < 2; ++i) { int Rr, C; stage_rc(tid * 16 + i * 8192, Rr, C); const int Rb = (Rr & ~31) + perm32(Rr & 31);
        RA[i] = Rr; CA[i] = C; voffB[i] = (unsigned)(Rb * K * ESZ + C * 2); }
    const size_t kstep = (size_t)(BK * 2);
    const size_t hstep = (size_t)HALF * K * ESZ;
    const size_t tstep = 2 * hstep;
    const unsigned ldsw = (unsigned)wid * 1024u;
    const int aoff = lds_byte(wr * 64 + fr, fq * 8), boff = lds_byte(wc * 32 + fr, fq * 8);
#define PG8_SA(b, h) (((b) * 2 + (h)) * HTB)
#define PG8_SB(b, h) ((4 + (b) * 2 + (h)) * HTB)
#define PG8_STAGE(bufoff, gbase, voff) do { _Pragma("unroll") for (int _i = 0; _i < 2; ++_i) \
        __builtin_amdgcn_global_load_lds((const unsigned*)((const char*)(gbase) + (voff)[_i]), (LAS unsigned*)(lds + (bufoff) + ldsw + _i * 8192), 16, 0, 0); } while (0)
#define PG8_STAGE_H1(bufoff, gbase) do { if constexpr (GATHER) PG8_STAGE(bufoff, gbase, v1); else PG8_STAGE(bufoff, (gbase) + hstep, v0); } while (0)
#define PG8_LD8(p0_, p1_) __builtin_bit_cast(v8i_t, __builtin_shufflevector(*(const LAS f32x4*)(p0_), *(const LAS f32x4*)(p1_), 0, 1, 2, 3, 4, 5, 6, 7))
#define PG8_LDA(dst, b, h) do { _Pragma("unroll") for (int m = 0; m < 4; ++m) { \
        if constexpr (FP8) dst##8[m] = PG8_LD8(lds + PG8_SA(b, h) + aoff + m * 2048, lds + PG8_SA(b, h) + aoff + 1024 + m * 2048); \
        else { _Pragma("unroll") for (int k = 0; k < 2; ++k) dst[m][k] = *(const LAS bf16x8*)(lds + PG8_SA(b, h) + aoff + k * 1024 + m * 2048); } } } while (0)
#define PG8_LDB(dst, b, h) do { _Pragma("unroll") for (int n = 0; n < 2; ++n) { \
        if constexpr (FP8) dst##8[n] = PG8_LD8(lds + PG8_SB(b, h) + boff + n * 2048, lds + PG8_SB(b, h) + boff + 1024 + n * 2048); \
        else { _Pragma("unroll") for (int k = 0; k < 2; ++k) dst[n][k] = *(const LAS bf16x8*)(lds + PG8_SB(b, h) + boff + k * 1024 + n * 2048); } } } while (0)
#define PG8_MMA(ai, bj, At, Bt) do { __builtin_amdgcn_s_setprio(1); _Pragma("unroll") for (int m = 0; m < 4; ++m) _Pragma("unroll") for (int n = 0; n < 2; ++n) { \
        if constexpr (FP8) acc[ai][bj][m][n] = __builtin_amdgcn_mfma_scale_f32_16x16x128_f8f6f4(Bt##8[n], At##8[m], acc[ai][bj][m][n], 0, 0, 0, mx_sw, 0, mx_sa); \
        else { _Pragma("unroll") for (int k = 0; k < 2; ++k) acc[ai][bj][m][n] = __builtin_amdgcn_mfma_f32_16x16x32_bf16(Bt[n][k], At[m][k], acc[ai][bj][m][n], 0, 0, 0); } } __builtin_amdgcn_s_setprio(0); } while (0)
#define PG8_WAIT_V(n) asm volatile("s_waitcnt vmcnt(" #n ")" ::: "memory")
#define PG8_WAIT_L(n) asm volatile("s_waitcnt lgkmcnt(" #n ")" ::: "memory")
#define PG8_BAR __builtin_amdgcn_s_barrier()
#define PG8_SCHED __builtin_amdgcn_sched_barrier(0)
#define PG8_PIN do { if constexpr (FP8) __builtin_amdgcn_sched_barrier(0); } while (0)
    int mx_sw = 0x79797979, mx_sa = 0x7F7F7F7F;
    if constexpr (FP8) asm volatile("" : "+v"(mx_sw), "+v"(mx_sa));
    Unit cur, nxt; int ui = 0;
    if (!S.next(0, cur)) return;
    f32x4 acc[2][2][4][2];
#pragma unroll
    for (int a = 0; a < 2; ++a)
#pragma unroll
        for (int b = 0; b < 2; ++b)
#pragma unroll
            for (int m = 0; m < 4; ++m)
#pragma unroll
                for (int n = 0; n < 2; ++n) acc[a][b][m][n] = (f32x4){0.f, 0.f, 0.f, 0.f};
    bf16x8 At[4][2], B0[2][2], B1[2][2]; v8i_t At8[4], B08[2], B18[2];
    unsigned v0[2], v1[2];
    const char* cA; const char* cB = (const char*)g.Bt + (size_t)cur.bn * tstep;
    if constexpr (GATHER) {
        cA = (const char*)g.A;
#pragma unroll
        for (int i = 0; i < 2; ++i) { const int r0 = g.ridx[cur.am * BM + RA[i]], r1 = g.ridx[cur.am * BM + HALF + RA[i]];
            v0[i] = (unsigned)(r0 * K * ESZ + CA[i] * 2); v1[i] = (unsigned)(r1 * K * ESZ + CA[i] * 2); }
    } else {
        cA = (const char*)g.A + (size_t)cur.am * tstep;
#pragma unroll
        for (int i = 0; i < 2; ++i) { v0[i] = (unsigned)(RA[i] * K * ESZ + CA[i] * 2); v1[i] = 0u; }
    }
    if constexpr (Epi::ROWVEC) { if (wid >= 4) __builtin_amdgcn_global_load_lds((const unsigned*)(E.gw + cur.am * BM + (tid - 256)), (LAS unsigned*)(lds + ROWVEC_OFF + (wid - 4) * 256), 4, 0, 0); }
    PG8_STAGE(PG8_SB(0, 0), cB, voffB); PG8_STAGE(PG8_SB(0, 1), cB + hstep, voffB); PG8_STAGE(PG8_SA(0, 0), cA, v0); PG8_STAGE_H1(PG8_SA(0, 1), cA);
    if (wr == 1) PG8_BAR;
    PG8_WAIT_V(2); PG8_BAR;
    PG8_STAGE(PG8_SB(1, 0), cB + kstep, voffB); PG8_STAGE(PG8_SA(1, 0), cA + kstep, v0); PG8_STAGE(PG8_SB(1, 1), cB + hstep + kstep, voffB);
    PG8_WAIT_V(6); PG8_BAR;
    for (;;) {
        const bool has_next = S.next(ui + 1, nxt);
        const char* nA; const char* nB = has_next ? (const char*)g.Bt + (size_t)nxt.bn * tstep : cB;
        if constexpr (GATHER) {
            nA = cA;
            if (has_next && wid < 4)
                __builtin_amdgcn_global_load_lds((const unsigned*)(g.ridx + nxt.am * BM + tid), (LAS unsigned*)(lds_ridx + ((ui + 1) & 1) * 1024 + wid * 256), 4, 0, 0);
            if constexpr (Epi::ROWVEC) { if (has_next && wid >= 4)
                __builtin_amdgcn_global_load_lds((const unsigned*)(E.gw + nxt.am * BM + (tid - 256)), (LAS unsigned*)(lds + ROWVEC_OFF + ((ui + 1) & 1) * 1024 + (wid - 4) * 256), 4, 0, 0); }
        } else {
            nA = has_next ? (const char*)g.A + (size_t)nxt.am * tstep : cA;
        }
#pragma unroll 1
        for (int t = 0; t < nt; t += 2) {
            const bool last = (t == nt - 2);
            const char* a1 = cA + (size_t)(t + 1) * kstep;
            const char* a2 = last ? nA : cA + (size_t)(t + 2) * kstep; const char* b2 = last ? nB : cB + (size_t)(t + 2) * kstep;
            const char* a3 = a2 + kstep; const char* b3 = b2 + kstep;
            PG8_LDB(B0, 0, 0); PG8_LDB(B1, 0, 1); PG8_SCHED; PG8_LDA(At, 0, 0); PG8_STAGE_H1(PG8_SA(1, 1), a1);
            if constexpr (GATHER) {
                if (last && has_next) {
                    const LAS int* rp = (const LAS int*)(lds_ridx + ((ui + 1) & 1) * 1024);
#pragma unroll
                    for (int i = 0; i < 2; ++i) { const int r0 = rp[RA[i]], r1 = rp[HALF + RA[i]];
                        v0[i] = (unsigned)(r0 * K * ESZ + CA[i] * 2); v1[i] = (unsigned)(r1 * K * ESZ + CA[i] * 2); }
                }
            }
            PG8_WAIT_V(8); PG8_WAIT_L(0); PG8_BAR; PG8_PIN; PG8_MMA(0, 0, At, B0); PG8_MMA(0, 1, At, B1); PG8_PIN; PG8_BAR; PG8_SCHED;
            PG8_LDA(At, 0, 1); PG8_STAGE(PG8_SB(0, 0), b2, voffB); PG8_STAGE(PG8_SB(0, 1), b2 + hstep, voffB); PG8_STAGE(PG8_SA(0, 0), a2, v0);
            PG8_WAIT_V(8); PG8_WAIT_L(0); PG8_BAR; PG8_PIN; PG8_MMA(1, 0, At, B0); PG8_MMA(1, 1, At, B1); PG8_PIN; PG8_BAR; PG8_SCHED;
            PG8_LDB(B0, 1, 0); PG8_LDB(B1, 1, 1); PG8_SCHED; PG8_LDA(At, 1, 0); PG8_STAGE_H1(PG8_SA(0, 1), a2);
            PG8_WAIT_V(8); PG8_WAIT_L(0); PG8_BAR; PG8_PIN; PG8_MMA(0, 0, At, B0); PG8_MMA(0, 1, At, B1); PG8_PIN; PG8_BAR; PG8_SCHED;
            PG8_LDA(At, 1, 1); PG8_STAGE(PG8_SB(1, 0), b3, voffB); PG8_STAGE(PG8_SB(1, 1), b3 + hstep, voffB); PG8_STAGE(PG8_SA(1, 0), a3, v0);
            PG8_WAIT_V(8); PG8_WAIT_L(0); PG8_BAR; PG8_PIN; PG8_MMA(1, 0, At, B0); PG8_MMA(1, 1, At, B1); PG8_PIN; PG8_BAR; PG8_SCHED;
        }
        if (wr == 0) PG8_BAR;
        E(acc, cur, wr, wc, fr, fq, ui);
        if (!has_next) break;
#pragma unroll
        for (int a = 0; a < 2; ++a)
#pragma unroll
            for (int b = 0; b < 2; ++b)
#pragma unroll
                for (int m = 0; m < 4; ++m)
#pragma unroll
                    for (int n = 0; n < 2; ++n) acc[a][b][m][n] = (f32x4){0.f, 0.f, 0.f, 0.f};
        cur = nxt; cA = nA; cB = nB; ++ui;
        if (wr == 1) PG8_BAR;
    }
    PG8_WAIT_V(0);
    PG8_BAR;
#undef PG8_SA
#undef PG8_SB
#undef PG8_STAGE
#undef PG8_LDA
#undef PG8_LDB
#undef PG8_MMA
#undef PG8_LD8
#undef PG8_STAGE_H1
#undef PG8_WAIT_V
#undef PG8_WAIT_L
#undef PG8_BAR
#undef PG8_SCHED
#undef PG8_PIN
}
static_assert(lds_byte(9, 16) + 16 == lds_byte(9, 24) && lds_byte(3, 48) + 16 == lds_byte(3, 56) && lds_byte(12, 0) + 16 == lds_byte(12, 8), "fp8 fragment halves are adjacent");
}

struct Args { const float* in[22]; float* out; unsigned char* ws; int ph_lo, ph_hi; };
struct Frame {
    LAS unsigned char* lds;
    int lane, wave, vcu, G, bx;
    __device__ __forceinline__ int tid_() const { return wave * 64 + lane; }
    unsigned char* ws;
};
__device__ __forceinline__ const float* inp(const Frame& F, int k) {
    const unsigned long long v = ((const LAS unsigned long long*)(F.lds + PTR_OFF))[k];
    const unsigned lo = __builtin_amdgcn_readfirstlane((unsigned)v), hi = __builtin_amdgcn_readfirstlane((unsigned)(v >> 32));
    return (const float*)(((unsigned long long)hi << 32) | lo);
}
#define F_x (inp(F, 0))
#define F_c (inp(F, 1))
#define F_ctx (inp(F, 2))
#define F_c_ctx (inp(F, 3))
#define F_w_mod (inp(F, 4))
#define F_b_mod (inp(F, 5))
#define F_w_in (inp(F, 6))
#define F_a_sink (inp(F, 7))
#define F_nat_bias (inp(F, 8))
#define F_conv_w (inp(F, 9))
#define F_conv_b (inp(F, 10))
#define F_conv_ln_g (inp(F, 11))
#define F_conv_ln_b (inp(F, 12))
#define F_w_out (inp(F, 13))
#define F_ln1_g (inp(F, 14))
#define F_ln1_b (inp(F, 15))
#define F_w_router (inp(F, 16))
#define F_w_gate (inp(F, 17))
#define F_w_up (inp(F, 18))
#define F_w_down (inp(F, 19))
#define F_ln2_g (inp(F, 20))
#define F_ln2_b (inp(F, 21))
#define F_out ((float*)inp(F, 22))
__device__ __forceinline__ const float* modp(const Frame& F, int l, int cond, int which) { return (const float*)(F.ws + WS_MOD) + ((size_t)(l * 5 + cond) * 6 + which) * D; }
__device__ __forceinline__ int row_cond(int m) { return m < RL ? (m >> 13) : 4; }

__device__ __forceinline__ void conv_item_load(const float* W, int N, int k0, int n0, int lane, f32x4 (&t)[8]) {
    const float* src = W + (size_t)(k0 + (lane >> 3)) * N + n0 + (lane & 7) * 4;
#pragma unroll
    for (int i = 0; i < 8; ++i) t[i] = *(const GAS f32x4*)(src + (size_t)(8 * i) * N);
}
__device__ __forceinline__ void conv_item_to_lds(const f32x4 (&t)[8], LAS float* scr, int lane) {
#pragma unroll
    for (int i = 0; i < 8; ++i) { LAS float* d = scr + (8 * i + (lane >> 3)) * 33 + (lane & 7) * 4; d[0] = t[i][0]; d[1] = t[i][1]; d[2] = t[i][2]; d[3] = t[i][3]; }
    LDS_WAIT(); asm volatile("" ::: "memory");
}
__device__ __forceinline__ void conv_item_store_bf16(bf16_t* WT, int Kd, int trow, LAS float* scr, int k0, int lane) {
    const int c = lane & 7;
#pragma unroll
    for (int j = 0; j < 4; ++j) { const int n = (lane >> 3) + 8 * j; const LAS float* sp = scr + (8 * c) * 33 + n;
        u32x4 o; o.x = pk2(sp[0 * 33], sp[1 * 33]); o.y = pk2(sp[2 * 33], sp[3 * 33]); o.z = pk2(sp[4 * 33], sp[5 * 33]); o.w = pk2(sp[6 * 33], sp[7 * 33]);
        *(GAS u32x4*)(WT + (size_t)(trow + n) * Kd + k0 + 8 * c) = o; }
    LDS_WAIT(); asm volatile("" ::: "memory");
}
__device__ __forceinline__ void conv_item_store_fp8(unsigned char* WT, int Kd, int trow, LAS float* scr, int k0, int lane) {
    const int n = lane >> 1, kh = (lane & 1) * 32; const LAS float* sp = scr + kh * 33 + n;
    unsigned w[8];
#pragma unroll
    for (int q = 0; q < 8; ++q) w[q] = pk4_fp8(sp[(4 * q) * 33] * 64.0f, sp[(4 * q + 1) * 33] * 64.0f, sp[(4 * q + 2) * 33] * 64.0f, sp[(4 * q + 3) * 33] * 64.0f);
    unsigned char* dst = WT + (size_t)(trow + n) * Kd + k0 + kh;
    *(GAS u32x4*)dst = (u32x4){w[0], w[1], w[2], w[3]}; *(GAS u32x4*)(dst + 16) = (u32x4){w[4], w[5], w[6], w[7]};
    LDS_WAIT(); asm volatile("" ::: "memory");
}
constexpr int CONV_NITEMS = 16 * 64 + 16 * 32 + 3 * NE * 16 * 32, CONV_S1 = (CONV_NITEMS * 56) / 100, CONV_S2 = (CONV_NITEMS * 74) / 100;
__device__ __forceinline__ void conv_decode(const Frame& F, int l, int it, const float*& W, int& N, int& k0, int& n0, int& kind, unsigned char*& WT, int& Kd, int& trow) {
    constexpr int I_IN = 16 * 64, I_OUT = 16 * 32, I_E = 16 * 32;
    int r = it;
    if (r < I_IN) { const int kb = r / 64, nb = r % 64; n0 = 32 * nb; k0 = 64 * kb; trow = n0;
        if (n0 >= OFF_C) { const int c = n0 - OFF_C, gate = c >> 8, ch = c & 255; trow = OFF_C + (ch >> 7) * 256 + gate * 128 + (ch & 127); }
        W = F_w_in + (size_t)l * D * INW; N = INW; kind = 0; WT = F.ws + wsw(l, WS_WIN); Kd = D; return; }
    r -= I_IN;
    if (r < I_OUT) { const int kb = r / 32, nb = r % 32; n0 = 32 * nb; k0 = 64 * kb; trow = n0; W = F_w_out + (size_t)l * D * D; N = D; kind = 0; WT = F.ws + wsw(l, WS_WOUT); Kd = D; return; }
    r -= I_OUT;
    const int mat = r / (NE * I_E); r -= mat * (NE * I_E);
    const int e = r / I_E; r -= e * I_E;
    const int kb = r / 32, nb = r % 32; n0 = 32 * nb; k0 = 64 * kb;
    const size_t woff = ((size_t)l * NE + e) * (size_t)D * FF;
    kind = 1; N = (mat == 2) ? D : FF; Kd = (mat == 2) ? FF : D;
    W = (mat == 0 ? F_w_gate : mat == 1 ? F_w_up : F_w_down) + woff;
    WT = (mat == 2) ? F.ws + wsw(l, WS_WD) : F.ws + wsw(l, WS_WGU);
    trow = (mat == 0) ? e * 2048 + (n0 >> 7) * 256 + (n0 & 127) : (mat == 1) ? e * 2048 + (n0 >> 7) * 256 + 128 + (n0 & 127) : e * 1024 + n0;
}
__device__ __forceinline__ void convert_weights(Frame& F, int l, int it_lo, int it_hi, int worker, int nworkers) {
    LAS float* scr = (LAS float*)(F.lds + F.wave * 16384);
    const int gw = worker * NWAVES + F.wave, NGW = nworkers * NWAVES;
    f32x4 ta[8], tb[8];
#pragma unroll
    for (int i = 0; i < 8; ++i) { ta[i] = (f32x4){0.f, 0.f, 0.f, 0.f}; tb[i] = ta[i]; }
#pragma unroll 1
    for (int it = it_lo + gw - NGW; it < it_hi; it += NGW) {
        const float* W; int N, k0, n0, kind, Kd, trow; unsigned char* WT;
        if (it + NGW < it_hi) { conv_decode(F, l, it + NGW, W, N, k0, n0, kind, WT, Kd, trow); conv_item_load(W, N, k0, n0, F.lane, tb); }
        if (it >= it_lo) { conv_decode(F, l, it, W, N, k0, n0, kind, WT, Kd, trow);
            conv_item_to_lds(ta, scr, F.lane);
            if (kind == 0) conv_item_store_bf16((bf16_t*)WT, Kd, trow, scr, k0, F.lane); else conv_item_store_fp8(WT, Kd, trow, scr, k0, F.lane); }
        __builtin_amdgcn_sched_barrier(0);
#pragma unroll
        for (int i = 0; i < 8; ++i) ta[i] = tb[i];
        __builtin_amdgcn_sched_barrier(0);
    }
}

__device__ __forceinline__ void mod_items(Frame& F) {
    LAS float* sl = (LAS float*)F.lds;
    LAS float* part = sl + 5 * 1024;
    bool have = false;
    for (int it = F.vcu; it < 48; it += F.G) {
        if (!have) {
            for (int i = F.tid_(); i < 5 * 1024; i += NTHR) { const int cd = i >> 10, k = i & 1023; const float v = cd < 4 ? F_c[cd * D + k] : F_c_ctx[k];
                sl[i] = v / (1.0f + expf(-v)); }
            have = true;
        }
        __syncthreads();
        const int l = it / 24, ch = it % 24;
        const float* W = F_w_mod + (size_t)l * D * 6 * D + ch * 256 + 4 * F.lane;
        f32x4 a[5];
#pragma unroll
        for (int cd = 0; cd < 5; ++cd) a[cd] = (f32x4){0.f, 0.f, 0.f, 0.f};
        const int kbase = F.wave * 128;
#pragma unroll 8
        for (int kk = 0; kk < 128; ++kk) { const int k = kbase + kk; const f32x4 w = *(const f32x4*)(W + (size_t)k * 6 * D);
#pragma unroll
            for (int cd = 0; cd < 5; ++cd) a[cd] += w * sl[cd * 1024 + k]; }
#pragma unroll
        for (int cd = 0; cd < 5; ++cd) *(LAS f32x4*)(part + (F.wave * 5 + cd) * 256 + 4 * F.lane) = a[cd];
        __syncthreads();
        for (int i = F.tid_(); i < 5 * 256; i += NTHR) { const int cd = i >> 8, cc = i & 255; float s = F_b_mod[(size_t)l * 6 * D + ch * 256 + cc];
#pragma unroll
            for (int w = 0; w < 8; ++w) s += part[(w * 5 + cd) * 256 + cc];
            ((float*)(F.ws + WS_MOD))[(size_t)(l * 5 + cd) * 6 * D + ch * 256 + cc] = s; }
        __syncthreads();
    }
}
__device__ __forceinline__ void rope_table(Frame& F) {
    if (F.vcu != F.G - 1) return;
    float* rc = (float*)(F.ws + WS_ROPE); float* rs = rc + 128 * 16;
    for (int i = F.tid_(); i < 128 * 16; i += NTHR) { const int pos = i >> 4, f = i & 15;
        const float inv = exp2f(-(float)f * (13.287712379549449f / 16.0f)), ang = (float)pos * inv;
        rc[i] = cosf(ang); rs[i] = sinf(ang); }
}

struct RowVec { f32x4 v[4]; };
__device__ __forceinline__ void ld_vec(const float* p, int lane, RowVec& r) {
#pragma unroll
    for (int j = 0; j < 4; ++j) r.v[j] = *(const GAS f32x4*)(p + 4 * lane + 256 * j);
}
__device__ __forceinline__ void ld_row_f32(const float* p, int lane, f32x4 (&v)[4]) {
#pragma unroll
    for (int j = 0; j < 4; ++j) v[j] = *(const GAS f32x4*)(p + 4 * lane + 256 * j);
}
__device__ __forceinline__ void st_row_f32(float* p, int lane, const f32x4 (&v)[4]) {
#pragma unroll
    for (int j = 0; j < 4; ++j) *(GAS f32x4*)(p + 4 * lane + 256 * j) = v[j];
}
__device__ __forceinline__ void ld_row_bf16raw(const bf16_t* p, int lane, u32x2 (&w)[4]) {
#pragma unroll
    for (int j = 0; j < 4; ++j) w[j] = *(const GAS u32x2*)(p + 4 * lane + 256 * j);
}
typedef _Float16 h16x2 __attribute__((ext_vector_type(2)));
__device__ __forceinline__ void ld_row_f16raw(const _Float16* p, int lane, u32x2 (&w)[4]) {
#pragma unroll
    for (int j = 0; j < 4; ++j) w[j] = *(const GAS u32x2*)(p + 4 * lane + 256 * j);
}
__device__ __forceinline__ f32x4 h4(u32x2 w) { const unsigned wx = w.x, wy = w.y;
    const h16x2 a = __builtin_bit_cast(h16x2, wx), b = __builtin_bit_cast(h16x2, wy); return (f32x4){(float)a[0], (float)a[1], (float)b[0], (float)b[1]}; }
__device__ __forceinline__ void st_row_f16(_Float16* p, int lane, const f32x4 (&v)[4]) {
#pragma unroll
    for (int j = 0; j < 4; ++j) { const h16x2 a = {(_Float16)v[j][0], (_Float16)v[j][1]}, b = {(_Float16)v[j][2], (_Float16)v[j][3]};
        u32x2 w; w.x = __builtin_bit_cast(unsigned, a); w.y = __builtin_bit_cast(unsigned, b); *(GAS u32x2*)(p + 4 * lane + 256 * j) = w; }
}
__device__ __forceinline__ f32x4 fp8x4(unsigned w) { const f32x2 lo = __builtin_amdgcn_cvt_pk_f32_fp8((int)w, false), hi = __builtin_amdgcn_cvt_pk_f32_fp8((int)w, true); return (f32x4){lo[0], lo[1], hi[0], hi[1]}; }
__device__ __forceinline__ f32x4 bf4(u32x2 w) { return (f32x4){bflo(w.x), bfhi(w.x), bflo(w.y), bfhi(w.y)}; }
__device__ __forceinline__ void st_row_bf16(bf16_t* p, int lane, const f32x4 (&v)[4]) {
#pragma unroll
    for (int j = 0; j < 4; ++j) { u32x2 w; w.x = cvt_pk_bf16(v[j][0], v[j][1]); w.y = cvt_pk_bf16(v[j][2], v[j][3]); *(GAS u32x2*)(p + 4 * lane + 256 * j) = w; }
}
__device__ __forceinline__ void ln_stats(const f32x4 (&v)[4], float& mean, float& rstd) {
    float s = 0.f, q = 0.f;
#pragma unroll
    for (int j = 0; j < 4; ++j) { s += (v[j][0] + v[j][1]) + (v[j][2] + v[j][3]); q += (v[j][0] * v[j][0] + v[j][1] * v[j][1]) + (v[j][2] * v[j][2] + v[j][3] * v[j][3]); }
    wave_sum2(s, q);
    mean = s * (1.0f / D);
    rstd = 1.0f / sqrtf(fmaxf(q * (1.0f / D) - mean * mean, 0.f) + LN_EPS);
}
__device__ __forceinline__ const float* xsrc_row(const Frame& F, int l, int m) {
    (void)l; return m < RL ? F_x + (size_t)m * D : F_ctx + (size_t)(m - RL) * D;
}

constexpr int CW_CIA = 8192;
__device__ __forceinline__ void row_segment(const Frame& F, int nc, int nrows, int seg, int& m0, int& m1) {
    if (nc == 0) { const int gw = F.vcu * NWAVES + F.wave, NGW = F.G * NWAVES, per = (nrows + NGW - 1) / NGW; m0 = seg == 0 ? nrows : gw * per; m1 = seg == 0 ? nrows : min(nrows, m0 + per); return; }
    const int wid = (F.vcu - nc) * NWAVES + F.wave, NW = (F.G - nc) * NWAVES;
    if (seg == 0) { m0 = RL + wid; m1 = (nrows > RL && m0 < R) ? m0 + 1 : m0; }
    else { const int per = (RL + NW - 1) / NW; m0 = wid * per; m1 = min(RL, m0 + per); }
}
__device__ __forceinline__ void cia_publish(const Frame& F, int nc, int which) {
    asm volatile("s_waitcnt vmcnt(0)" ::: "memory");
    __syncthreads();
    if (F.tid_() == 0) { const int w0 = (F.vcu - nc) * NWAVES, cnt = min(max(RC - w0, 0), NWAVES);
        if (cnt > 0) { __builtin_amdgcn_fence(__ATOMIC_RELEASE, "agent"); asm volatile("s_waitcnt vmcnt(0)" ::: "memory");
            __hip_atomic_fetch_add((unsigned*)(F.ws + WS_CTL) + CW_CIA + 64 * which, (unsigned)cnt, __ATOMIC_RELAXED, __HIP_MEMORY_SCOPE_AGENT); } }
}
__device__ __forceinline__ void cia_wait(const Frame& F, int which) {
    if (F.tid_() == 0) { unsigned* p = (unsigned*)(F.ws + WS_CTL) + CW_CIA + 64 * which; unsigned sp = 0;
        while (__hip_atomic_load(p, __ATOMIC_RELAXED, __HIP_MEMORY_SCOPE_AGENT) < (unsigned)RC) { __builtin_amdgcn_s_sleep(2); if (++sp > (1u << 24)) break; }
        __builtin_amdgcn_fence(__ATOMIC_ACQUIRE, "agent"); asm volatile("s_waitcnt vmcnt(0)" ::: "memory"); }
    __syncthreads();
}

__device__ __forceinline__ void phase_h0(Frame& F, bf16_t* H, int nc) {
    int cur = -1; RowVec sh, sc; f32x4 xa0[4], xa1[4], xb0[4], xb1[4];
#pragma unroll 1
    for (int seg = 0; seg < 2; ++seg) {
        int m0, m1; row_segment(F, nc, R, seg, m0, m1);
        if (m0 < m1) {
#pragma unroll
            for (int j = 0; j < 4; ++j) { xa0[j] = (f32x4){0.f, 0.f, 0.f, 0.f}; xa1[j] = xa0[j]; xb0[j] = xa0[j]; xb1[j] = xa0[j]; }
#pragma unroll 1
            for (int m = m0 - 2; m < m1; m += 2) {
                if (m >= m0) { const int cd = row_cond(m), cd1 = (m + 1 < m1) ? row_cond(m + 1) : cd;
                    if (cd != cur) { cur = cd; ld_vec(modp(F, 0, cd, 0), F.lane, sh); ld_vec(modp(F, 0, cd, 1), F.lane, sc);
                        asm volatile("" :: "v"(sh.v[0]), "v"(sh.v[1]), "v"(sh.v[2]), "v"(sh.v[3]), "v"(sc.v[0]), "v"(sc.v[1]), "v"(sc.v[2]), "v"(sc.v[3])); }
                    (void)cd1; }
                if (m + 2 < m1) ld_row_f32(xsrc_row(F, 0, m + 2), F.lane, xb0);
                if (m + 3 < m1) ld_row_f32(xsrc_row(F, 0, m + 3), F.lane, xb1);
                if (m >= m0) {
                    { float mean, rstd; ln_stats(xa0, mean, rstd); f32x4 h[4];
#pragma unroll
                      for (int j = 0; j < 4; ++j) h[j] = ((xa0[j] - mean) * rstd) * (sc.v[j] + 1.0f) + sh.v[j];
                      st_row_bf16(H + (size_t)m * D, F.lane, h); }
                    if (m + 1 < m1) {
                        const int cd1 = row_cond(m + 1);
                        if (cd1 != cur) { cur = cd1; ld_vec(modp(F, 0, cd1, 0), F.lane, sh); ld_vec(modp(F, 0, cd1, 1), F.lane, sc);
                            asm volatile("" :: "v"(sh.v[0]), "v"(sh.v[1]), "v"(sh.v[2]), "v"(sh.v[3]), "v"(sc.v[0]), "v"(sc.v[1]), "v"(sc.v[2]), "v"(sc.v[3])); }
                        float mean, rstd; ln_stats(xa1, mean, rstd); f32x4 h[4];
#pragma unroll
                        for (int j = 0; j < 4; ++j) h[j] = ((xa1[j] - mean) * rstd) * (sc.v[j] + 1.0f) + sh.v[j];
                        st_row_bf16(H + (size_t)(m + 1) * D, F.lane, h); }
                }
                __builtin_amdgcn_sched_barrier(0);
#pragma unroll
                for (int j = 0; j < 4; ++j) { xa0[j] = xb0[j]; xa1[j] = xb1[j]; }
                __builtin_amdgcn_sched_barrier(0);
            }
        }
        if (seg == 0 && nc > 0) cia_publish(F, nc, 0);
    }
}

typedef float f32x4_t __attribute__((ext_vector_type(4)));
constexpr int RP1_LD = 1028;
template <bool L0>
__device__ __forceinline__ void phase_rowpass1(Frame& F, int l, const bf16_t* O, unsigned char* H2, int nrows) {
    LAS float* Wl = (LAS float*)F.lds;
    LAS float* Hs = Wl + 16 * RP1_LD;
    LAS float* Pt = Hs + 16 * RP1_LD;
    { const f32x4* wr4 = (const f32x4*)(F_w_router + (size_t)l * D * NE); f32x4 t[8];
#pragma unroll
      for (int k = 0; k < 8; ++k) t[k] = wr4[F.tid_() + k * NTHR];
#pragma unroll
      for (int k = 0; k < 8; ++k) { const int i = 4 * (F.tid_() + k * NTHR);
#pragma unroll
          for (int q = 0; q < 4; ++q) Wl[((i & 15) + q) * RP1_LD + (i >> 4)] = t[k][q]; } }
    __syncthreads();
    const int lane = F.lane, wv = F.wave;
    const int perwg = (nrows + F.G - 1) / F.G, r0 = F.vcu * perwg, r1 = min(nrows, r0 + perwg);
    const int niter = r0 < r1 ? 2 * ((r1 - r0 + 15) / 16) : 0;
    _Float16* XA = (_Float16*)(F.ws + WS_XA); int* inv = (int*)(F.ws + WS_INV);
    RowVec lg, lb, g1, sh2, sc2;
    ld_vec(F_ln1_g + (size_t)l * D, lane, lg); ld_vec(F_ln1_b + (size_t)l * D, lane, lb);
    int cur = -1;
    f32x4 xa[4], xb[4]; u32x2 ha[4], hb[4]; u32x2 oa[4], ob[4];
#define RP1_LOAD(X, H_, O_, m_) do { if ((m_) < r1) { if (L0) ld_row_f32(xsrc_row(F, 0, (m_)), lane, X); else ld_row_f16raw(XA + (size_t)(m_) * D, lane, H_); ld_row_bf16raw(O + (size_t)(m_) * D, lane, O_); } } while (0)
#pragma unroll 1
    for (int it = -1; it < niter; ++it) {
        const int m = r0 + 8 * it + wv;
        if (it >= 0 && m < r1) { const int cd = row_cond(m); if (cd != cur) { cur = cd; ld_vec(modp(F, l, cd, 2), lane, g1); ld_vec(modp(F, l, cd, 3), lane, sh2); ld_vec(modp(F, l, cd, 4), lane, sc2);
            asm volatile("" :: "v"(g1.v[0]), "v"(g1.v[1]), "v"(g1.v[2]), "v"(g1.v[3]), "v"(sh2.v[0]), "v"(sh2.v[1]), "v"(sh2.v[2]), "v"(sh2.v[3]), "v"(sc2.v[0]), "v"(sc2.v[1]), "v"(sc2.v[2]), "v"(sc2.v[3])); } }
        RP1_LOAD(xb, hb, ob, m + 8);
        LAS float* hrow = Hs + ((it & 1) * 8 + wv) * RP1_LD;
        if (it >= 0) {
        if (m < r1) {
            if (!L0) {
#pragma unroll
                for (int j = 0; j < 4; ++j) xa[j] = h4(ha[j]); }
            f32x4 v[4];
#pragma unroll
            for (int j = 0; j < 4; ++j) v[j] = xa[j] * ALPHA + g1.v[j] * bf4(oa[j]);
            float mean, rstd; ln_stats(v, mean, rstd);
#pragma unroll
            for (int j = 0; j < 4; ++j) v[j] = ((v[j] - mean) * rstd) * lg.v[j] + lb.v[j];
            st_row_f16(XA + (size_t)m * D, lane, v);
            ln_stats(v, mean, rstd);
#pragma unroll
            for (int j = 0; j < 4; ++j) { const f32x4 h = ((v[j] - mean) * rstd) * (sc2.v[j] + 1.0f) + sh2.v[j];
                *(GAS unsigned*)(H2 + (size_t)m * D + 4 * lane + 256 * j) = pk4_fp8(h[0], h[1], h[2], h[3]);
                *(LAS f32x4*)(hrow + 4 * lane + 256 * j) = h; }
        } else {
#pragma unroll
            for (int j = 0; j < 4; ++j) *(LAS f32x4*)(hrow + 4 * lane + 256 * j) = (f32x4){0.f, 0.f, 0.f, 0.f};
        }
        if (it & 1) {
            __syncthreads();
            f32x4_t acc = {0.f, 0.f, 0.f, 0.f};
            { const LAS float* ap = Hs + (lane & 15) * RP1_LD + 128 * wv + 4 * (lane >> 4); const LAS float* bp = Wl + (lane & 15) * RP1_LD + 128 * wv + 4 * (lane >> 4);
#pragma unroll
              for (int ks = 0; ks < 8; ++ks) { const f32x4 a = *(const LAS f32x4*)(ap + 16 * ks), w = *(const LAS f32x4*)(bp + 16 * ks);
#pragma unroll
                  for (int i = 0; i < 4; ++i) acc = __builtin_amdgcn_mfma_f32_16x16x4f32(a[i], w[i], acc, 0, 0, 0); } }
#pragma unroll
            for (int r = 0; r < 4; ++r) Pt[(wv * 16 + 4 * (lane >> 4) + r) * 16 + (lane & 15)] = acc[r];
            __syncthreads();
            const int t = F.tid_();
            if (t < 256) { const int ri = t >> 4, e = t & 15; float lgt = 0.f;
#pragma unroll
                for (int w8 = 0; w8 < 8; ++w8) lgt += Pt[(w8 * 16 + ri) * 16 + e];
                const float mx = row16_max(lgt), ex = expf(lgt - mx), den = row16_sum(ex), aff = ex / den;
                const int mr = r0 + 8 * (it - 1) + (ri & 7) + 8 * (ri >> 3);
                if (mr < r1) {
                    if (mr < RL) ((float*)(F.ws + WS_AFF))[((size_t)((mr >> 13) * 16 + e)) * SEQ + (mr & (SEQ - 1))] = aff;
                    else { const int mc = mr - RL; ((float*)(F.ws + WS_AFFC))[((size_t)((mc >> 8) * 16 + e)) * NCTX + (mc & (NCTX - 1))] = aff; }
                    inv[(size_t)mr * 16 + e] = -1; } }
        }
        }
        __builtin_amdgcn_sched_barrier(0);
#pragma unroll
        for (int j = 0; j < 4; ++j) { if (L0) xa[j] = xb[j]; else ha[j] = hb[j]; oa[j] = ob[j]; }
        __builtin_amdgcn_sched_barrier(0);
    }
#undef RP1_LOAD
    __syncthreads();
}

template <int PER>
__device__ __forceinline__ void topk_item(Frame& F, const float* aff, int nact, int cap, int rowbase, int slotbase, int e) {
    LAS unsigned* hist = (LAS unsigned*)F.lds;
    LAS unsigned* wt = hist + 256;
    LAS unsigned* ctl = wt + 16;
    int* rowidx = (int*)(F.ws + WS_RIDX) + e * EROWS; float* gatew = (float*)(F.ws + WS_GATEW) + e * EROWS; int* inv = (int*)(F.ws + WS_INV);
    const int tid = F.tid_(), lane = F.lane, wave = F.wave;
    const bool act = tid * PER < nact;
    unsigned key[PER];
    if constexpr (PER == 16) {
#pragma unroll
        for (int q = 0; q < 4; ++q) { const u32x4 w = *(const u32x4*)(aff + tid * 16 + q * 4); key[q * 4 + 0] = w.x; key[q * 4 + 1] = w.y; key[q * 4 + 2] = w.z; key[q * 4 + 3] = w.w; }
    } else {
        key[0] = act ? __builtin_bit_cast(unsigned, aff[tid]) : 0u;
    }
    unsigned prefix = 0u, mask = 0u, remaining = (unsigned)cap;
#pragma unroll 1
    for (int pass = 0; pass < 4; ++pass) {
        const int shift = 24 - 8 * pass;
        if (tid < 256) hist[tid] = 0u;
        __syncthreads();
        if (act) {
#pragma unroll
            for (int i = 0; i < PER; ++i) if ((key[i] & mask) == prefix) __hip_atomic_fetch_add(&hist[(key[i] >> shift) & 255u], 1u, __ATOMIC_RELAXED, __HIP_MEMORY_SCOPE_WORKGROUP);
        }
        __syncthreads();
        unsigned hv = 0u, sfx = 0u;
        if (tid < 256) { hv = hist[tid]; sfx = hv;
#pragma unroll
            for (int o = 1; o < 64; o <<= 1) { const unsigned t2 = lane_get(sfx, (lane + o) & 63); if (lane + o < 64) sfx += t2; }
            if (lane == 0) wt[wave] = sfx; }
        __syncthreads();
        if (tid < 256) { for (int w = wave + 1; w < 4; ++w) sfx += wt[w];
            if (sfx >= remaining && sfx - hv < remaining) { ctl[0] = (unsigned)tid; ctl[1] = remaining - (sfx - hv); } }
        __syncthreads();
        prefix |= ctl[0] << shift; mask |= 255u << shift; remaining = ctl[1];
        __syncthreads();
    }
    const unsigned T = prefix, need_eq = remaining;
    unsigned cgt = 0u, ceq = 0u;
    if (act) {
#pragma unroll
        for (int i = 0; i < PER; ++i) { cgt += key[i] > T ? 1u : 0u; ceq += key[i] == T ? 1u : 0u; }
    }
    unsigned v = cgt | (ceq << 16), inc = v;
#pragma unroll
    for (int o = 1; o < 64; o <<= 1) { const unsigned t2 = lane_get(inc, (lane - o) & 63); if (lane >= o) inc += t2; }
    if (lane == 63) wt[wave] = inc;
    __syncthreads();
    unsigned base = 0u, total = 0u;
    for (int w = 0; w < 8; ++w) { const unsigned t2 = wt[w]; if (w < wave) base += t2; total += t2; }
    unsigned pgt = (base + inc - v) & 0xffffu, peq = (base + inc - v) >> 16;
    const unsigned total_gt = total & 0xffffu;
    if (act) {
#pragma unroll
        for (int i = 0; i < PER; ++i) {
            int slot = -1;
            if (key[i] > T) { slot = (int)pgt; ++pgt; }
            else if (key[i] == T) { if (peq < need_eq) slot = (int)(total_gt + peq); ++peq; }
            if (slot >= 0) { const int n = tid * PER + i; rowidx[slotbase + slot] = rowbase + n; gatew[slotbase + slot] = __builtin_bit_cast(float, key[i]); inv[(size_t)(rowbase + n) * 16 + e] = slotbase + slot; }
        }
    }
    __syncthreads();
}
__device__ __forceinline__ void phase_topk(Frame& F, bool with_ctx) {
    const int nitems = with_ctx ? 128 : 64;
    for (int it = F.vcu; it < nitems; it += F.G) {
        if (it < 64) { const int b = it >> 4, e = it & 15;
            topk_item<16>(F, (const float*)(F.ws + WS_AFF) + (size_t)(b * 16 + e) * SEQ, SEQ, CAP_L, b * SEQ, b * CAP_L, e);
        } else { const int b = (it - 64) >> 4, e = it & 15;
            topk_item<1>(F, (const float*)(F.ws + WS_AFFC) + (size_t)(b * 16 + e) * NCTX, NCTX, CAP_C, RL + b * NCTX, 4096 + b * CAP_C, e);
            if (b == 0 && F.tid_() < 128) { ((int*)(F.ws + WS_RIDX))[e * EROWS + 4224 + F.tid_()] = 0; ((float*)(F.ws + WS_GATEW))[e * EROWS + 4224 + F.tid_()] = 0.f; }
        }
    }
}

template <bool L0>
__device__ __forceinline__ void phase_rowpass2(Frame& F, int l, const unsigned char* slab, bf16_t* Hn, int nrows, int nc) {
    const int lane = F.lane;
    _Float16* XA = (_Float16*)(F.ws + WS_XA); const int* inv = (const int*)(F.ws + WS_INV);
    RowVec lg, lb, g2, sh, sc;
    ld_vec(F_ln2_g + (size_t)l * D, lane, lg); ld_vec(F_ln2_b + (size_t)l * D, lane, lb);
    int cur = -1;
#pragma unroll 1
    for (int seg = 0; seg < 2; ++seg) {
    int m0, m1; row_segment(F, nc, nrows, seg, m0, m1);
    if (m0 < m1) {
    u32x2 ha[4], hb[4]; int inva = -1, invb = -1, invc = -1;
    unsigned ya0[4], ya1[4], yb0[4], yb1[4];
#pragma unroll
    for (int j = 0; j < 4; ++j) { ha[j] = (u32x2){0u, 0u}; hb[j] = (u32x2){0u, 0u}; ya0[j] = 0u; ya1[j] = 0u; yb0[j] = 0u; yb1[j] = 0u; }
#pragma unroll 1
    for (int m = m0 - 2; m < m1; ++m) {
        if (m >= m0) { const int cd = row_cond(m);
            if (cd != cur) { cur = cd; ld_vec(modp(F, l, cd, 5), lane, g2);
                if (L0) { ld_vec(modp(F, 1, cd, 0), lane, sh); ld_vec(modp(F, 1, cd, 1), lane, sc);
                    asm volatile("" :: "v"(sh.v[0]), "v"(sh.v[1]), "v"(sh.v[2]), "v"(sh.v[3]), "v"(sc.v[0]), "v"(sc.v[1]), "v"(sc.v[2]), "v"(sc.v[3])); }
                asm volatile("" :: "v"(g2.v[0]), "v"(g2.v[1]), "v"(g2.v[2]), "v"(g2.v[3])); } }
        if (m + 2 < m1) invc = (lane < 16) ? inv[(size_t)(m + 2) * 16 + lane] : -1;
        if (m + 1 >= m0 && m + 1 < m1) {
            ld_row_f16raw(XA + (size_t)(m + 1) * D, lane, hb);
            unsigned long long mk = __ballot(invb >= 0);
            if (mk) { const int e0 = __builtin_ctzll(mk); mk &= mk - 1; const bool two = mk != 0ull; const int e1 = two ? __builtin_ctzll(mk) : e0;
                const int s0 = __builtin_amdgcn_readlane(invb, e0), s1 = __builtin_amdgcn_readlane(invb, e1);
                { const unsigned char* p0 = slab + ((size_t)e0 * EROWS + s0) * D + 4 * lane;
#pragma unroll
                  for (int j = 0; j < 4; ++j) yb0[j] = *(const GAS unsigned*)(p0 + 256 * j); }
                if (two) { const unsigned char* p1 = slab + ((size_t)e1 * EROWS + s1) * D + 4 * lane;
#pragma unroll
                  for (int j = 0; j < 4; ++j) yb1[j] = *(const GAS unsigned*)(p1 + 256 * j); } }
        }
        if (m >= m0) {
        f32x4 xa[4];
#pragma unroll
        for (int j = 0; j < 4; ++j) xa[j] = h4(ha[j]);
        f32x4 acc[4];
#pragma unroll
        for (int j = 0; j < 4; ++j) acc[j] = (f32x4){0.f, 0.f, 0.f, 0.f};
        unsigned long long msk = __ballot(inva >= 0);
        if (msk) { msk &= msk - 1; const bool two = msk != 0ull; if (two) msk &= msk - 1;
#pragma unroll
            for (int j = 0; j < 4; ++j) acc[j] += fp8x4(ya0[j]);
            if (two) {
#pragma unroll
                for (int j = 0; j < 4; ++j) acc[j] += fp8x4(ya1[j]); } }
#pragma unroll 1
        while (msk) {
            const int e0 = __builtin_ctzll(msk); msk &= msk - 1;
            const bool two = msk != 0ull; const int e1 = two ? __builtin_ctzll(msk) : e0; if (two) msk &= msk - 1;
            const int s0 = __builtin_amdgcn_readlane(inva, e0), s1 = __builtin_amdgcn_readlane(inva, e1);
            unsigned y0[4], y1[4];
            { const unsigned char* p0 = slab + ((size_t)e0 * EROWS + s0) * D + 4 * lane;
#pragma unroll
              for (int j = 0; j < 4; ++j) y0[j] = *(const GAS unsigned*)(p0 + 256 * j); }
            if (two) { const unsigned char* p1 = slab + ((size_t)e1 * EROWS + s1) * D + 4 * lane;
#pragma unroll
              for (int j = 0; j < 4; ++j) y1[j] = *(const GAS unsigned*)(p1 + 256 * j); }
#pragma unroll
            for (int j = 0; j < 4; ++j) acc[j] += fp8x4(y0[j]);
            if (two) {
#pragma unroll
                for (int j = 0; j < 4; ++j) acc[j] += fp8x4(y1[j]); }
        }
        f32x4 v[4];
#pragma unroll
        for (int j = 0; j < 4; ++j) v[j] = xa[j] * ALPHA + g2.v[j] * (acc[j] * 0.0625f);
        float mean, rstd; ln_stats(v, mean, rstd);
#pragma unroll
        for (int j = 0; j < 4; ++j) v[j] = ((v[j] - mean) * rstd) * lg.v[j] + lb.v[j];
        if (L0) st_row_f16(XA + (size_t)m * D, lane, v);
        else st_row_f32(F_out + (size_t)m * D, lane, v);
        if (L0) { ln_stats(v, mean, rstd); f32x4 h[4];
#pragma unroll
            for (int j = 0; j < 4; ++j) h[j] = ((v[j] - mean) * rstd) * (sc.v[j] + 1.0f) + sh.v[j];
            st_row_bf16(Hn + (size_t)m * D, lane, h); }
        }
        __builtin_amdgcn_sched_barrier(0);
#pragma unroll
        for (int j = 0; j < 4; ++j) { ha[j] = hb[j]; ya0[j] = yb0[j]; ya1[j] = yb1[j]; }
        inva = invb; invb = invc;
        __builtin_amdgcn_sched_barrier(0);
    }
    }
    if (seg == 0 && nc > 0) cia_publish(F, nc, 1);
    }
}

__device__ __forceinline__ void conv_unit_rows(int un, int& rowbase, int& t0, int& slen) {
    if (un < RL / 64) { const int b = un / (SEQ / 64); t0 = (un % (SEQ / 64)) * 64; rowbase = b * SEQ; slen = SEQ; }
    else { const int uc = un - RL / 64; const int b = uc / (NCTX / 64); t0 = (uc % (NCTX / 64)) * 64; rowbase = RL + b * NCTX; slen = NCTX; }
}
__device__ __forceinline__ void conv_fetch(const bf16_t* U, int un, int tid, u32x4 (&pf)[6]) {
    int rowbase, t0, slen; conv_unit_rows(un, rowbase, t0, slen);
#pragma unroll
    for (int q = 0; q < 6; ++q) { const int i = tid + q * NTHR, tt = i >> 5, c8 = (i & 31) * 8, t = t0 - 15 + tt;
        pf[q] = (u32x4){0u, 0u, 0u, 0u};
        if (tt < 94 && t >= 0 && t < slen) pf[q] = *(const GAS u32x4*)(U + (size_t)(rowbase + t) * INW + OFF_C + c8); }
}
__device__ __forceinline__ void phase_conv(Frame& F, int l, const bf16_t* U, bf16_t* MIX, bool with_ctx) {
    LAS float* g = (LAS float*)F.lds;
    const int nunits = (RL / 64) + (with_ctx ? RC / 64 : 0);
    const int ch = F.tid_() & 255, half = F.tid_() >> 8;
    float w[31];
    { const float* cw = F_conv_w + (size_t)l * 31 * 256;
#pragma unroll
      for (int j = 0; j < 31; ++j) w[j] = cw[j * 256 + ch]; }
    const float cb = F_conv_b[l * 256 + ch];
    const f32x4 lng = *(const f32x4*)(F_conv_ln_g + l * 256 + 4 * F.lane), lnb = *(const f32x4*)(F_conv_ln_b + l * 256 + 4 * F.lane);
    u32x4 pf[6];
    const int cv0 = F.G - 1 - F.vcu;
    if (cv0 < nunits) conv_fetch(U, cv0, F.tid_(), pf);
#pragma unroll 1
    for (int un = cv0; un < nunits; un += F.G) {
        int rowbase, t0, slen; conv_unit_rows(un, rowbase, t0, slen);
        __syncthreads();
#pragma unroll
        for (int q = 0; q < 6; ++q) { const int i = F.tid_() + q * NTHR, tt = i >> 5, c8 = (i & 31) * 8;
            if (tt < 94) { *(LAS f32x4*)(g + tt * 256 + c8) = (f32x4){bflo(pf[q].x), bfhi(pf[q].x), bflo(pf[q].y), bfhi(pf[q].y)};
                           *(LAS f32x4*)(g + tt * 256 + c8 + 4) = (f32x4){bflo(pf[q].z), bfhi(pf[q].z), bflo(pf[q].w), bfhi(pf[q].w)}; } }
        if (un + F.G < nunits) conv_fetch(U, un + F.G, F.tid_(), pf);
        __syncthreads();
        float out[32];
        { const LAS float* gp = g + (32 * half) * 256 + ch;
          float in[62];
#pragma unroll
          for (int i = 0; i < 62; ++i) in[i] = gp[i * 256];
#pragma unroll
          for (int t = 0; t < 32; ++t) { float sacc = cb;
#pragma unroll
              for (int j = 0; j < 31; ++j) sacc += w[j] * in[t + j];
              out[t] = sacc; } }
        __syncthreads();
#pragma unroll
        for (int t = 0; t < 32; ++t) g[(32 * half + t) * 256 + ch] = out[t];
        __syncthreads();
#pragma unroll 1
        for (int q = 0; q < 8; ++q) { const int tl = F.wave * 8 + q;
            const f32x4 v = *(const LAS f32x4*)(g + tl * 256 + 4 * F.lane);
            float s1 = (v[0] + v[1]) + (v[2] + v[3]), s2 = (v[0] * v[0] + v[1] * v[1]) + (v[2] * v[2] + v[3] * v[3]);
            wave_sum2(s1, s2);
            const float mean = s1 * (1.0f / 256.0f), rstd = 1.0f / sqrtf(fmaxf(s2 * (1.0f / 256.0f) - mean * mean, 0.f) + LN_EPS);
            f32x4 y = ((v - mean) * rstd) * lng + lnb;
#pragma unroll
            for (int i = 0; i < 4; ++i) y[i] = y[i] * __builtin_amdgcn_rcpf(1.0f + __builtin_amdgcn_exp2f(-y[i] * LOG2E));
            u32x2 o; o.x = cvt_pk_bf16(y[0], y[1]); o.y = cvt_pk_bf16(y[2], y[3]);
            *(GAS u32x2*)(MIX + (size_t)(rowbase + t0 + tl) * D + 768 + 4 * F.lane) = o; }
    }
    __syncthreads();
}

namespace att {
typedef float f32x16 __attribute__((ext_vector_type(16)));
typedef short s16x4 __attribute__((ext_vector_type(4)));
typedef short v4i16_t __attribute__((ext_vector_type(4)));
typedef float f32x2_t __attribute__((ext_vector_type(2)));
typedef __bf16 bf16x2_t __attribute__((ext_vector_type(2)));
constexpr int SLOTB = 16384, LDS_WS = 2 * SLOTB, LDS_OST = LDS_WS + 2048, LDS_BIAS = LDS_OST + 8 * 4096, LDS_ULIST = LDS_BIAS + 15 * 16 * 48 * 4, LDS_TOTAL = LDS_ULIST + 8192;
constexpr float THR = 8.0f;
__device__ __forceinline__ int crow(int r, int hi) { return (r & 3) + 8 * (r >> 2) + 4 * hi; }
__device__ __forceinline__ unsigned cvtpk_s(float lo, float hi) { f32x2_t v = {lo, hi}; bf16x2_t b = __builtin_convertvector(v, bf16x2_t); return __builtin_bit_cast(unsigned, b); }
__device__ __forceinline__ s16x4 vtr(const LAS unsigned char* p) { return __builtin_bit_cast(s16x4, __builtin_amdgcn_ds_read_tr16_b64_v4i16((LAS v4i16_t*)p)); }

struct AGeo { int qrow, qcol, kcol, vcol, ocol, nt, wrow0, jlo, R0, ctxrow0, alo, ahi, blk, hd, sinkh, ctxq; };
template <int TYPE>
__device__ __forceinline__ AGeo att_geo(int wid, int u) {
    AGeo g; int b, hd, blk; bool ctxq;
    if (TYPE == 0) { ctxq = u >= 1024; const int uc = u - 1024; b = ctxq ? uc >> 3 : u >> 8; hd = ctxq ? (uc >> 2) & 1 : (u >> 7) & 1; blk = ctxq ? uc & 3 : u & 127; }
    else { ctxq = u >= 512; const int uc = u - 512; b = ctxq ? uc >> 2 : u >> 7; hd = ctxq ? uc & 3 : (u >> 5) & 3; blk = ctxq ? 0 : u & 31; }
    if (TYPE == 0) { const int qh = hd * 4 + (wid >> 1); g.qcol = OFF_AQ + qh * 64; g.kcol = OFF_AK + hd * 64; g.vcol = OFF_AV + hd * 64; g.ocol = qh * 64; g.sinkh = qh;
        const int tok = 64 * blk + 32 * (wid & 1); g.qrow = ctxq ? RL + b * NCTX + tok : b * SEQ + tok; }
    else { g.qcol = OFF_BQ + hd * 64; g.kcol = OFF_BK + hd * 64; g.vcol = OFF_BV + hd * 64; g.ocol = 512 + hd * 64; g.sinkh = 0;
        const int tok = ctxq ? 32 * wid : (4 * blk + (wid >> 1)) * 64 + 32 * (wid & 1); g.qrow = ctxq ? RL + b * NCTX + tok : b * SEQ + tok; }
    int nwin = 0, wrow0 = 0, jlo = 0, R0 = 0;
    if (!ctxq) {
        if (TYPE == 0) { const int s0 = 64 * blk; jlo = s0 >= 128 ? 0 : (128 - s0) >> 6; const int jhi = min(4, (SEQ + 64 - s0) >> 6); nwin = jhi - jlo + 1; wrow0 = b * SEQ + s0 - 128 + 64 * jlo; }
        else { R0 = min(max(4 * blk - 4, 0), 120); const int R1 = min(max(4 * blk - 1, 0), 120) + 7; nwin = R1 - R0 + 1; wrow0 = b * SEQ + R0 * 64; }
    }
    g.nt = 4 + nwin; g.wrow0 = wrow0; g.jlo = jlo; g.R0 = R0; g.ctxrow0 = RL + b * NCTX; g.blk = blk; g.hd = hd; g.ctxq = ctxq ? 1 : 0;
    int alo = 4, ahi = g.nt;
    if (TYPE == 1 && !ctxq) { const int qg = 4 * blk + (wid >> 1), rs = min(max(qg - 4, 0), 120); alo = 4 + rs - R0; ahi = alo + 8; }
    g.alo = alo; g.ahi = ahi;
    return g;
}

template <int TYPE>
__device__ __forceinline__ void attn_stream(const Frame& F, int l, const bf16_t* U, bf16_t* MIX, LAS unsigned char* shm, int nun) {
    const int lane = F.lane, wid = F.wave;
    const LAS int* ul = (const LAS int*)(shm + LDS_ULIST) + 1;
    const char* Ub = (const char*)U;
    float NEGBIG = -1e30f; asm volatile("" : "+v"(NEGBIG));
    LAS float* wsf = (LAS float*)(shm + LDS_WS) + wid * 64;
#define ATT_TROW(G_, ti_) ((ti_) < 4 ? G_.ctxrow0 + 64 * (ti_) : G_.wrow0 + 64 * ((ti_) - 4))
#define ATT_DMA_K(G_, P_, ti_) __builtin_amdgcn_global_load_lds((const unsigned*)(Ub + (size_t)ATT_TROW(G_, ti_) * (INW * 2) + (unsigned)(ln_ * INW + G_.kcol + wid * 8) * 2u), (LAS unsigned*)(shm + (((ti_) + P_) & 1) * 8192 + wid * 1024), 16, 0, 0)
#define ATT_DMA_V(G_, P_, ti_) __builtin_amdgcn_global_load_lds((const unsigned*)(Ub + (size_t)ATT_TROW(G_, ti_) * (INW * 2) + (unsigned)((16 * (wid & 3) + (ln_ >> 2)) * INW + G_.vcol + (wid >> 2) * 32 + (ln_ & 3) * 8) * 2u), (LAS unsigned*)(shm + 16384 + (((ti_) + P_) & 1) * 8192 + wid * 1024), 16, 0, 0)
#define ATT_LOADQ(G_) do { const char* qb_ = Ub + (size_t)G_.qrow * (INW * 2); const unsigned qo_ = (unsigned)((ln_ & 31) * INW + G_.qcol + (ln_ >> 5) * 8) * 2u; \
        _Pragma("unroll") for (int d0 = 0; d0 < 4; ++d0) qr[d0] = *(const bf16x8*)(qb_ + qo_ + d0 * 32); } while (0)
    int par = 0, tblh = -1;
    if (wid >= 4) __builtin_amdgcn_s_setprio(1);
    bf16x8 qr[4];
    AGeo g = att_geo<TYPE>(wid, __builtin_amdgcn_readfirstlane(ul[0]));
    { const int ln_ = lane; ATT_DMA_K(g, par, 0); ATT_DMA_V(g, par, 0); ATT_DMA_K(g, par, 1); ATT_LOADQ(g); }
#pragma unroll 1
    for (int ui = 0; ui < nun; ++ui) {
        const bool hasn = ui + 1 < nun;
        const AGeo gn = att_geo<TYPE>(wid, __builtin_amdgcn_readfirstlane(ul[hasn ? ui + 1 : ui]));
        const int nt = g.nt, parn = (par + nt) & 1;
        if (TYPE == 1) { if (!g.ctxq && tblh != g.hd) { tblh = g.hd; const float* nb = F_nat_bias + (size_t)(l * 4 + g.hd) * 15 * 31; LAS float* bl = (LAS float*)(shm + LDS_BIAS); LAS float* raw = (LAS float*)(shm + LDS_ULIST + 4096);
            for (int i = F.tid_(); i < 15 * 31; i += NTHR) raw[i] = nb[i] * LOG2E;
            __syncthreads();
            for (int i = F.tid_(); i < 15 * 16 * 48; i += NTHR) { const int dr = i / 768, rem = i - dr * 768, dl_ = rem / 48, w = rem - dl_ * 48 - 16;
                bl[i] = (w >= 0 && w < 16) ? raw[dr * 31 + (w - dl_ + 15)] : -1e30f; } } }
        float sinkv = 0.f; if (TYPE == 0) sinkv = F_a_sink[l * 8 + g.sinkh] * LOG2E;
        float mrun = 0.f, lrun = 0.f; f32x16 o[2], pc0, pc1, negm;
#pragma unroll
        for (int r = 0; r < 16; ++r) { o[0][r] = 0.f; o[1][r] = 0.f; negm[r] = 0.f; }
        if (ui == 0) { asm volatile("s_waitcnt vmcnt(0) lgkmcnt(0)" ::: "memory"); __builtin_amdgcn_s_barrier(); asm volatile("" ::: "memory"); }
#define ATT_QK(P0, P1, ti_) do { const LAS unsigned char* kb = shm + (((ti_) + par) & 1) * 8192 + hi * 1024 + r32 * 16; \
        _Pragma("unroll") for (int d0 = 0; d0 < 4; ++d0) { const bf16x8 b0 = *(const LAS bf16x8*)(kb + d0 * 2048), b1 = *(const LAS bf16x8*)(kb + d0 * 2048 + 512); \
            if (d0 == 0) { P0 = __builtin_amdgcn_mfma_f32_32x32x16_bf16(b0, qr[0], negm, 0, 0, 0); P1 = __builtin_amdgcn_mfma_f32_32x32x16_bf16(b1, qr[0], negm, 0, 0, 0); } \
            else { P0 = __builtin_amdgcn_mfma_f32_32x32x16_bf16(b0, qr[d0], P0, 0, 0, 0); P1 = __builtin_amdgcn_mfma_f32_32x32x16_bf16(b1, qr[d0], P1, 0, 0, 0); } } } while (0)
        { int l0_ = lane; asm volatile("" : "+v"(l0_)); const int r32 = l0_ & 31, hi = l0_ >> 5; ATT_QK(pc0, pc1, 0); }
        asm volatile("s_waitcnt vmcnt(0) lgkmcnt(0)" ::: "memory"); __builtin_amdgcn_s_barrier(); asm volatile("" ::: "memory");
#pragma unroll 1
        for (int ti = 0; ti < nt; ++ti) {
            int ln_ = lane; asm volatile("" : "+v"(ln_));
            const int r32 = ln_ & 31, hi = ln_ >> 5;
            if (ti + 2 < nt) ATT_DMA_K(g, par, ti + 2);
            if (ti + 1 < nt) ATT_DMA_V(g, par, ti + 1);
            if (ti + 1 == nt && hasn) { ATT_DMA_K(gn, parn, 0); ATT_DMA_V(gn, parn, 0); ATT_DMA_K(gn, parn, 1); ATT_LOADQ(gn); }
            bf16x8 kf[8];
            { const LAS unsigned char* kb = shm + ((ti + 1 + par) & 1) * 8192 + hi * 1024 + r32 * 16;
#pragma unroll
              for (int d0 = 0; d0 < 4; ++d0) { kf[2 * d0] = *(const LAS bf16x8*)(kb + d0 * 2048); kf[2 * d0 + 1] = *(const LAS bf16x8*)(kb + d0 * 2048 + 512); } }
            __builtin_amdgcn_sched_barrier(0);
            const bool act = TYPE == 0 || ti < 4 || (ti >= g.alo && ti < g.ahi), actn = (ti + 1 < nt) && (TYPE == 0 || ti + 1 < 4 || (ti + 1 >= g.alo && ti + 1 < g.ahi));
            int mode = 0, aux = 0;
            if (ti >= 4) {
                if (TYPE == 0) { const int j = g.jlo + (ti - 4); if (j == 0 || j == 4) { mode = 1; aux = 64 * j - 128 - 32 * (wid & 1); } }
                else { mode = 2; aux = (g.R0 + (ti - 4)) - (4 * g.blk + (wid >> 1)) + 7; }
            }
            if (act) {
                if (mode == 1) {
                    const int dbase = aux - r32 + 4 * hi;
#pragma unroll
                    for (int r = 0; r < 16; ++r) { const int d0_ = dbase + (r & 3) + 8 * (r >> 2); if (abs(d0_) > 128) pc0[r] = NEGBIG; if (abs(d0_ + 32) > 128) pc1[r] = NEGBIG; }
                } else if (mode == 2) {
                    const int qc = 32 * (wid & 1) + r32, cs = min(max(qc - 8, 0), 48);
                    const LAS float* tb = (const LAS float*)(shm + LDS_BIAS) + aux * 768 + (qc - cs) * 48;
                    const int off = 16 - cs + 4 * hi;
#define ATT_TB(P, r, kadd) P[r] += tb[min(max(off + ((r) & 3) + 8 * ((r) >> 2) + (kadd), 0), 47)]
                    if ((wid & 1) == 0) {
#pragma unroll
                        for (int r = 0; r < 16; ++r) ATT_TB(pc0, r, 0);
#pragma unroll
                        for (int r = 0; r < 4; ++r) ATT_TB(pc1, r, 32);
#pragma unroll
                        for (int r = 4; r < 16; ++r) pc1[r] = NEGBIG;
                    } else {
#pragma unroll
                        for (int r = 0; r < 12; ++r) pc0[r] = NEGBIG;
#pragma unroll
                        for (int r = 12; r < 16; ++r) ATT_TB(pc0, r, 0);
#pragma unroll
                        for (int r = 0; r < 16; ++r) ATT_TB(pc1, r, 32);
                    }
#undef ATT_TB
                }
                float rm = fmaxf(fmaxf(pc0[0], pc0[1]), pc0[2]), rm1 = fmaxf(fmaxf(pc1[0], pc1[1]), pc1[2]);
#pragma unroll
                for (int r = 3; r < 15; r += 2) { rm = fmaxf(fmaxf(rm, pc0[r]), pc0[r + 1]); rm1 = fmaxf(fmaxf(rm1, pc1[r]), pc1[r + 1]); }
                rm = fmaxf(fmaxf(rm, pc0[15]), fmaxf(rm1, pc1[15]));
                if (ti == 0 || __any(rm > THR)) {
                    rm = max_halves(rm);
                    const float dl = (ti == 0) ? rm : fmaxf(rm, 0.f); mrun += dl;
#pragma unroll
                    for (int r = 0; r < 16; ++r) { pc0[r] -= dl; pc1[r] -= dl; negm[r] = -mrun; }
                    if (ti != 0) {
                        const float f = __builtin_amdgcn_exp2f(-dl); lrun *= f;
                        if (hi == 0) wsf[r32] = f;
#pragma unroll
                        for (int r = 0; r < 16; ++r) { const float fr_ = wsf[crow(r, hi)]; o[0][r] *= fr_; o[1][r] *= fr_; }
                    }
                }
            }
            u32x4 pw[4];
            if (act) {
                f32x2_t sa = {0.f, 0.f}, sb = {0.f, 0.f};
#pragma unroll
                for (int r = 0; r < 16; r += 2) { pc0[r] = __builtin_amdgcn_exp2f(pc0[r]); pc0[r + 1] = __builtin_amdgcn_exp2f(pc0[r + 1]); pc1[r] = __builtin_amdgcn_exp2f(pc1[r]); pc1[r + 1] = __builtin_amdgcn_exp2f(pc1[r + 1]);
                    sa += (f32x2_t){pc0[r], pc0[r + 1]}; sb += (f32x2_t){pc1[r], pc1[r + 1]}; }
                sa += sb; lrun += sa[0] + sa[1];
#pragma unroll
                for (int q = 0; q < 4; ++q) { pw[0][q] = cvtpk_s(pc0[2 * q], pc0[2 * q + 1]); pw[1][q] = cvtpk_s(pc0[8 + 2 * q], pc0[8 + 2 * q + 1]); pw[2][q] = cvtpk_s(pc1[2 * q], pc1[2 * q + 1]); pw[3][q] = cvtpk_s(pc1[8 + 2 * q], pc1[8 + 2 * q + 1]); }
                asm volatile("" : "+v"(pw[0]), "+v"(pw[1]), "+v"(pw[2]), "+v"(pw[3]), "+v"(lrun));
            }
            s16x4 vl[8], vh[8];
            if (act) {
                const LAS unsigned char* vp = shm + 16384 + ((ti + par) & 1) * 8192 + ((r32 >> 4) & 1) * 32 + (r32 & 3) * 8 + (4 * hi + ((r32 & 15) >> 2)) * 64;
#pragma unroll
                for (int d0 = 0; d0 < 2; ++d0)
#pragma unroll
                    for (int ks = 0; ks < 4; ++ks) { vl[d0 * 4 + ks] = vtr(vp + d0 * 4096 + ks * 1024); vh[d0 * 4 + ks] = vtr(vp + d0 * 4096 + ks * 1024 + 512); }
            }
            __builtin_amdgcn_sched_barrier(0);
            if (actn) {
#pragma unroll
                for (int d0 = 0; d0 < 4; ++d0) {
                    if (d0 == 0) { pc0 = __builtin_amdgcn_mfma_f32_32x32x16_bf16(kf[0], qr[0], negm, 0, 0, 0); pc1 = __builtin_amdgcn_mfma_f32_32x32x16_bf16(kf[1], qr[0], negm, 0, 0, 0); }
                    else { pc0 = __builtin_amdgcn_mfma_f32_32x32x16_bf16(kf[2 * d0], qr[d0], pc0, 0, 0, 0); pc1 = __builtin_amdgcn_mfma_f32_32x32x16_bf16(kf[2 * d0 + 1], qr[d0], pc1, 0, 0, 0); } }
            }
            if (act) {
#pragma unroll
                for (int d0 = 0; d0 < 2; ++d0)
#pragma unroll
                    for (int ks = 0; ks < 4; ++ks) { const s16x4 lo = vl[d0 * 4 + ks], hh = vh[d0 * 4 + ks];
                        const bf16x8 vf = (bf16x8){lo[0], lo[1], lo[2], lo[3], hh[0], hh[1], hh[2], hh[3]};
                        o[d0] = __builtin_amdgcn_mfma_f32_32x32x16_bf16(__builtin_bit_cast(bf16x8, pw[ks]), vf, o[d0], 0, 0, 0); }
            }
            asm volatile("s_waitcnt vmcnt(0) lgkmcnt(0)" ::: "memory"); __builtin_amdgcn_s_barrier(); asm volatile("" ::: "memory");
        }
        lrun = sum_halves(lrun);
        if (TYPE == 0) lrun += __builtin_amdgcn_exp2f(sinkv - mrun);
        int le_ = lane; asm volatile("" : "+v"(le_));
        const int r32 = le_ & 31, hi = le_ >> 5;
        if (hi == 0) wsf[32 + r32] = 1.0f / lrun;
        LAS bf16_t* stg3 = (LAS bf16_t*)(shm + LDS_OST) + wid * 2048;
        f32x4 rl4[4];
#pragma unroll
        for (int j = 0; j < 4; ++j) rl4[j] = *(const LAS f32x4*)(wsf + 32 + 8 * j + 4 * hi);
#pragma unroll
        for (int r = 0; r < 16; ++r) { const int orow = crow(r, hi); const float rl_ = rl4[r >> 2][r & 3];
            stg3[orow * 64 + r32] = (bf16_t)cvtpk_s(o[0][r] * rl_, 0.f); stg3[orow * 64 + 32 + r32] = (bf16_t)cvtpk_s(o[1][r] * rl_, 0.f); }
        asm volatile("s_waitcnt lgkmcnt(0)" ::: "memory");
        { char* ob_ = (char*)MIX + (size_t)g.qrow * (D * 2) + g.ocol * 2;
#pragma unroll
          for (int i = 0; i < 4; ++i) { const int row = i * 8 + (le_ >> 3), ch = le_ & 7; const u32x4 v = *(const LAS u32x4*)(stg3 + row * 64 + ch * 8); *(u32x4*)(ob_ + (unsigned)(row * D + ch * 8) * 2u) = v; } }
        asm volatile("s_waitcnt lgkmcnt(0)" ::: "memory");
        g = gn; par = parn;
    }
    __builtin_amdgcn_s_setprio(0);
    __builtin_amdgcn_s_barrier(); asm volatile("" ::: "memory");
#undef ATT_DMA_K
#undef ATT_DMA_V
#undef ATT_TROW
#undef ATT_QK
#undef ATT_LOADQ
}
}

__device__ __forceinline__ void phase_attn(Frame& F, int l, const bf16_t* U, bf16_t* MIX, bool with_ctx) {
    LAS unsigned char* shm = F.lds;
    const int nA = 1024 + (with_ctx ? 32 : 0), nB = 512 + (with_ctx ? 16 : 0);
#ifndef DBG_MIX
#define DBG_MIX 0
#endif
    LAS int* ul = (LAS int*)(shm + att::LDS_ULIST);
    if (F.tid_() == 0) { int n = 0;
#pragma unroll 1
        for (int j = 0; j < ((DBG_MIX & 1) ? 10 : 5); ++j) { const int jj = j % 5;
#pragma unroll 1
            for (int ua = (jj < 4 ? F.vcu * 4 + jj : 1024 + F.vcu); ua < (jj < 4 ? min(1024, nA) : nA); ua += (jj < 4 ? F.G * 4 : F.G)) ul[1 + n++] = ua; }
        ul[0] = n; }
    __syncthreads();
    { const int n = __builtin_amdgcn_readfirstlane(ul[0]); if (n > 0) att::attn_stream<0>(F, l, U, MIX, shm, n); }
    __syncthreads();
    if (F.tid_() == 0) { int n = 0;
#pragma unroll 1
        for (int j = 0; j < ((DBG_MIX & 2) ? 6 : 3); ++j) { const int jj = j % 3;
#pragma unroll 1
            for (int ub = (jj < 2 ? F.vcu * 2 + jj : 512 + ((F.vcu + F.G - 32) % F.G)); ub < (jj < 2 ? min(512, nB) : nB); ub += (jj < 2 ? F.G * 2 : F.G)) ul[1 + n++] = ub; }
        ul[0] = n; }
    __syncthreads();
    { const int n = __builtin_amdgcn_readfirstlane(ul[0]); if (n > 0) att::attn_stream<1>(F, l, U, MIX, shm, n); }
    __syncthreads();
}


constexpr int NPHASE = 18;
__global__ void __launch_bounds__(NTHR, 2) hybrid_fwd(Args args) {
    extern __shared__ __attribute__((aligned(16))) unsigned char lds_raw[];
    Frame F;
    F.lds = (LAS unsigned char*)lds_raw;
    F.lane = threadIdx.x & 63; F.wave = __builtin_amdgcn_readfirstlane(threadIdx.x >> 6);
    F.G = gridDim.x; { const int bx = blockIdx.x; F.vcu = (F.G % 8 == 0) ? (bx % 8) * (F.G / 8) + bx / 8 : bx; }
    F.ws = args.ws;
    for (int u = F.tid_(); u < (LDS_BYTES - LDSCTL_OFF) / 4; u += NTHR) ((LAS unsigned*)(F.lds + LDSCTL_OFF))[u] = 0u;
    __syncthreads();
    if (F.tid_() < 24) ((LAS unsigned long long*)(F.lds + PTR_OFF))[F.tid_()] = ((const unsigned long long*)&args)[F.tid_()];
    __syncthreads();
    volatile LAS unsigned* MISC = (volatile LAS unsigned*)(F.lds + MISC_OFF);
    XcdBarrier bar; bar.bar = (unsigned*)(F.ws + WS_CTL) + CW_BAR; bar.x = 0; bar.st = nullptr;
    if (!MK_PER_PHASE) bar = xcd_barrier_post((unsigned*)(F.ws + WS_CTL) + CW_BAR, MISC + 8);
    const int lo = args.ph_lo, hi = args.ph_hi;
    const int wave0 = F.wave; LAS unsigned char* const lds_base = F.lds;
    bool repeated = false;
#pragma unroll 1
    for (int ph = lo; ph < hi; ++ph) {
        { unsigned char* w = (unsigned char*)inp(F, 23); asm volatile("" : "+s"(w)); F.ws = w;
          unsigned z_ = 0u; asm volatile("" : "+v"(z_));
          int w_ = wave0, l_ = (int)__builtin_amdgcn_mbcnt_hi(~0u, __builtin_amdgcn_mbcnt_lo(~0u, z_)); asm volatile("" : "+s"(w_), "+v"(l_)); F.wave = w_; F.lane = l_;
          unsigned lb_ = (unsigned)(uintptr_t)lds_base; asm volatile("" : "+s"(lb_)); F.lds = (LAS unsigned char*)(uintptr_t)lb_;
          int bx_ = blockIdx.x, g_ = gridDim.x; asm volatile("" : "+s"(bx_), "+s"(g_)); F.G = g_; F.bx = bx_; F.vcu = (g_ % 8 == 0) ? (bx_ % 8) * (g_ / 8) + bx_ / 8 : bx_; }
#ifndef DBG_REP
#define DBG_REP 0
#endif
        const int ptype = ph == 0 ? 8 : ph == 1 ? 9 : ((ph - 2) & 7);
        const bool cia = F.G >= 64;
        const int NC0 = cia ? 32 : 0, NC1 = cia ? 12 : 0;
        int inproj = 0, il = 0;
        const int l = ph >= 2 ? (ph - 2) >> 3 : 0, p = ph >= 2 ? (ph - 2) & 7 : -1;
        unsigned char* rA = F.ws + (l == 0 ? WS_P : WS_Q); unsigned char* rB = F.ws + (l == 0 ? WS_Q : WS_P);
        const bool wc = (l == 0);
        const int nrows = wc ? R : RL, mt = wc ? 17 : 16;
        if (ph == 0) { mod_items(F); __syncthreads(); rope_table(F);
            { int* rid = (int*)(F.ws + WS_RIDENT); for (int i = F.vcu * NTHR + F.tid_(); i < NE * EROWS; i += F.G * NTHR) rid[i] = i; }
            { const int nmod = F.G > 96 ? 48 : 0, cut = (CONV_NITEMS * 86) / 100;
              convert_weights(F, 0, 0, cut, F.vcu, F.G); if (F.vcu >= nmod) convert_weights(F, 0, cut, CONV_NITEMS, F.vcu - nmod, F.G - nmod); } }
        else if (ph == 1) { if (F.vcu >= NC0) phase_h0(F, (bf16_t*)(F.ws + WS_P), NC0); else { inproj = 2; il = 0; } }
        else if (p == 0) { inproj = 1; il = l; }
        else if (p == 1) {
            phase_attn(F, l, (const bf16_t*)rB, (bf16_t*)(rA + HALFREG), wc); phase_conv(F, l, (const bf16_t*)rB, (bf16_t*)(rA + HALFREG), wc);
        } else if (p == 2) {
            pg8::Gemm g{(const bf16_t*)(rA + HALFREG), (const bf16_t*)(F.ws + wsw(l, WS_WOUT)), D, nullptr}; pg8::TileOrder S; S.init(nrows / 256, D / 256, F.G, F.bx, 0);
            pg8::EpiBf16 E{(bf16_t*)rA, D};
            pg8::gemm_phase<pg8::EpiBf16, false, false>(F.tid_(), F.lds, F.lds + RIDX_OFF, g, S, E);
            if (l == 0) { const int nu = (nrows / 256) * (D / 256), nlast = nu - (nu / F.G) * F.G; if (F.bx >= nlast) { __syncthreads(); convert_weights(F, 1, 0, CONV_S1, F.bx - nlast, F.G - nlast); } }
        } else if (p == 3) { if (l == 0) phase_rowpass1<true>(F, l, (const bf16_t*)rA, rA + HALFREG, nrows); else phase_rowpass1<false>(F, l, (const bf16_t*)rA, rA + HALFREG, nrows);
        } else if (p == 4) { phase_topk(F, wc);
        } else if (p == 5) {
            pg8::Gemm g{(const bf16_t*)(rA + HALFREG), (const bf16_t*)(F.ws + wsw(l, WS_WGU)), D, (const int*)(F.ws + WS_RIDX)}; pg8::TileOrder S; S.init(NE * mt, 8, F.G, F.bx, mt);
            pg8::EpiSwiGLU E{rB};
            pg8::gemm_phase<pg8::EpiSwiGLU, true, true>(F.tid_(), F.lds, F.lds + RIDX_OFF, g, S, E);
            if (l == 0) { const int nu = NE * mt * 8, nlast = nu - (nu / F.G) * F.G; if (nlast > 0 && F.bx >= nlast) { __syncthreads(); convert_weights(F, 1, CONV_S1, CONV_S2, F.bx - nlast, F.G - nlast); } }
        } else if (p == 6) {
            pg8::Gemm g{(const bf16_t*)rB, (const bf16_t*)(F.ws + wsw(l, WS_WD)), FF, (const int*)(F.ws + WS_RIDENT)}; pg8::TileOrder S; S.init(NE * mt, 4, F.G, F.bx, mt);
            pg8::EpiRowScale E{rA, (const float*)(F.ws + WS_GATEW), (const LAS float*)(F.lds + pg8::ROWVEC_OFF)};
            pg8::gemm_phase<pg8::EpiRowScale, true, true>(F.tid_(), F.lds, F.lds + RIDX_OFF, g, S, E);
            if (l == 0) { const int nu = NE * mt * 4, nlast = nu - (nu / F.G) * F.G; if (nlast > 0 && F.bx >= nlast) { __syncthreads(); convert_weights(F, 1, CONV_S2, CONV_NITEMS, F.bx - nlast, F.G - nlast); } }
        } else {
            if (l == 0 && F.vcu < NC1) { inproj = 3; il = 1; } else { if (l == 0) phase_rowpass2<true>(F, l, rA, (bf16_t*)rB, nrows, NC1); else phase_rowpass2<false>(F, l, rA, (bf16_t*)rB, nrows, 0); }
        }
        if (inproj) {
            unsigned char* hA = F.ws + (il == 0 ? WS_P : WS_Q); unsigned char* uB = F.ws + (il == 0 ? WS_Q : WS_P);
            pg8::Gemm g{(const bf16_t*)hA, (const bf16_t*)(F.ws + wsw(il, WS_WIN)), D, nullptr}; pg8::TileOrder S;
            if (inproj == 1) S.init((cia ? RL : R) / 256, INW / 256, F.G, F.bx, 0); else { S.init_special(inproj - 1, F.vcu); cia_wait(F, inproj - 2); }
            pg8::EpiInProj E{(bf16_t*)uB, (const float*)(F.ws + WS_ROPE), (const float*)(F.ws + WS_ROPE) + 128 * 16};
            pg8::gemm_phase<pg8::EpiInProj, false, false>(F.tid_(), F.lds, F.lds + RIDX_OFF, g, S, E);
        }
        if (DBG_REP && ((DBG_REP >> ptype) & 1) && !repeated) { repeated = true; __syncthreads(); --ph; continue; }
        repeated = false;
#ifdef DBG_BAR2
        if (ph + 1 < hi) xcd_barrier(bar);
#endif
        if (ph + 1 < hi) xcd_barrier(bar);
    }
}

extern "C" void kernel_launch(void* const* d_in, const int* in_sizes, int n_in, void* d_out, int out_size, void* d_ws, size_t ws_size, hipStream_t stream) {
    static int grid = 0;
    if (grid == 0) {
        if (n_in != 22 || out_size != RL * D || ws_size < WS_END) { fprintf(stderr, "kernel_launch: unexpected shapes (n_in %d out %d ws %zu)\n", n_in, out_size, ws_size); grid = -1; return; }
        int dev = 0, cus = 0, per_cu = 0;
        if (hipGetDevice(&dev) != hipSuccess || hipDeviceGetAttribute(&cus, hipDeviceAttributeMultiprocessorCount, dev) != hipSuccess) { grid = -1; return; }
        if (hipFuncSetAttribute((const void*)hybrid_fwd, hipFuncAttributeMaxDynamicSharedMemorySize, LDS_BYTES) != hipSuccess) { fprintf(stderr, "kernel_launch: hipFuncSetAttribute failed\n"); grid = -1; return; }
        if (hipOccupancyMaxActiveBlocksPerMultiprocessor(&per_cu, (const void*)hybrid_fwd, NTHR, LDS_BYTES) != hipSuccess || per_cu < 1) { fprintf(stderr, "kernel_launch: occupancy query says %d blocks/CU\n", per_cu); grid = -1; (void)hipGetLastError(); return; }
        grid = cus;
    }
    if (grid < 0) return;
    (void)hipMemsetAsync((char*)d_ws + WS_CTL, 0, CTL_ZERO_BYTES, stream);
    Args a{};
    for (int i = 0; i < 22; ++i) a.in[i] = (const float*)d_in[i];
    a.out = (float*)d_out; a.ws = (unsigned char*)d_ws;
#if MK_PER_PHASE
    for (int p = 0; p < NPHASE; ++p) { a.ph_lo = p; a.ph_hi = p + 1; hipLaunchKernelGGL(hybrid_fwd, dim3(grid), dim3(NTHR), LDS_BYTES, stream, a); }
#else
    a.ph_lo = 0; a.ph_hi = NPHASE;
    hipLaunchKernelGGL(hybrid_fwd, dim3(grid), dim3(NTHR), LDS_BYTES, stream, a);
#endif
}
```

```cpp
#include <hip/hip_runtime.h>
#include <cstdio>
#include <cstdint>

#ifndef MK_PER_PHASE
#define MK_PER_PHASE 0
#endif

#define LAS __attribute__((address_space(3)))
#define GAS __attribute__((address_space(1)))
typedef unsigned short bf16_t;
typedef short bf16x8 __attribute__((ext_vector_type(8)));
typedef float f32x4 __attribute__((ext_vector_type(4)));
typedef float f32x2 __attribute__((ext_vector_type(2)));
typedef unsigned u32x4 __attribute__((ext_vector_type(4)));
typedef unsigned u32x2 __attribute__((ext_vector_type(2)));

constexpr int D = 1024, NB = 4, SEQ = 8192, NCTX = 256, RL = NB * SEQ, RC = NB * NCTX, R = RL + RC;
constexpr int INW = 2048, NE = 16, FF = 1024;
constexpr int OFF_AQ = 0, OFF_AK = 512, OFF_AV = 640, OFF_BQ = 768, OFF_BK = 1024, OFF_BV = 1280, OFF_C = 1536;
constexpr int CAP_L = 1024, CAP_C = 32, EROWS = 4352, EMT = 17;
constexpr float LN_EPS = 1e-6f, ALPHA = 1.41421356237309515f;
constexpr float LOG2E = 1.4426950408889634f;
constexpr float C2 = 0.125f * LOG2E;

constexpr size_t MiB = 1u << 20;
constexpr size_t WS_CTL = 0, CTL_ZERO_BYTES = 1 * MiB;
constexpr size_t WS_MOD = 1 * MiB;
constexpr size_t WS_ROPE = 1 * MiB + 512 * 1024;
constexpr size_t WS_AFF = 2 * MiB;
constexpr size_t WS_AFFC = 4 * MiB;
constexpr size_t WS_INV = 5 * MiB;
constexpr size_t WS_RIDX = 8 * MiB;
constexpr size_t WS_GATEW = 8 * MiB + 512 * 1024;
constexpr size_t WS_RIDENT = 4 * MiB + 512 * 1024;
constexpr size_t WS_XC = 9 * MiB;
constexpr size_t WS_WIN = 13 * MiB;
constexpr size_t WS_WOUT = 17 * MiB;
constexpr size_t WS_WGU = 19 * MiB;
constexpr size_t WS_WD = 83 * MiB;
constexpr size_t WS_XA = 115 * MiB;
constexpr size_t WS_P = 247 * MiB;
constexpr size_t WS_Q = 383 * MiB;
constexpr size_t REGION = 136 * MiB, HALFREG = 68 * MiB;
constexpr size_t WS_W1 = 519 * MiB;
constexpr size_t WS_END = 573 * MiB;
__host__ __device__ constexpr size_t wsw(int l, size_t off) { return l == 0 ? off : (off == 13 * MiB ? WS_W1 : off == 17 * MiB ? WS_W1 + 4 * MiB : off == 19 * MiB ? WS_W1 + 6 * MiB : WS_W1 + 38 * MiB); }
constexpr int CW_BAR = 4096;

constexpr int RING_BYTES = 131072;
constexpr int RIDX_OFF = 143360;
constexpr int LDSCTL_OFF = RIDX_OFF + 2048, MISC_OFF = LDSCTL_OFF + 320, PTR_OFF = LDSCTL_OFF + 512;
constexpr int LDS_BYTES = 147456;
constexpr int NWAVES = 8, NTHR = 512;

__device__ __forceinline__ unsigned f2bf(float f) { unsigned u = __builtin_bit_cast(unsigned, f); return (u + 0x7fffu + ((u >> 16) & 1u)) >> 16; }
__device__ __forceinline__ unsigned pk2(float lo, float hi) { return f2bf(lo) | (f2bf(hi) << 16); }
__device__ __forceinline__ float bf2f(unsigned short b) { return __builtin_bit_cast(float, (unsigned)b << 16); }
__device__ __forceinline__ float bflo(unsigned w) { return __builtin_bit_cast(float, w << 16); }
__device__ __forceinline__ float bfhi(unsigned w) { return __builtin_bit_cast(float, w & 0xffff0000u); }
__device__ __forceinline__ unsigned pk4_fp8(float a, float b, float c, float d) { int w = 0; w = __builtin_amdgcn_cvt_pk_fp8_f32(a, b, w, false); w = __builtin_amdgcn_cvt_pk_fp8_f32(c, d, w, true); return (unsigned)w; }
__device__ __forceinline__ unsigned cvt_pk_bf16(float lo, float hi) { unsigned r; asm volatile("v_cvt_pk_bf16_f32 %0, %1, %2" : "=v"(r) : "v"(lo), "v"(hi)); return r; }
template <int O> __device__ __forceinline__ float swz_xor(float v) { return __builtin_bit_cast(float, __builtin_amdgcn_ds_swizzle(__builtin_bit_cast(int, v), (O << 10) | 0x1f)); }
__device__ __forceinline__ void swap_halves(float v, float& lo_everywhere, float& hi_everywhere) {
    unsigned a = __builtin_bit_cast(unsigned, v), b = a;
    asm volatile("s_nop 1\n\tv_permlane32_swap_b32 %0, %1\n\ts_nop 0" : "+v"(a), "+v"(b));
    lo_everywhere = __builtin_bit_cast(float, a); hi_everywhere = __builtin_bit_cast(float, b);
}
__device__ __forceinline__ float sum_halves(float v) { float x, y; swap_halves(v, x, y); return x + y; }
__device__ __forceinline__ float max_halves(float v) { float x, y; swap_halves(v, x, y); return fmaxf(x, y); }
__device__ __forceinline__ float other_half(float v, int hi) { float x, y; swap_halves(v, x, y); return hi ? x : y; }
template <int CTRL> __device__ __forceinline__ float dppf(float v) { return __builtin_bit_cast(float, __builtin_amdgcn_update_dpp(0, __builtin_bit_cast(int, v), CTRL, 0xf, 0xf, true)); }
__device__ __forceinline__ float row16_sum(float v) { v += dppf<0xB1>(v); v += dppf<0x4E>(v); v += dppf<0x141>(v); v += dppf<0x140>(v); return v; }
__device__ __forceinline__ float row16_max(float v) { v = fmaxf(v, dppf<0xB1>(v)); v = fmaxf(v, dppf<0x4E>(v)); v = fmaxf(v, dppf<0x141>(v)); v = fmaxf(v, dppf<0x140>(v)); return v; }
__device__ __forceinline__ float wave_sum(float v) { v = row16_sum(v); v += swz_xor<16>(v); return sum_halves(v); }
__device__ __forceinline__ void wave_sum2(float& a, float& b) {
    a = row16_sum(a); b = row16_sum(b); const float a2 = swz_xor<16>(a), b2 = swz_xor<16>(b); a += a2; b += b2; a = sum_halves(a); b = sum_halves(b);
}
__device__ __forceinline__ unsigned lane_get(unsigned v, int srclane) { return (unsigned)__builtin_amdgcn_ds_bpermute(srclane << 2, (int)v); }
#define LDS_WAIT() asm volatile("s_waitcnt lgkmcnt(0)" ::: "memory")
#define VM_WAIT() asm volatile("s_waitcnt vmcnt(0)" ::: "memory")

#define XB_TMO      128
#define XB_XCNT(j)  (256  + 64 * (j))
#define XB_XSUB(j)  (1280 + 64 * (j))
#define XB_XGEN(j)  (2304 + 64 * (j))
#define XB_TOP      3328
#define XB_TOPGEN   3392
#define XCD_BAR_WORDS 3456
#define XB_SPIN_CAP (1u << 24)
__device__ __forceinline__ unsigned xb_ld(unsigned* p)              { return __hip_atomic_load(p, __ATOMIC_RELAXED, __HIP_MEMORY_SCOPE_AGENT); }
__device__ __forceinline__ unsigned xb_add(unsigned* p, unsigned v) { return __hip_atomic_fetch_add(p, v, __ATOMIC_RELAXED, __HIP_MEMORY_SCOPE_AGENT); }
__device__ __forceinline__ unsigned xb_xcc_id() { return (unsigned)__builtin_amdgcn_s_getreg((3 << 11) | 20) & 0xFu; }
#define XB_SPIN(cond, bar) do { unsigned _sp = 0; while (cond) { __builtin_amdgcn_s_sleep(1); \
    if ((++_sp & 255u) == 0u) { if (xb_ld(&(bar)[XB_TMO])) break; if (_sp > XB_SPIN_CAP) { atomicAdd(&(bar)[XB_TMO], 1u); break; } } } } while (0)
struct XcdBarrier { unsigned* bar; unsigned x; volatile LAS unsigned* st; };
__device__ __forceinline__ XcdBarrier xcd_barrier_post(unsigned* bar, volatile LAS unsigned* st) {
    XcdBarrier b; b.bar = bar; b.x = xb_xcc_id(); b.st = st;
    if (threadIdx.x == 0) (void)xb_add(&bar[XB_XCNT(b.x)], 1u);
    return b;
}
__device__ __forceinline__ int xb_row16_isum(int v) {
    v += __builtin_amdgcn_update_dpp(0, v, 0xB1, 0xf, 0xf, true); v += __builtin_amdgcn_update_dpp(0, v, 0x4E, 0xf, 0xf, true);
    v += __builtin_amdgcn_update_dpp(0, v, 0x141, 0xf, 0xf, true); v += __builtin_amdgcn_update_dpp(0, v, 0x140, 0xf, 0xf, true); return v;
}
__device__ __forceinline__ void xcd_barrier_complete_w0(unsigned* bar, unsigned x, unsigned& nloc, unsigned& nx) {
    const unsigned G = gridDim.x * gridDim.y * gridDim.z;
    const unsigned ln = threadIdx.x & 63u;
    unsigned c = 0u, sp = 0u;
    for (;;) {
        c = (ln < 16u) ? xb_ld(&bar[XB_XCNT(ln)]) : 0u;
        const unsigned sum = (unsigned)__builtin_amdgcn_readfirstlane(xb_row16_isum((int)c));
        if (sum == G) break;
        __builtin_amdgcn_s_sleep(1);
        if ((++sp & 255u) == 0u) { if (xb_ld(&bar[XB_TMO])) break; if (sp > XB_SPIN_CAP) { if (ln == 0u) atomicAdd(&bar[XB_TMO], 1u); break; } }
    }
    const unsigned cnt = (unsigned)__builtin_popcountll(__ballot(c > 0u));
    const unsigned mine = (unsigned)__builtin_amdgcn_readlane((int)c, (int)x);
    nloc = mine > 0u ? mine : 1u; nx = cnt > 0u ? cnt : 1u;
}
__device__ __forceinline__ void xcd_barrier(const XcdBarrier& b) {
    asm volatile("s_waitcnt vmcnt(0)" ::: "memory");
    __syncthreads();
    if (threadIdx.x < 64) {
        unsigned* bar = b.bar; unsigned bx_ = b.x; asm volatile("" : "+s"(bar), "+s"(bx_));
        __builtin_amdgcn_s_waitcnt(0);
        unsigned nloc = b.st[0], nx = b.st[1];
        if (nloc == 0u) { xcd_barrier_complete_w0(bar, bx_, nloc, nx); if (threadIdx.x == 0) { b.st[0] = nloc; b.st[1] = nx; } }
        if (threadIdx.x == 0) {
        const unsigned old = xb_add(&bar[XB_XSUB(bx_)], 1u);
        const unsigned gen = old / nloc;
        if (old + 1u == (gen + 1u) * nloc) {
            __builtin_amdgcn_fence(__ATOMIC_RELEASE, "agent");
            asm volatile("s_waitcnt vmcnt(0)" ::: "memory");
            const unsigned og = xb_add(&bar[XB_TOP], 1u);
            const unsigned tg = og / nx;
            if (og + 1u == (tg + 1u) * nx) xb_add(&bar[XB_TOPGEN], 1u);
            else XB_SPIN(xb_ld(&bar[XB_TOPGEN]) == tg, bar);
            __builtin_amdgcn_fence(__ATOMIC_ACQUIRE, "agent");
            xb_add(&bar[XB_XGEN(bx_)], 1u);
            asm volatile("s_waitcnt vmcnt(0)" ::: "memory");
        } else {
            XB_SPIN(xb_ld(&bar[XB_XGEN(bx_)]) == gen, bar);
            __builtin_amdgcn_fence(__ATOMIC_ACQUIRE, "agent");
            asm volatile("s_waitcnt vmcnt(0)" ::: "memory");
        }
        }
    }
    __syncthreads();
}

namespace pg8 {
constexpr int BM = 256, BK = 64, HALF = 128, HTB = HALF * BK * 2, STAGE_BYTES = 8 * HTB, NXCD = 8, WGM = 8, ROWVEC_OFF = STAGE_BYTES;
__host__ __device__ constexpr __forceinline__ int lds_byte(int r, int c) { const int st = (r >> 4) * 2 + (c >> 5), rr = r & 15, cc = c & 31, ob = rr * 64 + cc * 2; return st * 1024 + (ob ^ (((ob >> 9) & 1) << 5)); }
__host__ __device__ __forceinline__ void stage_rc(int b, int& Rr, int& C) { const int st = b / 1024, sb = b % 1024, swz = sb ^ (((sb >> 9) & 1) << 5); Rr = (st >> 1) * 16 + swz / 64; C = (st & 1) * 32 + (swz % 64) / 2; }
__host__ __device__ __forceinline__ int perm32(int rho) { const int n = rho >> 4, i = rho & 15; return 8 * (i >> 2) + 4 * n + (i & 3); }

struct Unit { int pm, pn, am, bn; };
struct Gemm { const bf16_t* A; const bf16_t* Bt; int K; const int* ridx; };

struct TileOrder {
    int nM, nN, nwg, G, c, mt, special, sidx;
    __device__ void init(int nM_, int nN_, int G_, int c_, int mt_) { nM = nM_; nN = nN_; nwg = nM * nN; G = G_; c = c_; mt = mt_; special = 0; sidx = 0; }
    __device__ void init_special(int kind, int idx) { nM = nN = nwg = G = 1; c = 0; mt = 0; special = kind; sidx = idx; }
    __device__ bool next(int i, Unit& u) const {
        int pm, pn, am, bn; bool ok;
        if (special) { ok = (i == 0); const int t = sidx >> 2; pm = am = RL / BM + (sidx & 3); pn = bn = (special == 1) ? t : (t == 0 ? 2 : 3 + t); }
        else {
            const long L = (long)i * G + c; ok = L < nwg;
            int wgid = ok ? (int)L : 0; { const int q = nwg / NXCD, r = nwg % NXCD, xcd = wgid % NXCD, off = wgid / NXCD; wgid = (xcd < r ? xcd * (q + 1) : r * (q + 1) + (xcd - r) * q) + off; }
            const int nig = WGM * nN, gid = wgid / nig, fm = gid * WGM, gsz = (nM - fm) < WGM ? (nM - fm) : WGM;
            pm = fm + ((wgid % nig) % gsz); pn = (wgid % nig) / gsz;
            if (mt > 0) { const int e = pm / mt; am = e * EMT + (pm - e * mt); bn = e * nN + pn; } else { am = pm; bn = pn; }
        }
        u.pm = pm; u.pn = pn; u.am = am; u.bn = bn;
        return ok;
    }
};

struct EpiBf16 {
    static constexpr bool ROWVEC = false;
    bf16_t* O; int ldc;
    __device__ __forceinline__ void operator()(const f32x4 (&acc)[2][2][4][2], const Unit& u, int wr, int wc, int fr, int fq, int ui) const {
        const int row0 = u.am * BM + wr * 64 + fr, col0 = u.pn * BM + wc * 32 + 8 * fq;
#pragma unroll
        for (int ai = 0; ai < 2; ++ai)
#pragma unroll
            for (int m = 0; m < 4; ++m) { bf16_t* rowp = O + (size_t)(row0 + ai * HALF + m * 16) * ldc + col0;
#pragma unroll
                for (int bj = 0; bj < 2; ++bj) { const f32x4 v0 = acc[ai][bj][m][0], v1 = acc[ai][bj][m][1];
                    u32x4 w; w.x = cvt_pk_bf16(v0[0], v0[1]); w.y = cvt_pk_bf16(v0[2], v0[3]); w.z = cvt_pk_bf16(v1[0], v1[1]); w.w = cvt_pk_bf16(v1[2], v1[3]);
                    *(u32x4*)(rowp + bj * HALF) = w; } }
    }
};
struct EpiInProj {
    static constexpr bool ROWVEC = false;
    bf16_t* O; const float* ropec; const float* ropes;
    __device__ __forceinline__ void operator()(const f32x4 (&acc)[2][2][4][2], const Unit& u, int wr, int wc, int fr, int fq, int ui) const {
        const int row0 = u.am * BM + wr * 64 + fr;
        if (u.pn >= 6) {
            const int col0 = OFF_C + (u.pn - 6) * HALF + wc * 32 + 8 * fq;
#pragma unroll
            for (int ai = 0; ai < 2; ++ai)
#pragma unroll
                for (int m = 0; m < 4; ++m) { bf16_t* rowp = O + (size_t)(row0 + ai * HALF + m * 16) * INW + col0;
                    float h[8];
#pragma unroll
                    for (int n = 0; n < 2; ++n)
#pragma unroll
                        for (int i = 0; i < 4; ++i) { const float a = acc[ai][0][m][n][i], g = acc[ai][1][m][n][i]; h[n * 4 + i] = a * __builtin_amdgcn_rcpf(1.0f + __builtin_amdgcn_exp2f(-g * LOG2E)); }
                    u32x4 w; w.x = cvt_pk_bf16(h[0], h[1]); w.y = cvt_pk_bf16(h[2], h[3]); w.z = cvt_pk_bf16(h[4], h[5]); w.w = cvt_pk_bf16(h[6], h[7]);
                    *(u32x4*)rowp = w; }
            return;
        }
        const int col0 = u.pn * BM + wc * 32 + 8 * fq;
        const bool latent = (u.am * BM) < RL;
        const float sc = (u.pn < 2 || u.pn == 3) ? C2 : 1.0f;
        const float sgn = (fq < 2) ? -1.0f : 1.0f;
        const int f0 = 8 * (fq & 1);
#pragma unroll
        for (int ai = 0; ai < 2; ++ai)
#pragma unroll
            for (int m = 0; m < 4; ++m) {
                const int row = row0 + ai * HALF + m * 16;
                bf16_t* rowp = O + (size_t)row * INW + col0;
                const int t = row & (SEQ - 1);
                const int pos = (wc & 1) ? (t & 63) : (t >> 6);
#pragma unroll
                for (int bj = 0; bj < 2; ++bj) {
                    f32x4 v0 = acc[ai][bj][m][0], v1 = acc[ai][bj][m][1];
                    const bool rope = latent && (u.pn < 2 || (u.pn == 2 && bj == 0));
                    if (rope) {
                        const f32x4 c0 = *(const f32x4*)(ropec + pos * 16 + f0), c1 = *(const f32x4*)(ropec + pos * 16 + f0 + 4);
                        const f32x4 s0 = *(const f32x4*)(ropes + pos * 16 + f0), s1 = *(const f32x4*)(ropes + pos * 16 + f0 + 4);
                        f32x4 p0, p1;
#pragma unroll
                        for (int i = 0; i < 4; ++i) { p0[i] = other_half(v0[i], fq >> 1); p1[i] = other_half(v1[i], fq >> 1); }
                        v0 = v0 * c0 + (p0 * s0) * sgn; v1 = v1 * c1 + (p1 * s1) * sgn;
                    }
                    v0 = v0 * sc; v1 = v1 * sc;
                    u32x4 w; w.x = cvt_pk_bf16(v0[0], v0[1]); w.y = cvt_pk_bf16(v0[2], v0[3]); w.z = cvt_pk_bf16(v1[0], v1[1]); w.w = cvt_pk_bf16(v1[2], v1[3]);
                    *(u32x4*)(rowp + bj * HALF) = w;
                }
            }
    }
};
struct EpiSwiGLU {
    static constexpr bool ROWVEC = false;
    unsigned char* O;
    __device__ __forceinline__ void operator()(const f32x4 (&acc)[2][2][4][2], const Unit& u, int wr, int wc, int fr, int fq, int ui) const {
        const int row0 = u.am * BM + wr * 64 + fr, col0 = u.pn * HALF + wc * 32 + 8 * fq;
#pragma unroll
        for (int ai = 0; ai < 2; ++ai)
#pragma unroll
            for (int m = 0; m < 4; ++m) { unsigned char* rowp = O + (size_t)(row0 + ai * HALF + m * 16) * FF + col0;
                float h[8];
#pragma unroll
                for (int n = 0; n < 2; ++n)
#pragma unroll
                    for (int i = 0; i < 4; ++i) { const float g = acc[ai][0][m][n][i], up = acc[ai][1][m][n][i];
                        const float sg = g * __builtin_amdgcn_rcpf(1.0f + __builtin_amdgcn_exp2f(-g * LOG2E)); h[n * 4 + i] = sg * up; }
                u32x2 w; w.x = pk4_fp8(h[0], h[1], h[2], h[3]); w.y = pk4_fp8(h[4], h[5], h[6], h[7]);
                *(u32x2*)rowp = w; }
    }
};
struct EpiRowScale {
    static constexpr bool ROWVEC = true;
    unsigned char* O; const float* gw; const LAS float* lgw;
    __device__ __forceinline__ void operator()(const f32x4 (&acc)[2][2][4][2], const Unit& u, int wr, int wc, int fr, int fq, int ui) const {
        const int row0 = u.am * BM + wr * 64 + fr, col0 = u.pn * BM + wc * 32 + 8 * fq;
#pragma unroll
        for (int ai = 0; ai < 2; ++ai)
#pragma unroll
            for (int m = 0; m < 4; ++m) { const int row = row0 + ai * HALF + m * 16; const float g = lgw[(ui & 1) * BM + wr * 64 + fr + ai * HALF + m * 16] * 16.0f; unsigned char* rowp = O + (size_t)row * D + col0;
#pragma unroll
                for (int bj = 0; bj < 2; ++bj) { const f32x4 v0 = acc[ai][bj][m][0] * g, v1 = acc[ai][bj][m][1] * g;
                    u32x2 w; w.x = pk4_fp8(v0[0], v0[1], v0[2], v0[3]); w.y = pk4_fp8(v1[0], v1[1], v1[2], v1[3]);
                    *(u32x2*)(rowp + bj * HALF) = w; } }
    }
};

typedef int v8i_t __attribute__((ext_vector_type(8)));
template <class Epi, bool GATHER, bool FP8>
__device__ __forceinline__ void gemm_phase(const int tid, LAS unsigned char* lds, LAS unsigned char* lds_ridx, const Gemm g, const TileOrder& S, const Epi& E) {
    const int wid = __builtin_amdgcn_readfirstlane(tid >> 6), lane = tid & 63, wr = wid >> 2, wc = wid & 3, fr = lane & 15, fq = lane >> 4;
    constexpr int ESZ = FP8 ? 1 : 2;
    const int K = g.K, nt = K * ESZ / (BK * 2);
    int RA[2], CA[2]; unsigned voffB[2];
#pragma unroll
    for (int i = 0; i < 2; ++i) { int Rr, C; stage_rc(tid * 16 + i * 8192, Rr, C); const int Rb = (Rr & ~31) + perm32(Rr & 31);
        RA[i] = Rr; CA[i] = C; voffB[i] = (unsigned)(Rb * K * ESZ + C * 2); }
    const size_t kstep = (size_t)(BK * 2);
    const size_t hstep = (size_t)HALF * K * ESZ;
    const size_t tstep = 2 * hstep;
    const unsigned ldsw = (unsigned)wid * 1024u;
    const int aoff = lds_byte(wr * 64 + fr, fq * 8), boff = lds_byte(wc * 32 + fr, fq * 8);
#define PG8_SA(b, h) (((b) * 2 + (h)) * HTB)
#define PG8_SB(b, h) ((4 + (b) * 2 + (h)) * HTB)
#define PG8_STAGE(bufoff, gbase, voff) do { _Pragma("unroll") for (int _i = 0; _i < 2; ++_i) \
        __builtin_amdgcn_global_load_lds((const unsigned*)((const char*)(gbase) + (voff)[_i]), (LAS unsigned*)(lds + (bufoff) + ldsw + _i * 8192), 16, 0, 0); } while (0)
#define PG8_STAGE_H1(bufoff, gbase) do { if constexpr (GATHER) PG8_STAGE(bufoff, gbase, v1); else PG8_STAGE(bufoff, (gbase) + hstep, v0); } while (0)
#define PG8_LD8(p0_, p1_) __builtin_bit_cast(v8i_t, __builtin_shufflevector(*(const LAS f32x4*)(p0_), *(const LAS f32x4*)(p1_), 0, 1, 2, 3, 4, 5, 6, 7))
#define PG8_LDA(dst, b, h) do { _Pragma("unroll") for (int m = 0; m < 4; ++m) { \
        if constexpr (FP8) dst##8[m] = PG8_LD8(lds + PG8_SA(b, h) + aoff + m * 2048, lds + PG8_SA(b, h) + aoff + 1024 + m * 2048); \
        else { _Pragma("unroll") for (int k = 0; k < 2; ++k) dst[m][k] = *(const LAS bf16x8*)(lds + PG8_SA(b, h) + aoff + k * 1024 + m * 2048); } } } while (0)
#define PG8_LDB(dst, b, h) do { _Pragma("unroll") for (int n = 0; n < 2; ++n) { \
        if constexpr (FP8) dst##8[n] = PG8_LD8(lds + PG8_SB(b, h) + boff + n * 2048, lds + PG8_SB(b, h) + boff + 1024 + n * 2048); \
        else { _Pragma("unroll") for (int k = 0; k < 2; ++k) dst[n][k] = *(const LAS bf16x8*)(lds + PG8_SB(b, h) + boff + k * 1024 + n * 2048); } } } while (0)
#define PG8_MMA(ai, bj, At, Bt) do { __builtin_amdgcn_s_setprio(1); _Pragma("unroll") for (int m = 0; m < 4; ++m) _Pragma("unroll") for (int n = 0; n < 2; ++n) { \
        if constexpr (FP8) acc[ai][bj][m][n] = __builtin_amdgcn_mfma_scale_f32_16x16x128_f8f6f4(Bt##8[n], At##8[m], acc[ai][bj][m][n], 0, 0, 0, mx_sw, 0, mx_sa); \
        else { _Pragma("unroll") for (int k = 0; k < 2; ++k) acc[ai][bj][m][n] = __builtin_amdgcn_mfma_f32_16x16x32_bf16(Bt[n][k], At[m][k], acc[ai][bj][m][n], 0, 0, 0); } } __builtin_amdgcn_s_setprio(0); } while (0)
#define PG8_WAIT_V(n) asm volatile("s_waitcnt vmcnt(" #n ")" ::: "memory")
#define PG8_WAIT_L(n) asm volatile("s_waitcnt lgkmcnt(" #n ")" ::: "memory")
#define PG8_BAR __builtin_amdgcn_s_barrier()
#define PG8_SCHED __builtin_amdgcn_sched_barrier(0)
#define PG8_PIN do { if constexpr (FP8) __builtin_amdgcn_sched_barrier(0); } while (0)
    int mx_sw = 0x79797979, mx_sa = 0x7F7F7F7F;
    if constexpr (FP8) asm volatile("" : "+v"(mx_sw), "+v"(mx_sa));
    Unit cur, nxt; int ui = 0;
    if (!S.next(0, cur)) return;
    f32x4 acc[2][2][4][2];
#pragma unroll
    for (int a = 0; a < 2; ++a)
#pragma unroll
        for (int b = 0; b < 2; ++b)
#pragma unroll
            for (int m = 0; m < 4; ++m)
#pragma unroll
                for (int n = 0; n < 2; ++n) acc[a][b][m][n] = (f32x4){0.f, 0.f, 0.f, 0.f};
    bf16x8 At[4][2], B0[2][2], B1[2][2]; v8i_t At8[4], B08[2], B18[2];
    unsigned v0[2], v1[2];
    const char* cA; const char* cB = (const char*)g.Bt + (size_t)cur.bn * tstep;
    if constexpr (GATHER) {
        cA = (const char*)g.A;
#pragma unroll
        for (int i = 0; i < 2; ++i) { const int r0 = g.ridx[cur.am * BM + RA[i]], r1 = g.ridx[cur.am * BM + HALF + RA[i]];
            v0[i] = (unsigned)(r0 * K * ESZ + CA[i] * 2); v1[i] = (unsigned)(r1 * K * ESZ + CA[i] * 2); }
    } else {
        cA = (const char*)g.A + (size_t)cur.am * tstep;
#pragma unroll
        for (int i = 0; i < 2; ++i) { v0[i] = (unsigned)(RA[i] * K * ESZ + CA[i] * 2); v1[i] = 0u; }
    }
    if constexpr (Epi::ROWVEC) { if (wid >= 4) __builtin_amdgcn_global_load_lds((const unsigned*)(E.gw + cur.am * BM + (tid - 256)), (LAS unsigned*)(lds + ROWVEC_OFF + (wid - 4) * 256), 4, 0, 0); }
    PG8_STAGE(PG8_SB(0, 0), cB, voffB); PG8_STAGE(PG8_SB(0, 1), cB + hstep, voffB); PG8_STAGE(PG8_SA(0, 0), cA, v0); PG8_STAGE_H1(PG8_SA(0, 1), cA);
    if (wr == 1) PG8_BAR;
    PG8_WAIT_V(2); PG8_BAR;
    PG8_STAGE(PG8_SB(1, 0), cB + kstep, voffB); PG8_STAGE(PG8_SA(1, 0), cA + kstep, v0); PG8_STAGE(PG8_SB(1, 1), cB + hstep + kstep, voffB);
    PG8_WAIT_V(6); PG8_BAR;
    for (;;) {
        const bool has_next = S.next(ui + 1, nxt);
        const char* nA; const char* nB = has_next ? (const char*)g.Bt + (size_t)nxt.bn * tstep : cB;
        if constexpr (GATHER) {
            nA = cA;
            if (has_next && wid < 4)
                __builtin_amdgcn_global_load_lds((const unsigned*)(g.ridx + nxt.am * BM + tid), (LAS unsigned*)(lds_ridx + ((ui + 1) & 1) * 1024 + wid * 256), 4, 0, 0);
            if constexpr (Epi::ROWVEC) { if (has_next && wid >= 4)
                __builtin_amdgcn_global_load_lds((const unsigned*)(E.gw + nxt.am * BM + (tid - 256)), (LAS unsigned*)(lds + ROWVEC_OFF + ((ui + 1) & 1) * 1024 + (wid - 4) * 256), 4, 0, 0); }
        } else {
            nA = has_next ? (const char*)g.A + (size_t)nxt.am * tstep : cA;
        }
#pragma unroll 1
        for (int t = 0; t < nt; t += 2) {
            const bool last = (t == nt - 2);
            const char* a1 = cA + (size_t)(t + 1) * kstep;
            const char* a2 = last ? nA : cA + (size_t)(t + 2) * kstep; const char* b2 = last ? nB : cB + (size_t)(t + 2) * kstep;
            const char* a3 = a2 + kstep; const char* b3 = b2 + kstep;
            PG8_LDB(B0, 0, 0); PG8_LDB(B1, 0, 1); PG8_SCHED; PG8_LDA(At, 0, 0); PG8_STAGE_H1(PG8_SA(1, 1), a1);
            if constexpr (GATHER) {
                if (last && has_next) {
                    const LAS int* rp = (const LAS int*)(lds_ridx + ((ui + 1) & 1) * 1024);
#pragma unroll
                    for (int i = 0; i < 2; ++i) { const int r0 = rp[RA[i]], r1 = rp[HALF + RA[i]];
                        v0[i] = (unsigned)(r0 * K * ESZ + CA[i] * 2); v1[i] = (unsigned)(r1 * K * ESZ + CA[i] * 2); }
                }
            }
            PG8_WAIT_V(8); PG8_WAIT_L(0); PG8_BAR; PG8_PIN; PG8_MMA(0, 0, At, B0); PG8_MMA(0, 1, At, B1); PG8_PIN; PG8_BAR; PG8_SCHED;
            PG8_LDA(At, 0, 1); PG8_STAGE(PG8_SB(0, 0), b2, voffB); PG8_STAGE(PG8_SB(0, 1), b2 + hstep, voffB); PG8_STAGE(PG8_SA(0, 0), a2, v0);
            PG8_WAIT_V(8); PG8_WAIT_L(0); PG8_BAR; PG8_PIN; PG8_MMA(1, 0, At, B0); PG8_MMA(1, 1, At, B1); PG8_PIN; PG8_BAR; PG8_SCHED;
            PG8_LDB(B0, 1, 0); PG8_LDB(B1, 1, 1); PG8_SCHED; PG8_LDA(At, 1, 0); PG8_STAGE_H1(PG8_SA(0, 1), a2);
            PG8_WAIT_V(8); PG8_WAIT_L(0); PG8_BAR; PG8_PIN; PG8_MMA(0, 0, At, B0); PG8_MMA(0, 1, At, B1); PG8_PIN; PG8_BAR; PG8_SCHED;
            PG8_LDA(At, 1, 1); PG8_STAGE(PG8_SB(1, 0), b3, voffB); PG8_STAGE(PG8_SB(1, 1), b3 + hstep, voffB); PG8_STAGE(PG8_SA(1, 0), a3, v0);
            PG8_WAIT_V(8); PG8_WAIT_L(0); PG8_BAR; PG8_PIN; PG8_MMA(1, 0, At, B0); PG8_MMA(1, 1, At, B1); PG8_PIN; PG8_BAR; PG8_SCHED;
        }
        if (wr == 0) PG8_BAR;
        E(acc, cur, wr, wc, fr, fq, ui);
        if (!has_next) break;
#pragma unroll
        for (int a = 0; a < 2; ++a)
#pragma unroll
            for (int b = 0; b < 2; ++b)
#pragma unroll
                for (int m = 0; m < 4; ++m)
#pragma unroll
                    for (int n = 0; n < 2; ++n) acc[a][b][m][n] = (f32x4){0.f, 0.f, 0.f, 0.f};
        cur = nxt; cA = nA; cB = nB; ++ui;
        if (wr == 1) PG8_BAR;
    }
    PG8_WAIT_V(0);
    PG8_BAR;
#undef PG8_SA
#undef PG8_SB
#undef PG8_STAGE
#undef PG8_LDA
#undef PG8_LDB
#undef PG8_MMA
#undef PG8_LD8
#undef PG8_STAGE_H1
#undef PG8_WAIT_V
#undef PG8_WAIT_L
#undef PG8_BAR
#undef PG8_SCHED
#undef PG8_PIN
}
static_assert(lds_byte(9, 16) + 16 == lds_byte(9, 24) && lds_byte(3, 48) + 16 == lds_byte(3, 56) && lds_byte(12, 0) + 16 == lds_byte(12, 8), "fp8 fragment halves are adjacent");
}

struct Args { const float* in[22]; float* out; unsigned char* ws; int ph_lo, ph_hi; };
struct Frame {
    LAS unsigned char* lds;
    int lane, wave, vcu, G, bx;
    __device__ __forceinline__ int tid_() const { return wave * 64 + lane; }
    unsigned char* ws;
};
__device__ __forceinline__ const float* inp(const Frame& F, int k) {
    const unsigned long long v = ((const LAS unsigned long long*)(F.lds + PTR_OFF))[k];
    const unsigned lo = __builtin_amdgcn_readfirstlane((unsigned)v), hi = __builtin_amdgcn_readfirstlane((unsigned)(v >> 32));
    return (const float*)(((unsigned long long)hi << 32) | lo);
}
#define F_x (inp(F, 0))
#define F_c (inp(F, 1))
#define F_ctx (inp(F, 2))
#define F_c_ctx (inp(F, 3))
#define F_w_mod (inp(F, 4))
#define F_b_mod (inp(F, 5))
#define F_w_in (inp(F, 6))
#define F_a_sink (inp(F, 7))
#define F_nat_bias (inp(F, 8))
#define F_conv_w (inp(F, 9))
#define F_conv_b (inp(F, 10))
#define F_conv_ln_g (inp(F, 11))
#define F_conv_ln_b (inp(F, 12))
#define F_w_out (inp(F, 13))
#define F_ln1_g (inp(F, 14))
#define F_ln1_b (inp(F, 15))
#define F_w_router (inp(F, 16))
#define F_w_gate (inp(F, 17))
#define F_w_up (inp(F, 18))
#define F_w_down (inp(F, 19))
#define F_ln2_g (inp(F, 20))
#define F_ln2_b (inp(F, 21))
#define F_out ((float*)inp(F, 22))
__device__ __forceinline__ const float* modp(const Frame& F, int l, int cond, int which) { return (const float*)(F.ws + WS_MOD) + ((size_t)(l * 5 + cond) * 6 + which) * D; }
__device__ __forceinline__ int row_cond(int m) { return m < RL ? (m >> 13) : 4; }

__device__ __forceinline__ void conv_item_load(const float* W, int N, int k0, int n0, int lane, f32x4 (&t)[8]) {
    const float* src = W + (size_t)(k0 + (lane >> 3)) * N + n0 + (lane & 7) * 4;
#pragma unroll
    for (int i = 0; i < 8; ++i) t[i] = *(const GAS f32x4*)(src + (size_t)(8 * i) * N);
}
__device__ __forceinline__ void conv_item_to_lds(const f32x4 (&t)[8], LAS float* scr, int lane) {
#pragma unroll
    for (int i = 0; i < 8; ++i) { LAS float* d = scr + (8 * i + (lane >> 3)) * 33 + (lane & 7) * 4; d[0] = t[i][0]; d[1] = t[i][1]; d[2] = t[i][2]; d[3] = t[i][3]; }
    LDS_WAIT(); asm volatile("" ::: "memory");
}
__device__ __forceinline__ void conv_item_store_bf16(bf16_t* WT, int Kd, int trow, LAS float* scr, int k0, int lane) {
    const int c = lane & 7;
#pragma unroll
    for (int j = 0; j < 4; ++j) { const int n = (lane >> 3) + 8 * j; const LAS float* sp = scr + (8 * c) * 33 + n;
        u32x4 o; o.x = pk2(sp[0 * 33], sp[1 * 33]); o.y = pk2(sp[2 * 33], sp[3 * 33]); o.z = pk2(sp[4 * 33], sp[5 * 33]); o.w = pk2(sp[6 * 33], sp[7 * 33]);
        *(GAS u32x4*)(WT + (size_t)(trow + n) * Kd + k0 + 8 * c) = o; }
    LDS_WAIT(); asm volatile("" ::: "memory");
}
__device__ __forceinline__ void conv_item_store_fp8(unsigned char* WT, int Kd, int trow, LAS float* scr, int k0, int lane) {
    const int n = lane >> 1, kh = (lane & 1) * 32; const LAS float* sp = scr + kh * 33 + n;
    unsigned w[8];
#pragma unroll
    for (int q = 0; q < 8; ++q) w[q] = pk4_fp8(sp[(4 * q) * 33] * 64.0f, sp[(4 * q + 1) * 33] * 64.0f, sp[(4 * q + 2) * 33] * 64.0f, sp[(4 * q + 3) * 33] * 64.0f);
    unsigned char* dst = WT + (size_t)(trow + n) * Kd + k0 + kh;
    *(GAS u32x4*)dst = (u32x4){w[0], w[1], w[2], w[3]}; *(GAS u32x4*)(dst + 16) = (u32x4){w[4], w[5], w[6], w[7]};
    LDS_WAIT(); asm volatile("" ::: "memory");
}
constexpr int CONV_NITEMS = 16 * 64 + 16 * 32 + 3 * NE * 16 * 32, CONV_S1 = (CONV_NITEMS * 56) / 100, CONV_S2 = (CONV_NITEMS * 74) / 100;
__device__ __forceinline__ void conv_decode(const Frame& F, int l, int it, const float*& W, int& N, int& k0, int& n0, int& kind, unsigned char*& WT, int& Kd, int& trow) {
    constexpr int I_IN = 16 * 64, I_OUT = 16 * 32, I_E = 16 * 32;
    int r = it;
    if (r < I_IN) { const int kb = r / 64, nb = r % 64; n0 = 32 * nb; k0 = 64 * kb; trow = n0;
        if (n0 >= OFF_C) { const int c = n0 - OFF_C, gate = c >> 8, ch = c & 255; trow = OFF_C + (ch >> 7) * 256 + gate * 128 + (ch & 127); }
        W = F_w_in + (size_t)l * D * INW; N = INW; kind = 0; WT = F.ws + wsw(l, WS_WIN); Kd = D; return; }
    r -= I_IN;
    if (r < I_OUT) { const int kb = r / 32, nb = r % 32; n0 = 32 * nb; k0 = 64 * kb; trow = n0; W = F_w_out + (size_t)l * D * D; N = D; kind = 0; WT = F.ws + wsw(l, WS_WOUT); Kd = D; return; }
    r -= I_OUT;
    const int mat = r / (NE * I_E); r -= mat * (NE * I_E);
    const int e = r / I_E; r -= e * I_E;
    const int kb = r / 32, nb = r % 32; n0 = 32 * nb; k0 = 64 * kb;
    const size_t woff = ((size_t)l * NE + e) * (size_t)D * FF;
    kind = 1; N = (mat == 2) ? D : FF; Kd = (mat == 2) ? FF : D;
    W = (mat == 0 ? F_w_gate : mat == 1 ? F_w_up : F_w_down) + woff;
    WT = (mat == 2) ? F.ws + wsw(l, WS_WD) : F.ws + wsw(l, WS_WGU);
    trow = (mat == 0) ? e * 2048 + (n0 >> 7) * 256 + (n0 & 127) : (mat == 1) ? e * 2048 + (n0 >> 7) * 256 + 128 + (n0 & 127) : e * 1024 + n0;
}
__device__ __forceinline__ void convert_weights(Frame& F, int l, int it_lo, int it_hi, int worker, int nworkers) {
    LAS float* scr = (LAS float*)(F.lds + F.wave * 16384);
    const int gw = worker * NWAVES + F.wave, NGW = nworkers * NWAVES;
    f32x4 ta[8], tb[8];
#pragma unroll
    for (int i = 0; i < 8; ++i) { ta[i] = (f32x4){0.f, 0.f, 0.f, 0.f}; tb[i] = ta[i]; }
#pragma unroll 1
    for (int it = it_lo + gw - NGW; it < it_hi; it += NGW) {
        const float* W; int N, k0, n0, kind, Kd, trow; unsigned char* WT;
        if (it + NGW < it_hi) { conv_decode(F, l, it + NGW, W, N, k0, n0, kind, WT, Kd, trow); conv_item_load(W, N, k0, n0, F.lane, tb); }
        if (it >= it_lo) { conv_decode(F, l, it, W, N, k0, n0, kind, WT, Kd, trow);
            conv_item_to_lds(ta, scr, F.lane);
            if (kind == 0) conv_item_store_bf16((bf16_t*)WT, Kd, trow, scr, k0, F.lane); else conv_item_store_fp8(WT, Kd, trow, scr, k0, F.lane); }
        __builtin_amdgcn_sched_barrier(0);
#pragma unroll
        for (int i = 0; i < 8; ++i) ta[i] = tb[i];
        __builtin_amdgcn_sched_barrier(0);
    }
}

__device__ __forceinline__ void mod_items(Frame& F) {
    LAS float* sl = (LAS float*)F.lds;
    LAS float* part = sl + 5 * 1024;
    bool have = false;
    for (int it = F.vcu; it < 48; it += F.G) {
        if (!have) {
            for (int i = F.tid_(); i < 5 * 1024; i += NTHR) { const int cd = i >> 10, k = i & 1023; const float v = cd < 4 ? F_c[cd * D + k] : F_c_ctx[k];
                sl[i] = v / (1.0f + expf(-v)); }
            have = true;
        }
        __syncthreads();
        const int l = it / 24, ch = it % 24;
        const float* W = F_w_mod + (size_t)l * D * 6 * D + ch * 256 + 4 * F.lane;
        f32x4 a[5];
#pragma unroll
        for (int cd = 0; cd < 5; ++cd) a[cd] = (f32x4){0.f, 0.f, 0.f, 0.f};
        const int kbase = F.wave * 128;
#pragma unroll 8
        for (int kk = 0; kk < 128; ++kk) { const int k = kbase + kk; const f32x4 w = *(const f32x4*)(W + (size_t)k * 6 * D);
#pragma unroll
            for (int cd = 0; cd < 5; ++cd) a[cd] += w * sl[cd * 1024 + k]; }
#pragma unroll
        for (int cd = 0; cd < 5; ++cd) *(LAS f32x4*)(part + (F.wave * 5 + cd) * 256 + 4 * F.lane) = a[cd];
        __syncthreads();
        for (int i = F.tid_(); i < 5 * 256; i += NTHR) { const int cd = i >> 8, cc = i & 255; float s = F_b_mod[(size_t)l * 6 * D + ch * 256 + cc];
#pragma unroll
            for (int w = 0; w < 8; ++w) s += part[(w * 5 + cd) * 256 + cc];
            ((float*)(F.ws + WS_MOD))[(size_t)(l * 5 + cd) * 6 * D + ch * 256 + cc] = s; }
        __syncthreads();
    }
}
__device__ __forceinline__ void rope_table(Frame& F) {
    if (F.vcu != F.G - 1) return;
    float* rc = (float*)(F.ws + WS_ROPE); float* rs = rc + 128 * 16;
    for (int i = F.tid_(); i < 128 * 16; i += NTHR) { const int pos = i >> 4, f = i & 15;
        const float inv = exp2f(-(float)f * (13.287712379549449f / 16.0f)), ang = (float)pos * inv;
        rc[i] = cosf(ang); rs[i] = sinf(ang); }
}

struct RowVec { f32x4 v[4]; };
__device__ __forceinline__ void ld_vec(const float* p, int lane, RowVec& r) {
#pragma unroll
    for (int j = 0; j < 4; ++j) r.v[j] = *(const GAS f32x4*)(p + 4 * lane + 256 * j);
}
__device__ __forceinline__ void ld_row_f32(const float* p, int lane, f32x4 (&v)[4]) {
#pragma unroll
    for (int j = 0; j < 4; ++j) v[j] = *(const GAS f32x4*)(p + 4 * lane + 256 * j);
}
__device__ __forceinline__ void st_row_f32(float* p, int lane, const f32x4 (&v)[4]) {
#pragma unroll
    for (int j = 0; j < 4; ++j) *(GAS f32x4*)(p + 4 * lane + 256 * j) = v[j];
}
__device__ __forceinline__ void ld_row_bf16raw(const bf16_t* p, int lane, u32x2 (&w)[4]) {
#pragma unroll
    for (int j = 0; j < 4; ++j) w[j] = *(const GAS u32x2*)(p + 4 * lane + 256 * j);
}
typedef _Float16 h16x2 __attribute__((ext_vector_type(2)));
__device__ __forceinline__ void ld_row_f16raw(const _Float16* p, int lane, u32x2 (&w)[4]) {
#pragma unroll
    for (int j = 0; j < 4; ++j) w[j] = *(const GAS u32x2*)(p + 4 * lane + 256 * j);
}
__device__ __forceinline__ f32x4 h4(u32x2 w) { const unsigned wx = w.x, wy = w.y;
    const h16x2 a = __builtin_bit_cast(h16x2, wx), b = __builtin_bit_cast(h16x2, wy); return (f32x4){(float)a[0], (float)a[1], (float)b[0], (float)b[1]}; }
__device__ __forceinline__ void st_row_f16(_Float16* p, int lane, const f32x4 (&v)[4]) {
#pragma unroll
    for (int j = 0; j < 4; ++j) { const h16x2 a = {(_Float16)v[j][0], (_Float16)v[j][1]}, b = {(_Float16)v[j][2], (_Float16)v[j][3]};
        u32x2 w; w.x = __builtin_bit_cast(unsigned, a); w.y = __builtin_bit_cast(unsigned, b); *(GAS u32x2*)(p + 4 * lane + 256 * j) = w; }
}
__device__ __forceinline__ f32x4 fp8x4(unsigned w) { const f32x2 lo = __builtin_amdgcn_cvt_pk_f32_fp8((int)w, false), hi = __builtin_amdgcn_cvt_pk_f32_fp8((int)w, true); return (f32x4){lo[0], lo[1], hi[0], hi[1]}; }
__device__ __forceinline__ f32x4 bf4(u32x2 w) { return (f32x4){bflo(w.x), bfhi(w.x), bflo(w.y), bfhi(w.y)}; }
__device__ __forceinline__ void st_row_bf16(bf16_t* p, int lane, const f32x4 (&v)[4]) {
#pragma unroll
    for (int j = 0; j < 4; ++j) { u32x2 w; w.x = cvt_pk_bf16(v[j][0], v[j][1]); w.y = cvt_pk_bf16(v[j][2], v[j][3]); *(GAS u32x2*)(p + 4 * lane + 256 * j) = w; }
}
__device__ __forceinline__ void ln_stats(const f32x4 (&v)[4], float& mean, float& rstd) {
    float s = 0.f, q = 0.f;
#pragma unroll
    for (int j = 0; j < 4; ++j) { s += (v[j][0] + v[j][1]) + (v[j][2] + v[j][3]); q += (v[j][0] * v[j][0] + v[j][1] * v[j][1]) + (v[j][2] * v[j][2] + v[j][3] * v[j][3]); }
    wave_sum2(s, q);
    mean = s * (1.0f / D);
    rstd = 1.0f / sqrtf(fmaxf(q * (1.0f / D) - mean * mean, 0.f) + LN_EPS);
}
__device__ __forceinline__ const float* xsrc_row(const Frame& F, int l, int m) {
    (void)l; return m < RL ? F_x + (size_t)m * D : F_ctx + (size_t)(m - RL) * D;
}

constexpr int CW_CIA = 8192;
__device__ __forceinline__ void row_segment(const Frame& F, int nc, int nrows, int seg, int& m0, int& m1) {
    if (nc == 0) { const int gw = F.vcu * NWAVES + F.wave, NGW = F.G * NWAVES, per = (nrows + NGW - 1) / NGW; m0 = seg == 0 ? nrows : gw * per; m1 = seg == 0 ? nrows : min(nrows, m0 + per); return; }
    const int wid = (F.vcu - nc) * NWAVES + F.wave, NW = (F.G - nc) * NWAVES;
    if (seg == 0) { m0 = RL + wid; m1 = (nrows > RL && m0 < R) ? m0 + 1 : m0; }
    else { const int per = (RL + NW - 1) / NW; m0 = wid * per; m1 = min(RL, m0 + per); }
}
__device__ __forceinline__ void cia_publish(const Frame& F, int nc, int which) {
    asm volatile("s_waitcnt vmcnt(0)" ::: "memory");
    __syncthreads();
    if (F.tid_() == 0) { const int w0 = (F.vcu - nc) * NWAVES, cnt = min(max(RC - w0, 0), NWAVES);
        if (cnt > 0) { __builtin_amdgcn_fence(__ATOMIC_RELEASE, "agent"); asm volatile("s_waitcnt vmcnt(0)" ::: "memory");
            __hip_atomic_fetch_add((unsigned*)(F.ws + WS_CTL) + CW_CIA + 64 * which, (unsigned)cnt, __ATOMIC_RELAXED, __HIP_MEMORY_SCOPE_AGENT); } }
}
__device__ __forceinline__ void cia_wait(const Frame& F, int which) {
    if (F.tid_() == 0) { unsigned* p = (unsigned*)(F.ws + WS_CTL) + CW_CIA + 64 * which; unsigned sp = 0;
        while (__hip_atomic_load(p, __ATOMIC_RELAXED, __HIP_MEMORY_SCOPE_AGENT) < (unsigned)RC) { __builtin_amdgcn_s_sleep(2); if (++sp > (1u << 24)) break; }
        __builtin_amdgcn_fence(__ATOMIC_ACQUIRE, "agent"); asm volatile("s_waitcnt vmcnt(0)" ::: "memory"); }
    __syncthreads();
}

__device__ __forceinline__ void phase_h0(Frame& F, bf16_t* H, int nc) {
    int cur = -1; RowVec sh, sc; f32x4 xa0[4], xa1[4], xb0[4], xb1[4];
#pragma unroll 1
    for (int seg = 0; seg < 2; ++seg) {
        int m0, m1; row_segment(F, nc, R, seg, m0, m1);
        if (m0 < m1) {
#pragma unroll
            for (int j = 0; j < 4; ++j) { xa0[j] = (f32x4){0.f, 0.f, 0.f, 0.f}; xa1[j] = xa0[j]; xb0[j] = xa0[j]; xb1[j] = xa0[j]; }
#pragma unroll 1
            for (int m = m0 - 2; m < m1; m += 2) {
                if (m >= m0) { const int cd = row_cond(m), cd1 = (m + 1 < m1) ? row_cond(m + 1) : cd;
                    if (cd != cur) { cur = cd; ld_vec(modp(F, 0, cd, 0), F.lane, sh); ld_vec(modp(F, 0, cd, 1), F.lane, sc);
                        asm volatile("" :: "v"(sh.v[0]), "v"(sh.v[1]), "v"(sh.v[2]), "v"(sh.v[3]), "v"(sc.v[0]), "v"(sc.v[1]), "v"(sc.v[2]), "v"(sc.v[3])); }
                    (void)cd1; }
                if (m + 2 < m1) ld_row_f32(xsrc_row(F, 0, m + 2), F.lane, xb0);
                if (m + 3 < m1) ld_row_f32(xsrc_row(F, 0, m + 3), F.lane, xb1);
                if (m >= m0) {
                    { float mean, rstd; ln_stats(xa0, mean, rstd); f32x4 h[4];
#pragma unroll
                      for (int j = 0; j < 4; ++j) h[j] = ((xa0[j] - mean) * rstd) * (sc.v[j] + 1.0f) + sh.v[j];
                      st_row_bf16(H + (size_t)m * D, F.lane, h); }
                    if (m + 1 < m1) {
                        const int cd1 = row_cond(m + 1);
                        if (cd1 != cur) { cur = cd1; ld_vec(modp(F, 0, cd1, 0), F.lane, sh); ld_vec(modp(F, 0, cd1, 1), F.lane, sc);
                            asm volatile("" :: "v"(sh.v[0]), "v"(sh.v[1]), "v"(sh.v[2]), "v"(sh.v[3]), "v"(sc.v[0]), "v"(sc.v[1]), "v"(sc.v[2]), "v"(sc.v[3])); }
                        float mean, rstd; ln_stats(xa1, mean, rstd); f32x4 h[4];
#pragma unroll
                        for (int j = 0; j < 4; ++j) h[j] = ((xa1[j] - mean) * rstd) * (sc.v[j] + 1.0f) + sh.v[j];
                        st_row_bf16(H + (size_t)(m + 1) * D, F.lane, h); }
                }
                __builtin_amdgcn_sched_barrier(0);
#pragma unroll
                for (int j = 0; j < 4; ++j) { xa0[j] = xb0[j]; xa1[j] = xb1[j]; }
                __builtin_amdgcn_sched_barrier(0);
            }
        }
        if (seg == 0 && nc > 0) cia_publish(F, nc, 0);
    }
}

typedef float f32x4_t __attribute__((ext_vector_type(4)));
constexpr int RP1_LD = 1028;
template <bool L0>
__device__ __forceinline__ void phase_rowpass1(Frame& F, int l, const bf16_t* O, unsigned char* H2, int nrows) {
    LAS float* Wl = (LAS float*)F.lds;
    LAS float* Hs = Wl + 16 * RP1_LD;
    LAS float* Pt = Hs + 16 * RP1_LD;
    { const f32x4* wr4 = (const f32x4*)(F_w_router + (size_t)l * D * NE); f32x4 t[8];
#pragma unroll
      for (int k = 0; k < 8; ++k) t[k] = wr4[F.tid_() + k * NTHR];
#pragma unroll
      for (int k = 0; k < 8; ++k) { const int i = 4 * (F.tid_() + k * NTHR);
#pragma unroll
          for (int q = 0; q < 4; ++q) Wl[((i & 15) + q) * RP1_LD + (i >> 4)] = t[k][q]; } }
    __syncthreads();
    const int lane = F.lane, wv = F.wave;
    const int perwg = (nrows + F.G - 1) / F.G, r0 = F.vcu * perwg, r1 = min(nrows, r0 + perwg);
    const int niter = r0 < r1 ? 2 * ((r1 - r0 + 15) / 16) : 0;
    _Float16* XA = (_Float16*)(F.ws + WS_XA); int* inv = (int*)(F.ws + WS_INV);
    RowVec lg, lb, g1, sh2, sc2;
    ld_vec(F_ln1_g + (size_t)l * D, lane, lg); ld_vec(F_ln1_b + (size_t)l * D, lane, lb);
    int cur = -1;
    f32x4 xa[4], xb[4]; u32x2 ha[4], hb[4]; u32x2 oa[4], ob[4];
#define RP1_LOAD(X, H_, O_, m_) do { if ((m_) < r1) { if (L0) ld_row_f32(xsrc_row(F, 0, (m_)), lane, X); else ld_row_f16raw(XA + (size_t)(m_) * D, lane, H_); ld_row_bf16raw(O + (size_t)(m_) * D, lane, O_); } } while (0)
#pragma unroll 1
    for (int it = -1; it < niter; ++it) {
        const int m = r0 + 8 * it + wv;
        if (it >= 0 && m < r1) { const int cd = row_cond(m); if (cd != cur) { cur = cd; ld_vec(modp(F, l, cd, 2), lane, g1); ld_vec(modp(F, l, cd, 3), lane, sh2); ld_vec(modp(F, l, cd, 4), lane, sc2);
            asm volatile("" :: "v"(g1.v[0]), "v"(g1.v[1]), "v"(g1.v[2]), "v"(g1.v[3]), "v"(sh2.v[0]), "v"(sh2.v[1]), "v"(sh2.v[2]), "v"(sh2.v[3]), "v"(sc2.v[0]), "v"(sc2.v[1]), "v"(sc2.v[2]), "v"(sc2.v[3])); } }
        RP1_LOAD(xb, hb, ob, m + 8);
        LAS float* hrow = Hs + ((it & 1) * 8 + wv) * RP1_LD;
        if (it >= 0) {
        if (m < r1) {
            if (!L0) {
#pragma unroll
                for (int j = 0; j < 4; ++j) xa[j] = h4(ha[j]); }
            f32x4 v[4];
#pragma unroll
            for (int j = 0; j < 4; ++j) v[j] = xa[j] * ALPHA + g1.v[j] * bf4(oa[j]);
            float mean, rstd; ln_stats(v, mean, rstd);
#pragma unroll
            for (int j = 0; j < 4; ++j) v[j] = ((v[j] - mean) * rstd) * lg.v[j] + lb.v[j];
            st_row_f16(XA + (size_t)m * D, lane, v);
            ln_stats(v, mean, rstd);
#pragma unroll
            for (int j = 0; j < 4; ++j) { const f32x4 h = ((v[j] - mean) * rstd) * (sc2.v[j] + 1.0f) + sh2.v[j];
                *(GAS unsigned*)(H2 + (size_t)m * D + 4 * lane + 256 * j) = pk4_fp8(h[0], h[1], h[2], h[3]);
                *(LAS f32x4*)(hrow + 4 * lane + 256 * j) = h; }
        } else {
#pragma unroll
            for (int j = 0; j < 4; ++j) *(LAS f32x4*)(hrow + 4 * lane + 256 * j) = (f32x4){0.f, 0.f, 0.f, 0.f};
        }
        if (it & 1) {
            __syncthreads();
            f32x4_t acc = {0.f, 0.f, 0.f, 0.f};
            { const LAS float* ap = Hs + (lane & 15) * RP1_LD + 128 * wv + 4 * (lane >> 4); const LAS float* bp = Wl + (lane & 15) * RP1_LD + 128 * wv + 4 * (lane >> 4);
#pragma unroll
              for (int ks = 0; ks < 8; ++ks) { const f32x4 a = *(const LAS f32x4*)(ap + 16 * ks), w = *(const LAS f32x4*)(bp + 16 * ks);
#pragma unroll
                  for (int i = 0; i < 4; ++i) acc = __builtin_amdgcn_mfma_f32_16x16x4f32(a[i], w[i], acc, 0, 0, 0); } }
#pragma unroll
            for (int r = 0; r < 4; ++r) Pt[(wv * 16 + 4 * (lane >> 4) + r) * 16 + (lane & 15)] = acc[r];
            __syncthreads();
            const int t = F.tid_();
            if (t < 256) { const int ri = t >> 4, e = t & 15; float lgt = 0.f;
#pragma unroll
                for (int w8 = 0; w8 < 8; ++w8) lgt += Pt[(w8 * 16 + ri) * 16 + e];
                const float mx = row16_max(lgt), ex = expf(lgt - mx), den = row16_sum(ex), aff = ex / den;
                const int mr = r0 + 8 * (it - 1) + (ri & 7) + 8 * (ri >> 3);
                if (mr < r1) {
                    if (mr < RL) ((float*)(F.ws + WS_AFF))[((size_t)((mr >> 13) * 16 + e)) * SEQ + (mr & (SEQ - 1))] = aff;
                    else { const int mc = mr - RL; ((float*)(F.ws + WS_AFFC))[((size_t)((mc >> 8) * 16 + e)) * NCTX + (mc & (NCTX - 1))] = aff; }
                    inv[(size_t)mr * 16 + e] = -1; } }
        }
        }
        __builtin_amdgcn_sched_barrier(0);
#pragma unroll
        for (int j = 0; j < 4; ++j) { if (L0) xa[j] = xb[j]; else ha[j] = hb[j]; oa[j] = ob[j]; }
        __builtin_amdgcn_sched_barrier(0);
    }
#undef RP1_LOAD
    __syncthreads();
}

template <int PER>
__device__ __forceinline__ void topk_item(Frame& F, const float* aff, int nact, int cap, int rowbase, int slotbase, int e) {
    LAS unsigned* hist = (LAS unsigned*)F.lds;
    LAS unsigned* wt = hist + 256;
    LAS unsigned* ctl = wt + 16;
    int* rowidx = (int*)(F.ws + WS_RIDX) + e * EROWS; float* gatew = (float*)(F.ws + WS_GATEW) + e * EROWS; int* inv = (int*)(F.ws + WS_INV);
    const int tid = F.tid_(), lane = F.lane, wave = F.wave;
    const bool act = tid * PER < nact;
    unsigned key[PER];
    if constexpr (PER == 16) {
#pragma unroll
        for (int q = 0; q < 4; ++q) { const u32x4 w = *(const u32x4*)(aff + tid * 16 + q * 4); key[q * 4 + 0] = w.x; key[q * 4 + 1] = w.y; key[q * 4 + 2] = w.z; key[q * 4 + 3] = w.w; }
    } else {
        key[0] = act ? __builtin_bit_cast(unsigned, aff[tid]) : 0u;
    }
    unsigned prefix = 0u, mask = 0u, remaining = (unsigned)cap;
#pragma unroll 1
    for (int pass = 0; pass < 4; ++pass) {
        const int shift = 24 - 8 * pass;
        if (tid < 256) hist[tid] = 0u;
        __syncthreads();
        if (act) {
#pragma unroll
            for (int i = 0; i < PER; ++i) if ((key[i] & mask) == prefix) __hip_atomic_fetch_add(&hist[(key[i] >> shift) & 255u], 1u, __ATOMIC_RELAXED, __HIP_MEMORY_SCOPE_WORKGROUP);
        }
        __syncthreads();
        unsigned hv = 0u, sfx = 0u;
        if (tid < 256) { hv = hist[tid]; sfx = hv;
#pragma unroll
            for (int o = 1; o < 64; o <<= 1) { const unsigned t2 = lane_get(sfx, (lane + o) & 63); if (lane + o < 64) sfx += t2; }
            if (lane == 0) wt[wave] = sfx; }
        __syncthreads();
        if (tid < 256) { for (int w = wave + 1; w < 4; ++w) sfx += wt[w];
            if (sfx >= remaining && sfx - hv < remaining) { ctl[0] = (unsigned)tid; ctl[1] = remaining - (sfx - hv); } }
        __syncthreads();
        prefix |= ctl[0] << shift; mask |= 255u << shift; remaining = ctl[1];
        __syncthreads();
    }
    const unsigned T = prefix, need_eq = remaining;
    unsigned cgt = 0u, ceq = 0u;
    if (act) {
#pragma unroll
        for (int i = 0; i < PER; ++i) { cgt += key[i] > T ? 1u : 0u; ceq += key[i] == T ? 1u : 0u; }
    }
    unsigned v = cgt | (ceq << 16), inc = v;
#pragma unroll
    for (int o = 1; o < 64; o <<= 1) { const unsigned t2 = lane_get(inc, (lane - o) & 63); if (lane >= o) inc += t2; }
    if (lane == 63) wt[wave] = inc;
    __syncthreads();
    unsigned base = 0u, total = 0u;
    for (int w = 0; w < 8; ++w) { const unsigned t2 = wt[w]; if (w < wave) base += t2; total += t2; }
    unsigned pgt = (base + inc - v) & 0xffffu, peq = (base + inc - v) >> 16;
    const unsigned total_gt = total & 0xffffu;
    if (act) {
#pragma unroll
        for (int i = 0; i < PER; ++i) {
            int slot = -1;
            if (key[i] > T) { slot = (int)pgt; ++pgt; }
            else if (key[i] == T) { if (peq < need_eq) slot = (int)(total_gt + peq); ++peq; }
            if (slot >= 0) { const int n = tid * PER + i; rowidx[slotbase + slot] = rowbase + n; gatew[slotbase + slot] = __builtin_bit_cast(float, key[i]); inv[(size_t)(rowbase + n) * 16 + e] = slotbase + slot; }
        }
    }
    __syncthreads();
}
__device__ __forceinline__ void phase_topk(Frame& F, bool with_ctx) {
    const int nitems = with_ctx ? 128 : 64;
    for (int it = F.vcu; it < nitems; it += F.G) {
        if (it < 64) { const int b = it >> 4, e = it & 15;
            topk_item<16>(F, (const float*)(F.ws + WS_AFF) + (size_t)(b * 16 + e) * SEQ, SEQ, CAP_L, b * SEQ, b * CAP_L, e);
        } else { const int b = (it - 64) >> 4, e = it & 15;
            topk_item<1>(F, (const float*)(F.ws + WS_AFFC) + (size_t)(b * 16 + e) * NCTX, NCTX, CAP_C, RL + b * NCTX, 4096 + b * CAP_C, e);
            if (b == 0 && F.tid_() < 128) { ((int*)(F.ws + WS_RIDX))[e * EROWS + 4224 + F.tid_()] = 0; ((float*)(F.ws + WS_GATEW))[e * EROWS + 4224 + F.tid_()] = 0.f; }
        }
    }
}

template <bool L0>
__device__ __forceinline__ void phase_rowpass2(Frame& F, int l, const unsigned char* slab, bf16_t* Hn, int nrows, int nc) {
    const int lane = F.lane;
    _Float16* XA = (_Float16*)(F.ws + WS_XA); const int* inv = (const int*)(F.ws + WS_INV);
    RowVec lg, lb, g2, sh, sc;
    ld_vec(F_ln2_g + (size_t)l * D, lane, lg); ld_vec(F_ln2_b + (size_t)l * D, lane, lb);
    int cur = -1;
#pragma unroll 1
    for (int seg = 0; seg < 2; ++seg) {
    int m0, m1; row_segment(F, nc, nrows, seg, m0, m1);
    if (m0 < m1) {
    u32x2 ha[4], hb[4]; int inva = -1, invb = -1, invc = -1;
    unsigned ya0[4], ya1[4], yb0[4], yb1[4];
#pragma unroll
    for (int j = 0; j < 4; ++j) { ha[j] = (u32x2){0u, 0u}; hb[j] = (u32x2){0u, 0u}; ya0[j] = 0u; ya1[j] = 0u; yb0[j] = 0u; yb1[j] = 0u; }
#pragma unroll 1
    for (int m = m0 - 2; m < m1; ++m) {
        if (m >= m0) { const int cd = row_cond(m);
            if (cd != cur) { cur = cd; ld_vec(modp(F, l, cd, 5), lane, g2);
                if (L0) { ld_vec(modp(F, 1, cd, 0), lane, sh); ld_vec(modp(F, 1, cd, 1), lane, sc);
                    asm volatile("" :: "v"(sh.v[0]), "v"(sh.v[1]), "v"(sh.v[2]), "v"(sh.v[3]), "v"(sc.v[0]), "v"(sc.v[1]), "v"(sc.v[2]), "v"(sc.v[3])); }
                asm volatile("" :: "v"(g2.v[0]), "v"(g2.v[1]), "v"(g2.v[2]), "v"(g2.v[3])); } }
        if (m + 2 < m1) invc = (lane < 16) ? inv[(size_t)(m + 2) * 16 + lane] : -1;
        if (m + 1 >= m0 && m + 1 < m1) {
            ld_row_f16raw(XA + (size_t)(m + 1) * D, lane, hb);
            unsigned long long mk = __ballot(invb >= 0);
            if (mk) { const int e0 = __builtin_ctzll(mk); mk &= mk - 1; const bool two = mk != 0ull; const int e1 = two ? __builtin_ctzll(mk) : e0;
                const int s0 = __builtin_amdgcn_readlane(invb, e0), s1 = __builtin_amdgcn_readlane(invb, e1);
                { const unsigned char* p0 = slab + ((size_t)e0 * EROWS + s0) * D + 4 * lane;
#pragma unroll
                  for (int j = 0; j < 4; ++j) yb0[j] = *(const GAS unsigned*)(p0 + 256 * j); }
                if (two) { const unsigned char* p1 = slab + ((size_t)e1 * EROWS + s1) * D + 4 * lane;
#pragma unroll
                  for (int j = 0; j < 4; ++j) yb1[j] = *(const GAS unsigned*)(p1 + 256 * j); } }
        }
        if (m >= m0) {
        f32x4 xa[4];
#pragma unroll
        for (int j = 0; j < 4; ++j) xa[j] = h4(ha[j]);
        f32x4 acc[4];
#pragma unroll
        for (int j = 0; j < 4; ++j) acc[j] = (f32x4){0.f, 0.f, 0.f, 0.f};
        unsigned long long msk = __ballot(inva >= 0);
        if (msk) { msk &= msk - 1; const bool two = msk != 0ull; if (two) msk &= msk - 1;
#pragma unroll
            for (int j = 0; j < 4; ++j) acc[j] += fp8x4(ya0[j]);
            if (two) {
#pragma unroll
                for (int j = 0; j < 4; ++j) acc[j] += fp8x4(ya1[j]); } }
#pragma unroll 1
        while (msk) {
            const int e0 = __builtin_ctzll(msk); msk &= msk - 1;
            const bool two = msk != 0ull; const int e1 = two ? __builtin_ctzll(msk) : e0; if (two) msk &= msk - 1;
            const int s0 = __builtin_amdgcn_readlane(inva, e0), s1 = __builtin_amdgcn_readlane(inva, e1);
            unsigned y0[4], y1[4];
            { const unsigned char* p0 = slab + ((size_t)e0 * EROWS + s0) * D + 4 * lane;
#pragma unroll
              for (int j = 0; j < 4; ++j) y0[j] = *(const GAS unsigned*)(p0 + 256 * j); }
            if (two) { const unsigned char* p1 = slab + ((size_t)e1 * EROWS + s1) * D + 4 * lane;
#pragma unroll
              for (int j = 0; j < 4; ++j) y1[j] = *(const GAS unsigned*)(p1 + 256 * j); }
#pragma unroll
            for (int j = 0; j < 4; ++j) acc[j] += fp8x4(y0[j]);
            if (two) {
#pragma unroll
                for (int j = 0; j < 4; ++j) acc[j] += fp8x4(y1[j]); }
        }
        f32x4 v[4];
#pragma unroll
        for (int j = 0; j < 4; ++j) v[j] = xa[j] * ALPHA + g2.v[j] * (acc[j] * 0.0625f);
        float mean, rstd; ln_stats(v, mean, rstd);
#pragma unroll
        for (int j = 0; j < 4; ++j) v[j] = ((v[j] - mean) * rstd) * lg.v[j] + lb.v[j];
        if (L0) st_row_f16(XA + (size_t)m * D, lane, v);
        else st_row_f32(F_out + (size_t)m * D, lane, v);
        if (L0) { ln_stats(v, mean, rstd); f32x4 h[4];
#pragma unroll
            for (int j = 0; j < 4; ++j) h[j] = ((v[j] - mean) * rstd) * (sc.v[j] + 1.0f) + sh.v[j];
            st_row_bf16(Hn + (size_t)m * D, lane, h); }
        }
        __builtin_amdgcn_sched_barrier(0);
#pragma unroll
        for (int j = 0; j < 4; ++j) { ha[j] = hb[j]; ya0[j] = yb0[j]; ya1[j] = yb1[j]; }
        inva = invb; invb = invc;
        __builtin_amdgcn_sched_barrier(0);
    }
    }
    if (seg == 0 && nc > 0) cia_publish(F, nc, 1);
    }
}

__device__ __forceinline__ void conv_unit_rows(int un, int& rowbase, int& t0, int& slen) {
    if (un < RL / 64) { const int b = un / (SEQ / 64); t0 = (un % (SEQ / 64)) * 64; rowbase = b * SEQ; slen = SEQ; }
    else { const int uc = un - RL / 64; const int b = uc / (NCTX / 64); t0 = (uc % (NCTX / 64)) * 64; rowbase = RL + b * NCTX; slen = NCTX; }
}
__device__ __forceinline__ void conv_fetch(const bf16_t* U, int un, int tid, u32x4 (&pf)[6]) {
    int rowbase, t0, slen; conv_unit_rows(un, rowbase, t0, slen);
#pragma unroll
    for (int q = 0; q < 6; ++q) { const int i = tid + q * NTHR, tt = i >> 5, c8 = (i & 31) * 8, t = t0 - 15 + tt;
        pf[q] = (u32x4){0u, 0u, 0u, 0u};
        if (tt < 94 && t >= 0 && t < slen) pf[q] = *(const GAS u32x4*)(U + (size_t)(rowbase + t) * INW + OFF_C + c8); }
}
__device__ __forceinline__ void phase_conv(Frame& F, int l, const bf16_t* U, bf16_t* MIX, bool with_ctx) {
    LAS float* g = (LAS float*)F.lds;
    const int nunits = (RL / 64) + (with_ctx ? RC / 64 : 0);
    const int ch = F.tid_() & 255, half = F.tid_() >> 8;
    float w[31];
    { const float* cw = F_conv_w + (size_t)l * 31 * 256;
#pragma unroll
      for (int j = 0; j < 31; ++j) w[j] = cw[j * 256 + ch]; }
    const float cb = F_conv_b[l * 256 + ch];
    const f32x4 lng = *(const f32x4*)(F_conv_ln_g + l * 256 + 4 * F.lane), lnb = *(const f32x4*)(F_conv_ln_b + l * 256 + 4 * F.lane);
    u32x4 pf[6];
    const int cv0 = F.G - 1 - F.vcu;
    if (cv0 < nunits) conv_fetch(U, cv0, F.tid_(), pf);
#pragma unroll 1
    for (int un = cv0; un < nunits; un += F.G) {
        int rowbase, t0, slen; conv_unit_rows(un, rowbase, t0, slen);
        __syncthreads();
#pragma unroll
        for (int q = 0; q < 6; ++q) { const int i = F.tid_() + q * NTHR, tt = i >> 5, c8 = (i & 31) * 8;
            if (tt < 94) { *(LAS f32x4*)(g + tt * 256 + c8) = (f32x4){bflo(pf[q].x), bfhi(pf[q].x), bflo(pf[q].y), bfhi(pf[q].y)};
                           *(LAS f32x4*)(g + tt * 256 + c8 + 4) = (f32x4){bflo(pf[q].z), bfhi(pf[q].z), bflo(pf[q].w), bfhi(pf[q].w)}; } }
        if (un + F.G < nunits) conv_fetch(U, un + F.G, F.tid_(), pf);
        __syncthreads();
        float out[32];
        { const LAS float* gp = g + (32 * half) * 256 + ch;
          float in[62];
#pragma unroll
          for (int i = 0; i < 62; ++i) in[i] = gp[i * 256];
#pragma unroll
          for (int t = 0; t < 32; ++t) { float sacc = cb;
#pragma unroll
              for (int j = 0; j < 31; ++j) sacc += w[j] * in[t + j];
              out[t] = sacc; } }
        __syncthreads();
#pragma unroll
        for (int t = 0; t < 32; ++t) g[(32 * half + t) * 256 + ch] = out[t];
        __syncthreads();
#pragma unroll 1
        for (int q = 0; q < 8; ++q) { const int tl = F.wave * 8 + q;
            const f32x4 v = *(const LAS f32x4*)(g + tl * 256 + 4 * F.lane);
            float s1 = (v[0] + v[1]) + (v[2] + v[3]), s2 = (v[0] * v[0] + v[1] * v[1]) + (v[2] * v[2] + v[3] * v[3]);
            wave_sum2(s1, s2);
            const float mean = s1 * (1.0f / 256.0f), rstd = 1.0f / sqrtf(fmaxf(s2 * (1.0f / 256.0f) - mean * mean, 0.f) + LN_EPS);
            f32x4 y = ((v - mean) * rstd) * lng + lnb;
#pragma unroll
            for (int i = 0; i < 4; ++i) y[i] = y[i] * __builtin_amdgcn_rcpf(1.0f + __builtin_amdgcn_exp2f(-y[i] * LOG2E));
            u32x2 o; o.x = cvt_pk_bf16(y[0], y[1]); o.y = cvt_pk_bf16(y[2], y[3]);
            *(GAS u32x2*)(MIX + (size_t)(rowbase + t0 + tl) * D + 768 + 4 * F.lane) = o; }
    }
    __syncthreads();
}

namespace att {
typedef float f32x16 __attribute__((ext_vector_type(16)));
typedef short s16x4 __attribute__((ext_vector_type(4)));
typedef short v4i16_t __attribute__((ext_vector_type(4)));
typedef float f32x2_t __attribute__((ext_vector_type(2)));
typedef __bf16 bf16x2_t __attribute__((ext_vector_type(2)));
constexpr int SLOTB = 16384, LDS_WS = 2 * SLOTB, LDS_OST = LDS_WS + 2048, LDS_BIAS = LDS_OST + 8 * 4096, LDS_ULIST = LDS_BIAS + 15 * 16 * 56 * 4, LDS_TOTAL = LDS_ULIST + 8192;
constexpr float THR = 8.0f;
__device__ __forceinline__ int crow(int r, int hi) { return (r & 3) + 8 * (r >> 2) + 4 * hi; }
__device__ __forceinline__ unsigned cvtpk_s(float lo, float hi) { f32x2_t v = {lo, hi}; bf16x2_t b = __builtin_convertvector(v, bf16x2_t); return __builtin_bit_cast(unsigned, b); }
__device__ __forceinline__ s16x4 vtr(const LAS unsigned char* p) { return __builtin_bit_cast(s16x4, __builtin_amdgcn_ds_read_tr16_b64_v4i16((LAS v4i16_t*)p)); }

struct AGeo { int qrow, qcol, kcol, vcol, ocol, nt, wrow0, jlo, R0, ctxrow0, alo, ahi, blk, hd, sinkh, ctxq; };
template <int TYPE>
__device__ __forceinline__ AGeo att_geo(int wid, int u) {
    AGeo g; int b, hd, blk; bool ctxq;
    if (TYPE == 0) { ctxq = u >= 1024; const int uc = u - 1024; b = ctxq ? uc >> 3 : u >> 8; hd = ctxq ? (uc >> 2) & 1 : (u >> 7) & 1; blk = ctxq ? uc & 3 : u & 127; }
    else { ctxq = u >= 512; const int uc = u - 512; b = ctxq ? uc >> 2 : u >> 7; hd = ctxq ? uc & 3 : (u >> 5) & 3; blk = ctxq ? 0 : u & 31; }
    if (TYPE == 0) { const int qh = hd * 4 + (wid >> 1); g.qcol = OFF_AQ + qh * 64; g.kcol = OFF_AK + hd * 64; g.vcol = OFF_AV + hd * 64; g.ocol = qh * 64; g.sinkh = qh;
        const int tok = 64 * blk + 32 * (wid & 1); g.qrow = ctxq ? RL + b * NCTX + tok : b * SEQ + tok; }
    else { g.qcol = OFF_BQ + hd * 64; g.kcol = OFF_BK + hd * 64; g.vcol = OFF_BV + hd * 64; g.ocol = 512 + hd * 64; g.sinkh = 0;
        const int tok = ctxq ? 32 * wid : (4 * blk + (wid >> 1)) * 64 + 32 * (wid & 1); g.qrow = ctxq ? RL + b * NCTX + tok : b * SEQ + tok; }
    int nwin = 0, wrow0 = 0, jlo = 0, R0 = 0;
    if (!ctxq) {
        if (TYPE == 0) { const int s0 = 64 * blk; jlo = s0 >= 128 ? 0 : (128 - s0) >> 6; const int jhi = min(4, (SEQ + 64 - s0) >> 6); nwin = jhi - jlo + 1; wrow0 = b * SEQ + s0 - 128 + 64 * jlo; }
        else { R0 = min(max(4 * blk - 4, 0), 120); const int R1 = min(max(4 * blk - 1, 0), 120) + 7; nwin = R1 - R0 + 1; wrow0 = b * SEQ + R0 * 64; }
    }
    g.nt = 4 + nwin; g.wrow0 = wrow0; g.jlo = jlo; g.R0 = R0; g.ctxrow0 = RL + b * NCTX; g.blk = blk; g.hd = hd; g.ctxq = ctxq ? 1 : 0;
    int alo = 4, ahi = g.nt;
    if (TYPE == 1 && !ctxq) { const int qg = 4 * blk + (wid >> 1), rs = min(max(qg - 4, 0), 120); alo = 4 + rs - R0; ahi = alo + 8; }
    g.alo = alo; g.ahi = ahi;
    return g;
}

template <int TYPE>
__device__ __forceinline__ void attn_stream(const Frame& F, int l, const bf16_t* U, bf16_t* MIX, LAS unsigned char* shm, int nun) {
    const int lane = F.lane, wid = F.wave;
    const LAS int* ul = (const LAS int*)(shm + LDS_ULIST) + 1;
    const char* Ub = (const char*)U;
    float NEGBIG = -1e30f; asm volatile("" : "+v"(NEGBIG));
    LAS float* wsf = (LAS float*)(shm + LDS_WS) + wid * 64;
#define ATT_TROW(G_, ti_) ((ti_) < 4 ? G_.ctxrow0 + 64 * (ti_) : G_.wrow0 + 64 * ((ti_) - 4))
#define ATT_DMA_K(G_, P_, ti_) __builtin_amdgcn_global_load_lds((const unsigned*)(Ub + (size_t)ATT_TROW(G_, ti_) * (INW * 2) + (unsigned)(ln_ * INW + G_.kcol + wid * 8) * 2u), (LAS unsigned*)(shm + (((ti_) + P_) & 1) * 8192 + wid * 1024), 16, 0, 0)
#define ATT_DMA_V(G_, P_, ti_) __builtin_amdgcn_global_load_lds((const unsigned*)(Ub + (size_t)ATT_TROW(G_, ti_) * (INW * 2) + (unsigned)((16 * (wid & 3) + (ln_ >> 2)) * INW + G_.vcol + (wid >> 2) * 32 + (ln_ & 3) * 8) * 2u), (LAS unsigned*)(shm + 16384 + (((ti_) + P_) & 1) * 8192 + wid * 1024), 16, 0, 0)
#define ATT_LOADQ(G_) do { const char* qb_ = Ub + (size_t)G_.qrow * (INW * 2); const unsigned qo_ = (unsigned)((ln_ & 31) * INW + G_.qcol + (ln_ >> 5) * 8) * 2u; \
        _Pragma("unroll") for (int d0 = 0; d0 < 4; ++d0) qr[d0] = *(const bf16x8*)(qb_ + qo_ + d0 * 32); } while (0)
    int par = 0, tblh = -1;
    bf16x8 qr[4];
    AGeo g = att_geo<TYPE>(wid, __builtin_amdgcn_readfirstlane(ul[0]));
    { const int ln_ = lane; ATT_DMA_K(g, par, 0); ATT_DMA_V(g, par, 0); ATT_DMA_K(g, par, 1); ATT_LOADQ(g); }
#pragma unroll 1
    for (int ui = 0; ui < nun; ++ui) {
        const bool hasn = ui + 1 < nun;
        const AGeo gn = att_geo<TYPE>(wid, __builtin_amdgcn_readfirstlane(ul[hasn ? ui + 1 : ui]));
        const int nt = g.nt, parn = (par + nt) & 1;
        if (TYPE == 1) { if (!g.ctxq && tblh != g.hd) { tblh = g.hd; const float* nb = F_nat_bias + (size_t)(l * 4 + g.hd) * 15 * 31; LAS float* bl = (LAS float*)(shm + LDS_BIAS); LAS float* raw = (LAS float*)(shm + LDS_ULIST + 4096);
            for (int i = F.tid_(); i < 15 * 31; i += NTHR) raw[i] = nb[i] * LOG2E;
            __syncthreads();
            for (int i = F.tid_(); i < 15 * 16 * 56; i += NTHR) { const int dr = i / 896, rem = i - dr * 896, dl_ = rem / 56, w = rem - dl_ * 56 - 20;
                bl[i] = (w >= 0 && w < 16) ? raw[dr * 31 + (w - dl_ + 15)] : -1e30f; } } }
        float sinkv = 0.f; if (TYPE == 0) sinkv = F_a_sink[l * 8 + g.sinkh] * LOG2E;
        float mrun = 0.f, lrun = 0.f; f32x16 o[2], pc0, pc1, negm;
#pragma unroll
        for (int r = 0; r < 16; ++r) { o[0][r] = 0.f; o[1][r] = 0.f; negm[r] = 0.f; }
        if (ui == 0) { asm volatile("s_waitcnt vmcnt(0) lgkmcnt(0)" ::: "memory"); __builtin_amdgcn_s_barrier(); asm volatile("" ::: "memory"); }
#define ATT_QK(P0, P1, ti_) do { const LAS unsigned char* kb = shm + (((ti_) + par) & 1) * 8192 + hi * 1024 + r32 * 16; \
        _Pragma("unroll") for (int d0 = 0; d0 < 4; ++d0) { const bf16x8 b0 = *(const LAS bf16x8*)(kb + d0 * 2048), b1 = *(const LAS bf16x8*)(kb + d0 * 2048 + 512); \
            if (d0 == 0) { P0 = __builtin_amdgcn_mfma_f32_32x32x16_bf16(b0, qr[0], negm, 0, 0, 0); P1 = __builtin_amdgcn_mfma_f32_32x32x16_bf16(b1, qr[0], negm, 0, 0, 0); } \
            else { P0 = __builtin_amdgcn_mfma_f32_32x32x16_bf16(b0, qr[d0], P0, 0, 0, 0); P1 = __builtin_amdgcn_mfma_f32_32x32x16_bf16(b1, qr[d0], P1, 0, 0, 0); } } } while (0)
        { int l0_ = lane; asm volatile("" : "+v"(l0_)); const int r32 = l0_ & 31, hi = l0_ >> 5; ATT_QK(pc0, pc1, 0); }
        asm volatile("s_waitcnt vmcnt(0) lgkmcnt(0)" ::: "memory"); __builtin_amdgcn_s_barrier(); asm volatile("" ::: "memory");
#pragma unroll 1
        for (int ti = 0; ti < nt; ++ti) {
            int ln_ = lane; asm volatile("" : "+v"(ln_));
            const int r32 = ln_ & 31, hi = ln_ >> 5;
            if (ti + 2 < nt) ATT_DMA_K(g, par, ti + 2);
            if (ti + 1 < nt) ATT_DMA_V(g, par, ti + 1);
            if (ti + 1 == nt && hasn) { ATT_DMA_K(gn, parn, 0); ATT_DMA_V(gn, parn, 0); ATT_DMA_K(gn, parn, 1); ATT_LOADQ(gn); }
            bf16x8 kf[8];
            { const LAS unsigned char* kb = shm + ((ti + 1 + par) & 1) * 8192 + hi * 1024 + r32 * 16;
#pragma unroll
              for (int d0 = 0; d0 < 4; ++d0) { kf[2 * d0] = *(const LAS bf16x8*)(kb + d0 * 2048); kf[2 * d0 + 1] = *(const LAS bf16x8*)(kb + d0 * 2048 + 512); } }
            __builtin_amdgcn_sched_barrier(0);
            const bool act = TYPE == 0 || ti < 4 || (ti >= g.alo && ti < g.ahi), actn = (ti + 1 < nt) && (TYPE == 0 || ti + 1 < 4 || (ti + 1 >= g.alo && ti + 1 < g.ahi));
            int mode = 0, aux = 0;
            if (ti >= 4) {
                if (TYPE == 0) { const int j = g.jlo + (ti - 4); if (j == 0 || j == 4) { mode = 1; aux = 64 * j - 128 - 32 * (wid & 1); } }
                else { mode = 2; aux = (g.R0 + (ti - 4)) - (4 * g.blk + (wid >> 1)) + 7; }
            }
            if (act) {
                if (mode == 1) {
                    const int dbase = aux - r32 + 4 * hi;
#pragma unroll
                    for (int r = 0; r < 16; ++r) { const int d0_ = dbase + (r & 3) + 8 * (r >> 2); if (abs(d0_) > 128) pc0[r] = NEGBIG; if (abs(d0_ + 32) > 128) pc1[r] = NEGBIG; }
                } else if (mode == 2) {
                    const int qc = 32 * (wid & 1) + r32, cs = min(max(qc - 8, 0), 48);
                    const LAS float* tb = (const LAS float*)(shm + LDS_BIAS) + aux * 896 + (qc - cs) * 56;
                    const int off = 16 - cs + 4 * hi;
#define ATT_TBG(P, j, kadd) do { const LAS float* p_ = tb + (min(max(off + 8 * (j) + (kadd), -4), 48) + 4); \
        P[4 * (j)] += p_[0]; P[4 * (j) + 1] += p_[1]; P[4 * (j) + 2] += p_[2]; P[4 * (j) + 3] += p_[3]; } while (0)
                    if ((wid & 1) == 0) {
#pragma unroll
                        for (int j = 0; j < 4; ++j) ATT_TBG(pc0, j, 0);
                        ATT_TBG(pc1, 0, 32);
#pragma unroll
                        for (int r = 4; r < 16; ++r) pc1[r] = NEGBIG;
                    } else {
#pragma unroll
                        for (int r = 0; r < 12; ++r) pc0[r] = NEGBIG;
                        ATT_TBG(pc0, 3, 0);
#pragma unroll
                        for (int j = 0; j < 4; ++j) ATT_TBG(pc1, j, 32);
                    }
#undef ATT_TBG
                }
                float rm = fmaxf(fmaxf(pc0[0], pc0[1]), pc0[2]), rm1 = fmaxf(fmaxf(pc1[0], pc1[1]), pc1[2]);
#pragma unroll
                for (int r = 3; r < 15; r += 2) { rm = fmaxf(fmaxf(rm, pc0[r]), pc0[r + 1]); rm1 = fmaxf(fmaxf(rm1, pc1[r]), pc1[r + 1]); }
                rm = fmaxf(fmaxf(rm, pc0[15]), fmaxf(rm1, pc1[15]));
                if (ti == 0 || __any(rm > THR)) {
                    rm = max_halves(rm);
                    const float dl = (ti == 0) ? rm : fmaxf(rm, 0.f); mrun += dl;
#pragma unroll
                    for (int r = 0; r < 16; ++r) { pc0[r] -= dl; pc1[r] -= dl; negm[r] = -mrun; }
                    if (ti != 0) {
                        const float f = __builtin_amdgcn_exp2f(-dl); lrun *= f;
                        if (hi == 0) wsf[r32] = f;
#pragma unroll
                        for (int r = 0; r < 16; ++r) { const float fr_ = wsf[crow(r, hi)]; o[0][r] *= fr_; o[1][r] *= fr_; }
                    }
                }
            }
            u32x4 pw[4];
            if (act) {
                f32x2_t sa = {0.f, 0.f}, sb = {0.f, 0.f};
#pragma unroll
                for (int r = 0; r < 16; r += 2) { pc0[r] = __builtin_amdgcn_exp2f(pc0[r]); pc0[r + 1] = __builtin_amdgcn_exp2f(pc0[r + 1]); pc1[r] = __builtin_amdgcn_exp2f(pc1[r]); pc1[r + 1] = __builtin_amdgcn_exp2f(pc1[r + 1]);
                    sa += (f32x2_t){pc0[r], pc0[r + 1]}; sb += (f32x2_t){pc1[r], pc1[r + 1]}; }
                sa += sb; lrun += sa[0] + sa[1];
#pragma unroll
                for (int q = 0; q < 4; ++q) { pw[0][q] = cvtpk_s(pc0[2 * q], pc0[2 * q + 1]); pw[1][q] = cvtpk_s(pc0[8 + 2 * q], pc0[8 + 2 * q + 1]); pw[2][q] = cvtpk_s(pc1[2 * q], pc1[2 * q + 1]); pw[3][q] = cvtpk_s(pc1[8 + 2 * q], pc1[8 + 2 * q + 1]); }
                asm volatile("" : "+v"(pw[0]), "+v"(pw[1]), "+v"(pw[2]), "+v"(pw[3]), "+v"(lrun));
            }
            s16x4 vl[8], vh[8];
            if (act) {
                const LAS unsigned char* vp = shm + 16384 + ((ti + par) & 1) * 8192 + ((r32 >> 4) & 1) * 32 + (r32 & 3) * 8 + (4 * hi + ((r32 & 15) >> 2)) * 64;
#pragma unroll
                for (int d0 = 0; d0 < 2; ++d0)
#pragma unroll
                    for (int ks = 0; ks < 4; ++ks) { vl[d0 * 4 + ks] = vtr(vp + d0 * 4096 + ks * 1024); vh[d0 * 4 + ks] = vtr(vp + d0 * 4096 + ks * 1024 + 512); }
            }
            __builtin_amdgcn_sched_barrier(0);
            if (actn) {
#pragma unroll
                for (int d0 = 0; d0 < 4; ++d0) {
                    if (d0 == 0) { pc0 = __builtin_amdgcn_mfma_f32_32x32x16_bf16(kf[0], qr[0], negm, 0, 0, 0); pc1 = __builtin_amdgcn_mfma_f32_32x32x16_bf16(kf[1], qr[0], negm, 0, 0, 0); }
                    else { pc0 = __builtin_amdgcn_mfma_f32_32x32x16_bf16(kf[2 * d0], qr[d0], pc0, 0, 0, 0); pc1 = __builtin_amdgcn_mfma_f32_32x32x16_bf16(kf[2 * d0 + 1], qr[d0], pc1, 0, 0, 0); } }
            }
            if (act) {
#pragma unroll
                for (int d0 = 0; d0 < 2; ++d0)
#pragma unroll
                    for (int ks = 0; ks < 4; ++ks) { const s16x4 lo = vl[d0 * 4 + ks], hh = vh[d0 * 4 + ks];
                        const bf16x8 vf = (bf16x8){lo[0], lo[1], lo[2], lo[3], hh[0], hh[1], hh[2], hh[3]};
                        o[d0] = __builtin_amdgcn_mfma_f32_32x32x16_bf16(__builtin_bit_cast(bf16x8, pw[ks]), vf, o[d0], 0, 0, 0); }
            }
            asm volatile("s_waitcnt vmcnt(0) lgkmcnt(0)" ::: "memory"); __builtin_amdgcn_s_barrier(); asm volatile("" ::: "memory");
        }
        lrun = sum_halves(lrun);
        if (TYPE == 0) lrun += __builtin_amdgcn_exp2f(sinkv - mrun);
        int le_ = lane; asm volatile("" : "+v"(le_));
        const int r32 = le_ & 31, hi = le_ >> 5;
        if (hi == 0) wsf[32 + r32] = 1.0f / lrun;
        LAS bf16_t* stg3 = (LAS bf16_t*)(shm + LDS_OST) + wid * 2048;
        f32x4 rl4[4];
#pragma unroll
        for (int j = 0; j < 4; ++j) rl4[j] = *(const LAS f32x4*)(wsf + 32 + 8 * j + 4 * hi);
#pragma unroll
        for (int r = 0; r < 16; ++r) { const int orow = crow(r, hi); const float rl_ = rl4[r >> 2][r & 3];
            stg3[orow * 64 + r32] = (bf16_t)cvtpk_s(o[0][r] * rl_, 0.f); stg3[orow * 64 + 32 + r32] = (bf16_t)cvtpk_s(o[1][r] * rl_, 0.f); }
        asm volatile("s_waitcnt lgkmcnt(0)" ::: "memory");
        { char* ob_ = (char*)MIX + (size_t)g.qrow * (D * 2) + g.ocol * 2;
#pragma unroll
          for (int i = 0; i < 4; ++i) { const int row = i * 8 + (le_ >> 3), ch = le_ & 7; const u32x4 v = *(const LAS u32x4*)(stg3 + row * 64 + ch * 8); *(u32x4*)(ob_ + (unsigned)(row * D + ch * 8) * 2u) = v; } }
        asm volatile("s_waitcnt lgkmcnt(0)" ::: "memory");
        g = gn; par = parn;
    }
    __builtin_amdgcn_s_barrier(); asm volatile("" ::: "memory");
#undef ATT_DMA_K
#undef ATT_DMA_V
#undef ATT_TROW
#undef ATT_QK
#undef ATT_LOADQ
}
}

__device__ __forceinline__ void phase_attn(Frame& F, int l, const bf16_t* U, bf16_t* MIX, bool with_ctx) {
    LAS unsigned char* shm = F.lds;
    const int nA = 1024 + (with_ctx ? 32 : 0), nB = 512 + (with_ctx ? 16 : 0);
#ifndef DBG_MIX
#define DBG_MIX 0
#endif
    LAS int* ul = (LAS int*)(shm + att::LDS_ULIST);
    if (F.tid_() == 0) { int n = 0;
#pragma unroll 1
        for (int j = 0; j < ((DBG_MIX & 1) ? 10 : 5); ++j) { const int jj = j % 5;
#pragma unroll 1
            for (int ua = (jj < 4 ? F.vcu * 4 + jj : 1024 + F.vcu); ua < (jj < 4 ? min(1024, nA) : nA); ua += (jj < 4 ? F.G * 4 : F.G)) ul[1 + n++] = ua; }
        ul[0] = n; }
    __syncthreads();
    { const int n = __builtin_amdgcn_readfirstlane(ul[0]); if (n > 0) att::attn_stream<0>(F, l, U, MIX, shm, n); }
    __syncthreads();
    if (F.tid_() == 0) { int n = 0;
#pragma unroll 1
        for (int j = 0; j < ((DBG_MIX & 2) ? 6 : 3); ++j) { const int jj = j % 3;
#pragma unroll 1
            for (int ub = (jj < 2 ? F.vcu * 2 + jj : 512 + ((F.vcu + F.G - 32) % F.G)); ub < (jj < 2 ? min(512, nB) : nB); ub += (jj < 2 ? F.G * 2 : F.G)) ul[1 + n++] = ub; }
        ul[0] = n; }
    __syncthreads();
    { const int n = __builtin_amdgcn_readfirstlane(ul[0]); if (n > 0) att::attn_stream<1>(F, l, U, MIX, shm, n); }
    __syncthreads();
}


constexpr int NPHASE = 18;
__global__ void __launch_bounds__(NTHR, 2) hybrid_fwd(Args args) {
    extern __shared__ __attribute__((aligned(16))) unsigned char lds_raw[];
    Frame F;
    F.lds = (LAS unsigned char*)lds_raw;
    F.lane = threadIdx.x & 63; F.wave = __builtin_amdgcn_readfirstlane(threadIdx.x >> 6);
    F.G = gridDim.x; { const int bx = blockIdx.x; F.vcu = (F.G % 8 == 0) ? (bx % 8) * (F.G / 8) + bx / 8 : bx; }
    F.ws = args.ws;
    for (int u = F.tid_(); u < (LDS_BYTES - LDSCTL_OFF) / 4; u += NTHR) ((LAS unsigned*)(F.lds + LDSCTL_OFF))[u] = 0u;
    __syncthreads();
    if (F.tid_() < 24) ((LAS unsigned long long*)(F.lds + PTR_OFF))[F.tid_()] = ((const unsigned long long*)&args)[F.tid_()];
    __syncthreads();
    volatile LAS unsigned* MISC = (volatile LAS unsigned*)(F.lds + MISC_OFF);
    XcdBarrier bar; bar.bar = (unsigned*)(F.ws + WS_CTL) + CW_BAR; bar.x = 0; bar.st = nullptr;
    if (!MK_PER_PHASE) bar = xcd_barrier_post((unsigned*)(F.ws + WS_CTL) + CW_BAR, MISC + 8);
    const int lo = args.ph_lo, hi = args.ph_hi;
    const int wave0 = F.wave; LAS unsigned char* const lds_base = F.lds;
    bool repeated = false;
#pragma unroll 1
    for (int ph = lo; ph < hi; ++ph) {
        { unsigned char* w = (unsigned char*)inp(F, 23); asm volatile("" : "+s"(w)); F.ws = w;
          unsigned z_ = 0u; asm volatile("" : "+v"(z_));
          int w_ = wave0, l_ = (int)__builtin_amdgcn_mbcnt_hi(~0u, __builtin_amdgcn_mbcnt_lo(~0u, z_)); asm volatile("" : "+s"(w_), "+v"(l_)); F.wave = w_; F.lane = l_;
          unsigned lb_ = (unsigned)(uintptr_t)lds_base; asm volatile("" : "+s"(lb_)); F.lds = (LAS unsigned char*)(uintptr_t)lb_;
          int bx_ = blockIdx.x, g_ = gridDim.x; asm volatile("" : "+s"(bx_), "+s"(g_)); F.G = g_; F.bx = bx_; F.vcu = (g_ % 8 == 0) ? (bx_ % 8) * (g_ / 8) + bx_ / 8 : bx_; }
#ifndef DBG_REP
#define DBG_REP 0
#endif
        const int ptype = ph == 0 ? 8 : ph == 1 ? 9 : ((ph - 2) & 7);
        const bool cia = F.G >= 64;
        const int NC0 = cia ? 32 : 0, NC1 = cia ? 12 : 0;
        int inproj = 0, il = 0;
        const int l = ph >= 2 ? (ph - 2) >> 3 : 0, p = ph >= 2 ? (ph - 2) & 7 : -1;
        unsigned char* rA = F.ws + (l == 0 ? WS_P : WS_Q); unsigned char* rB = F.ws + (l == 0 ? WS_Q : WS_P);
        const bool wc = (l == 0);
        const int nrows = wc ? R : RL, mt = wc ? 17 : 16;
        if (ph == 0) { mod_items(F); __syncthreads(); rope_table(F);
            { int* rid = (int*)(F.ws + WS_RIDENT); for (int i = F.vcu * NTHR + F.tid_(); i < NE * EROWS; i += F.G * NTHR) rid[i] = i; }
            { const int nmod = F.G > 96 ? 48 : 0, cut = (CONV_NITEMS * 86) / 100;
              convert_weights(F, 0, 0, cut, F.vcu, F.G); if (F.vcu >= nmod) convert_weights(F, 0, cut, CONV_NITEMS, F.vcu - nmod, F.G - nmod); } }
        else if (ph == 1) { if (F.vcu >= NC0) phase_h0(F, (bf16_t*)(F.ws + WS_P), NC0); else { inproj = 2; il = 0; } }
        else if (p == 0) { inproj = 1; il = l; }
        else if (p == 1) {
            phase_attn(F, l, (const bf16_t*)rB, (bf16_t*)(rA + HALFREG), wc); phase_conv(F, l, (const bf16_t*)rB, (bf16_t*)(rA + HALFREG), wc);
        } else if (p == 2) {
            pg8::Gemm g{(const bf16_t*)(rA + HALFREG), (const bf16_t*)(F.ws + wsw(l, WS_WOUT)), D, nullptr}; pg8::TileOrder S; S.init(nrows / 256, D / 256, F.G, F.bx, 0);
            pg8::EpiBf16 E{(bf16_t*)rA, D};
            pg8::gemm_phase<pg8::EpiBf16, false, false>(F.tid_(), F.lds, F.lds + RIDX_OFF, g, S, E);
            if (l == 0) { const int nu = (nrows / 256) * (D / 256), nlast = nu - (nu / F.G) * F.G; if (F.bx >= nlast) { __syncthreads(); convert_weights(F, 1, 0, CONV_S1, F.bx - nlast, F.G - nlast); } }
        } else if (p == 3) { if (l == 0) phase_rowpass1<true>(F, l, (const bf16_t*)rA, rA + HALFREG, nrows); else phase_rowpass1<false>(F, l, (const bf16_t*)rA, rA + HALFREG, nrows);
        } else if (p == 4) { phase_topk(F, wc);
        } else if (p == 5) {
            pg8::Gemm g{(const bf16_t*)(rA + HALFREG), (const bf16_t*)(F.ws + wsw(l, WS_WGU)), D, (const int*)(F.ws + WS_RIDX)}; pg8::TileOrder S; S.init(NE * mt, 8, F.G, F.bx, mt);
            pg8::EpiSwiGLU E{rB};
            pg8::gemm_phase<pg8::EpiSwiGLU, true, true>(F.tid_(), F.lds, F.lds + RIDX_OFF, g, S, E);
            if (l == 0) { const int nu = NE * mt * 8, nlast = nu - (nu / F.G) * F.G; if (nlast > 0 && F.bx >= nlast) { __syncthreads(); convert_weights(F, 1, CONV_S1, CONV_S2, F.bx - nlast, F.G - nlast); } }
        } else if (p == 6) {
            pg8::Gemm g{(const bf16_t*)rB, (const bf16_t*)(F.ws + wsw(l, WS_WD)), FF, (const int*)(F.ws + WS_RIDENT)}; pg8::TileOrder S; S.init(NE * mt, 4, F.G, F.bx, mt);
            pg8::EpiRowScale E{rA, (const float*)(F.ws + WS_GATEW), (const LAS float*)(F.lds + pg8::ROWVEC_OFF)};
            pg8::gemm_phase<pg8::EpiRowScale, true, true>(F.tid_(), F.lds, F.lds + RIDX_OFF, g, S, E);
            if (l == 0) { const int nu = NE * mt * 4, nlast = nu - (nu / F.G) * F.G; if (nlast > 0 && F.bx >= nlast) { __syncthreads(); convert_weights(F, 1, CONV_S2, CONV_NITEMS, F.bx - nlast, F.G - nlast); } }
        } else {
            if (l == 0 && F.vcu < NC1) { inproj = 3; il = 1; } else { if (l == 0) phase_rowpass2<true>(F, l, rA, (bf16_t*)rB, nrows, NC1); else phase_rowpass2<false>(F, l, rA, (bf16_t*)rB, nrows, 0); }
        }
        if (inproj) {
            unsigned char* hA = F.ws + (il == 0 ? WS_P : WS_Q); unsigned char* uB = F.ws + (il == 0 ? WS_Q : WS_P);
            pg8::Gemm g{(const bf16_t*)hA, (const bf16_t*)(F.ws + wsw(il, WS_WIN)), D, nullptr}; pg8::TileOrder S;
            if (inproj == 1) S.init((cia ? RL : R) / 256, INW / 256, F.G, F.bx, 0); else { S.init_special(inproj - 1, F.vcu); cia_wait(F, inproj - 2); }
            pg8::EpiInProj E{(bf16_t*)uB, (const float*)(F.ws + WS_ROPE), (const float*)(F.ws + WS_ROPE) + 128 * 16};
            pg8::gemm_phase<pg8::EpiInProj, false, false>(F.tid_(), F.lds, F.lds + RIDX_OFF, g, S, E);
        }
        if (DBG_REP && ((DBG_REP >> ptype) & 1) && !repeated) { repeated = true; __syncthreads(); --ph; continue; }
        repeated = false;
#ifdef DBG_BAR2
        if (ph + 1 < hi) xcd_barrier(bar);
#endif
        if (ph + 1 < hi) xcd_barrier(bar);
    }
}

extern "C" void kernel_launch(void* const* d_in, const int* in_sizes, int n_in, void* d_out, int out_size, void* d_ws, size_t ws_size, hipStream_t stream) {
    static int grid = 0;
    if (grid == 0) {
        if (n_in != 22 || out_size != RL * D || ws_size < WS_END) { fprintf(stderr, "kernel_launch: unexpected shapes (n_in %d out %d ws %zu)\n", n_in, out_size, ws_size); grid = -1; return; }
        int dev = 0, cus = 0, per_cu = 0;
        if (hipGetDevice(&dev) != hipSuccess || hipDeviceGetAttribute(&cus, hipDeviceAttributeMultiprocessorCount, dev) != hipSuccess) { grid = -1; return; }
        if (hipFuncSetAttribute((const void*)hybrid_fwd, hipFuncAttributeMaxDynamicSharedMemorySize, LDS_BYTES) != hipSuccess) { fprintf(stderr, "kernel_launch: hipFuncSetAttribute failed\n"); grid = -1; return; }
        if (hipOccupancyMaxActiveBlocksPerMultiprocessor(&per_cu, (const void*)hybrid_fwd, NTHR, LDS_BYTES) != hipSuccess || per_cu < 1) { fprintf(stderr, "kernel_launch: occupancy query says %d blocks/CU\n", per_cu); grid = -1; (void)hipGetLastError(); return; }
        grid = cus;
    }
    if (grid < 0) return;
    (void)hipMemsetAsync((char*)d_ws + WS_CTL, 0, CTL_ZERO_BYTES, stream);
    Args a{};
    for (int i = 0; i < 22; ++i) a.in[i] = (const float*)d_in[i];
    a.out = (float*)d_out; a.ws = (unsigned char*)d_ws;
#if MK_PER_PHASE
    for (int p = 0; p < NPHASE; ++p) { a.ph_lo = p; a.ph_hi = p + 1; hipLaunchKernelGGL(hybrid_fwd, dim3(grid), dim3(NTHR), LDS_BYTES, stream, a); }
#else
    a.ph_lo = 0; a.ph_hi = NPHASE;
    hipLaunchKernelGGL(hybrid_fwd, dim3(grid), dim3(NTHR), LDS_BYTES, stream, a);
#endif
}
```

```cpp
#include <hip/hip_runtime.h>
#include <cstdio>
#include <cstdint>

#ifndef MK_PER_PHASE
#define MK_PER_PHASE 0
#endif

#define LAS __attribute__((address_space(3)))
#define GAS __attribute__((address_space(1)))
typedef unsigned short bf16_t;
typedef short bf16x8 __attribute__((ext_vector_type(8)));
typedef float f32x4 __attribute__((ext_vector_type(4)));
typedef float f32x2 __attribute__((ext_vector_type(2)));
typedef unsigned u32x4 __attribute__((ext_vector_type(4)));
typedef unsigned u32x2 __attribute__((ext_vector_type(2)));

constexpr int D = 1024, NB = 4, SEQ = 8192, NCTX = 256, RL = NB * SEQ, RC = NB * NCTX, R = RL + RC;
constexpr int INW = 2048, NE = 16, FF = 1024;
constexpr int OFF_AQ = 0, OFF_AK = 512, OFF_AV = 640, OFF_BQ = 768, OFF_BK = 1024, OFF_BV = 1280, OFF_C = 1536;
constexpr int CAP_L = 1024, CAP_C = 32, EROWS = 4352, EMT = 17;
constexpr float LN_EPS = 1e-6f, ALPHA = 1.41421356237309515f;
constexpr float LOG2E = 1.4426950408889634f;
constexpr float C2 = 0.125f * LOG2E;

constexpr size_t MiB = 1u << 20;
constexpr size_t WS_CTL = 0, CTL_ZERO_BYTES = 1 * MiB;
constexpr size_t WS_MOD = 1 * MiB;
constexpr size_t WS_ROPE = 1 * MiB + 512 * 1024;
constexpr size_t WS_AFF = 2 * MiB;
constexpr size_t WS_AFFC = 4 * MiB;
constexpr size_t WS_INV = 5 * MiB;
constexpr size_t WS_RIDX = 8 * MiB;
constexpr size_t WS_GATEW = 8 * MiB + 512 * 1024;
constexpr size_t WS_RIDENT = 4 * MiB + 512 * 1024;
constexpr size_t WS_XC = 9 * MiB;
constexpr size_t WS_WIN = 13 * MiB;
constexpr size_t WS_WOUT = 17 * MiB;
constexpr size_t WS_WGU = 19 * MiB;
constexpr size_t WS_WD = 83 * MiB;
constexpr size_t WS_XA = 115 * MiB;
constexpr size_t WS_P = 247 * MiB;
constexpr size_t WS_Q = 383 * MiB;
constexpr size_t REGION = 136 * MiB, HALFREG = 68 * MiB;
constexpr size_t WS_W1 = 519 * MiB;
constexpr size_t WS_END = 573 * MiB;
__host__ __device__ constexpr size_t wsw(int l, size_t off) { return l == 0 ? off : (off == 13 * MiB ? WS_W1 : off == 17 * MiB ? WS_W1 + 4 * MiB : off == 19 * MiB ? WS_W1 + 6 * MiB : WS_W1 + 38 * MiB); }
constexpr int CW_BAR = 4096;

constexpr int RING_BYTES = 131072;
constexpr int RIDX_OFF = 143360;
constexpr int LDSCTL_OFF = RIDX_OFF + 2048, MISC_OFF = LDSCTL_OFF + 320, PTR_OFF = LDSCTL_OFF + 512;
constexpr int LDS_BYTES = 147456;
constexpr int NWAVES = 8, NTHR = 512;

__device__ __forceinline__ unsigned f2bf(float f) { unsigned u = __builtin_bit_cast(unsigned, f); return (u + 0x7fffu + ((u >> 16) & 1u)) >> 16; }
__device__ __forceinline__ unsigned pk2(float lo, float hi) { return f2bf(lo) | (f2bf(hi) << 16); }
__device__ __forceinline__ float bf2f(unsigned short b) { return __builtin_bit_cast(float, (unsigned)b << 16); }
__device__ __forceinline__ float bflo(unsigned w) { return __builtin_bit_cast(float, w << 16); }
__device__ __forceinline__ float bfhi(unsigned w) { return __builtin_bit_cast(float, w & 0xffff0000u); }
__device__ __forceinline__ unsigned pk4_fp8(float a, float b, float c, float d) { int w = 0; w = __builtin_amdgcn_cvt_pk_fp8_f32(a, b, w, false); w = __builtin_amdgcn_cvt_pk_fp8_f32(c, d, w, true); return (unsigned)w; }
__device__ __forceinline__ unsigned cvt_pk_bf16(float lo, float hi) { unsigned r; asm volatile("v_cvt_pk_bf16_f32 %0, %1, %2" : "=v"(r) : "v"(lo), "v"(hi)); return r; }
template <int O> __device__ __forceinline__ float swz_xor(float v) { return __builtin_bit_cast(float, __builtin_amdgcn_ds_swizzle(__builtin_bit_cast(int, v), (O << 10) | 0x1f)); }
__device__ __forceinline__ void swap_halves(float v, float& lo_everywhere, float& hi_everywhere) {
    unsigned a = __builtin_bit_cast(unsigned, v), b = a;
    asm volatile("s_nop 1\n\tv_permlane32_swap_b32 %0, %1\n\ts_nop 0" : "+v"(a), "+v"(b));
    lo_everywhere = __builtin_bit_cast(float, a); hi_everywhere = __builtin_bit_cast(float, b);
}
__device__ __forceinline__ float sum_halves(float v) { float x, y; swap_halves(v, x, y); return x + y; }
__device__ __forceinline__ float max_halves(float v) { float x, y; swap_halves(v, x, y); return fmaxf(x, y); }
__device__ __forceinline__ float other_half(float v, int hi) { float x, y; swap_halves(v, x, y); return hi ? x : y; }
template <int CTRL> __device__ __forceinline__ float dppf(float v) { return __builtin_bit_cast(float, __builtin_amdgcn_update_dpp(0, __builtin_bit_cast(int, v), CTRL, 0xf, 0xf, true)); }
__device__ __forceinline__ float row16_sum(float v) { v += dppf<0xB1>(v); v += dppf<0x4E>(v); v += dppf<0x141>(v); v += dppf<0x140>(v); return v; }
__device__ __forceinline__ float row16_max(float v) { v = fmaxf(v, dppf<0xB1>(v)); v = fmaxf(v, dppf<0x4E>(v)); v = fmaxf(v, dppf<0x141>(v)); v = fmaxf(v, dppf<0x140>(v)); return v; }
__device__ __forceinline__ float wave_sum(float v) { v = row16_sum(v); v += swz_xor<16>(v); return sum_halves(v); }
__device__ __forceinline__ void wave_sum2(float& a, float& b) {
    a = row16_sum(a); b = row16_sum(b); const float a2 = swz_xor<16>(a), b2 = swz_xor<16>(b); a += a2; b += b2; a = sum_halves(a); b = sum_halves(b);
}
__device__ __forceinline__ unsigned lane_get(unsigned v, int srclane) { return (unsigned)__builtin_amdgcn_ds_bpermute(srclane << 2, (int)v); }
#define LDS_WAIT() asm volatile("s_waitcnt lgkmcnt(0)" ::: "memory")
#define VM_WAIT() asm volatile("s_waitcnt vmcnt(0)" ::: "memory")

#define XB_TMO      128
#define XB_XCNT(j)  (256  + 64 * (j))
#define XB_XSUB(j)  (1280 + 64 * (j))
#define XB_XGEN(j)  (2304 + 64 * (j))
#define XB_TOP      3328
#define XB_TOPGEN   3392
#define XCD_BAR_WORDS 3456
#define XB_SPIN_CAP (1u << 24)
__device__ __forceinline__ unsigned xb_ld(unsigned* p)              { return __hip_atomic_load(p, __ATOMIC_RELAXED, __HIP_MEMORY_SCOPE_AGENT); }
__device__ __forceinline__ unsigned xb_add(unsigned* p, unsigned v) { return __hip_atomic_fetch_add(p, v, __ATOMIC_RELAXED, __HIP_MEMORY_SCOPE_AGENT); }
__device__ __forceinline__ unsigned xb_xcc_id() { return (unsigned)__builtin_amdgcn_s_getreg((3 << 11) | 20) & 0xFu; }
#define XB_SPIN(cond, bar) do { unsigned _sp = 0; while (cond) { __builtin_amdgcn_s_sleep(1); \
    if ((++_sp & 255u) == 0u) { if (xb_ld(&(bar)[XB_TMO])) break; if (_sp > XB_SPIN_CAP) { atomicAdd(&(bar)[XB_TMO], 1u); break; } } } } while (0)
struct XcdBarrier { unsigned* bar; unsigned x; volatile LAS unsigned* st; };
__device__ __forceinline__ XcdBarrier xcd_barrier_post(unsigned* bar, volatile LAS unsigned* st) {
    XcdBarrier b; b.bar = bar; b.x = xb_xcc_id(); b.st = st;
    if (threadIdx.x == 0) (void)xb_add(&bar[XB_XCNT(b.x)], 1u);
    return b;
}
__device__ __forceinline__ int xb_row16_isum(int v) {
    v += __builtin_amdgcn_update_dpp(0, v, 0xB1, 0xf, 0xf, true); v += __builtin_amdgcn_update_dpp(0, v, 0x4E, 0xf, 0xf, true);
    v += __builtin_amdgcn_update_dpp(0, v, 0x141, 0xf, 0xf, true); v += __builtin_amdgcn_update_dpp(0, v, 0x140, 0xf, 0xf, true); return v;
}
__device__ __forceinline__ void xcd_barrier_complete_w0(unsigned* bar, unsigned x, unsigned& nloc, unsigned& nx, int tid) {
    const unsigned G = gridDim.x * gridDim.y * gridDim.z;
    unsigned ln = (unsigned)tid & 63u; asm volatile("" : "+v"(ln));
    unsigned c = 0u, sp = 0u;
    for (;;) {
        c = (ln < 16u) ? xb_ld(&bar[XB_XCNT(ln)]) : 0u;
        const unsigned sum = (unsigned)__builtin_amdgcn_readfirstlane(xb_row16_isum((int)c));
        if (sum == G) break;
        __builtin_amdgcn_s_sleep(1);
        if ((++sp & 255u) == 0u) { if (xb_ld(&bar[XB_TMO])) break; if (sp > XB_SPIN_CAP) { if (ln == 0u) atomicAdd(&bar[XB_TMO], 1u); break; } }
    }
    const unsigned cnt = (unsigned)__builtin_popcountll(__ballot(c > 0u));
    const unsigned mine = (unsigned)__builtin_amdgcn_readlane((int)c, (int)x);
    nloc = mine > 0u ? mine : 1u; nx = cnt > 0u ? cnt : 1u;
}
__device__ __forceinline__ void xcd_barrier(const XcdBarrier& b, int tid) {
    asm volatile("s_waitcnt vmcnt(0)" ::: "memory");
    __syncthreads();
    if (tid < 64) {
        unsigned* bar = b.bar; unsigned bx_ = b.x; asm volatile("" : "+s"(bar), "+s"(bx_));
        __builtin_amdgcn_s_waitcnt(0);
        unsigned nloc = b.st[0], nx = b.st[1];
        if (nloc == 0u) { xcd_barrier_complete_w0(bar, bx_, nloc, nx, tid); if (tid == 0) { b.st[0] = nloc; b.st[1] = nx; } }
        if (tid == 0) {
        const unsigned old = xb_add(&bar[XB_XSUB(bx_)], 1u);
        const unsigned gen = old / nloc;
        if (old + 1u == (gen + 1u) * nloc) {
            __builtin_amdgcn_fence(__ATOMIC_RELEASE, "agent");
            asm volatile("s_waitcnt vmcnt(0)" ::: "memory");
            const unsigned og = xb_add(&bar[XB_TOP], 1u);
            const unsigned tg = og / nx;
            if (og + 1u == (tg + 1u) * nx) xb_add(&bar[XB_TOPGEN], 1u);
            else XB_SPIN(xb_ld(&bar[XB_TOPGEN]) == tg, bar);
            __builtin_amdgcn_fence(__ATOMIC_ACQUIRE, "agent");
            xb_add(&bar[XB_XGEN(bx_)], 1u);
            asm volatile("s_waitcnt vmcnt(0)" ::: "memory");
        } else {
            XB_SPIN(xb_ld(&bar[XB_XGEN(bx_)]) == gen, bar);
            __builtin_amdgcn_fence(__ATOMIC_ACQUIRE, "agent");
            asm volatile("s_waitcnt vmcnt(0)" ::: "memory");
        }
        }
    }
    __syncthreads();
}

namespace pg8 {
constexpr int BM = 256, BK = 64, HALF = 128, HTB = HALF * BK * 2, STAGE_BYTES = 8 * HTB, NXCD = 8, WGM = 8, ROWVEC_OFF = STAGE_BYTES;
__host__ __device__ constexpr __forceinline__ int lds_byte(int r, int c) { const int st = (r >> 4) * 2 + (c >> 5), rr = r & 15, cc = c & 31, ob = rr * 64 + cc * 2; return st * 1024 + (ob ^ (((ob >> 9) & 1) << 5)); }
__host__ __device__ __forceinline__ void stage_rc(int b, int& Rr, int& C) { const int st = b / 1024, sb = b % 1024, swz = sb ^ (((sb >> 9) & 1) << 5); Rr = (st >> 1) * 16 + swz / 64; C = (st & 1) * 32 + (swz % 64) / 2; }
__host__ __device__ __forceinline__ int perm32(int rho) { const int n = rho >> 4, i = rho & 15; return 8 * (i >> 2) + 4 * n + (i & 3); }

struct Unit { int pm, pn, am, bn; };
struct Gemm { const bf16_t* A; const bf16_t* Bt; int K; const int* ridx; };

struct TileOrder {
    int nM, nN, nwg, G, c, mt, special, sidx;
    __device__ void init(int nM_, int nN_, int G_, int c_, int mt_) { nM = nM_; nN = nN_; nwg = nM * nN; G = G_; c = c_; mt = mt_; special = 0; sidx = 0; }
    __device__ void init_special(int kind, int idx) { nM = nN = nwg = G = 1; c = 0; mt = 0; special = kind; sidx = idx; }
    __device__ bool next(int i, Unit& u) const {
        int pm, pn, am, bn; bool ok;
        if (special) { ok = (i == 0); const int t = sidx >> 2; pm = am = RL / BM + (sidx & 3); pn = bn = (special == 1) ? t : (t == 0 ? 2 : 3 + t); }
        else {
            const long L = (long)i * G + c; ok = L < nwg;
            int wgid = ok ? (int)L : 0; { const int q = nwg / NXCD, r = nwg % NXCD, xcd = wgid % NXCD, off = wgid / NXCD; wgid = (xcd < r ? xcd * (q + 1) : r * (q + 1) + (xcd - r) * q) + off; }
            const int nig = WGM * nN, gid = wgid / nig, fm = gid * WGM, gsz = (nM - fm) < WGM ? (nM - fm) : WGM;
            pm = fm + ((wgid % nig) % gsz); pn = (wgid % nig) / gsz;
            if (mt > 0) { const int e = pm / mt; am = e * EMT + (pm - e * mt); bn = e * nN + pn; } else { am = pm; bn = pn; }
        }
        u.pm = pm; u.pn = pn; u.am = am; u.bn = bn;
        return ok;
    }
};

struct EpiBf16 {
    static constexpr bool ROWVEC = false;
    bf16_t* O; int ldc;
    __device__ __forceinline__ void operator()(const f32x4 (&acc)[2][2][4][2], const Unit& u, int wr, int wc, int fr, int fq, int ui) const {
        const int row0 = u.am * BM + wr * 64 + fr, col0 = u.pn * BM + wc * 32 + 8 * fq;
#pragma unroll
        for (int ai = 0; ai < 2; ++ai)
#pragma unroll
            for (int m = 0; m < 4; ++m) { bf16_t* rowp = O + (size_t)(row0 + ai * HALF + m * 16) * ldc + col0;
#pragma unroll
                for (int bj = 0; bj < 2; ++bj) { const f32x4 v0 = acc[ai][bj][m][0], v1 = acc[ai][bj][m][1];
                    u32x4 w; w.x = cvt_pk_bf16(v0[0], v0[1]); w.y = cvt_pk_bf16(v0[2], v0[3]); w.z = cvt_pk_bf16(v1[0], v1[1]); w.w = cvt_pk_bf16(v1[2], v1[3]);
                    *(u32x4*)(rowp + bj * HALF) = w; } }
    }
};
struct EpiInProj {
    static constexpr bool ROWVEC = false;
    bf16_t* O; const float* ropec; const float* ropes;
    __device__ __forceinline__ void operator()(const f32x4 (&acc)[2][2][4][2], const Unit& u, int wr, int wc, int fr, int fq, int ui) const {
        const int row0 = u.am * BM + wr * 64 + fr;
        if (u.pn >= 6) {
            const int col0 = OFF_C + (u.pn - 6) * HALF + wc * 32 + 8 * fq;
#pragma unroll
            for (int ai = 0; ai < 2; ++ai)
#pragma unroll
                for (int m = 0; m < 4; ++m) { bf16_t* rowp = O + (size_t)(row0 + ai * HALF + m * 16) * INW + col0;
                    float h[8];
#pragma unroll
                    for (int n = 0; n < 2; ++n)
#pragma unroll
                        for (int i = 0; i < 4; ++i) { const float a = acc[ai][0][m][n][i], g = acc[ai][1][m][n][i]; h[n * 4 + i] = a * __builtin_amdgcn_rcpf(1.0f + __builtin_amdgcn_exp2f(-g * LOG2E)); }
                    u32x4 w; w.x = cvt_pk_bf16(h[0], h[1]); w.y = cvt_pk_bf16(h[2], h[3]); w.z = cvt_pk_bf16(h[4], h[5]); w.w = cvt_pk_bf16(h[6], h[7]);
                    *(u32x4*)rowp = w; }
            return;
        }
        const int col0 = u.pn * BM + wc * 32 + 8 * fq;
        const bool latent = (u.am * BM) < RL;
        const float sc = (u.pn < 2 || u.pn == 3) ? C2 : 1.0f;
        const float sgn = (fq < 2) ? -1.0f : 1.0f;
        const int f0 = 8 * (fq & 1);
        const bool ropetile = latent && u.pn <= 2;
#pragma unroll
        for (int ai = 0; ai < 2; ++ai) {
            f32x4 c0[4], c1[4], s0[4], s1[4];
            if (ropetile) {
#pragma unroll
                for (int m = 0; m < 4; ++m) { const int t = (row0 + ai * HALF + m * 16) & (SEQ - 1); const int pos = (wc & 1) ? (t & 63) : (t >> 6);
                    c0[m] = *(const f32x4*)(ropec + pos * 16 + f0); c1[m] = *(const f32x4*)(ropec + pos * 16 + f0 + 4);
                    s0[m] = *(const f32x4*)(ropes + pos * 16 + f0); s1[m] = *(const f32x4*)(ropes + pos * 16 + f0 + 4); }
            }
#pragma unroll
            for (int m = 0; m < 4; ++m) {
                const int row = row0 + ai * HALF + m * 16;
                bf16_t* rowp = O + (size_t)row * INW + col0;
#pragma unroll
                for (int bj = 0; bj < 2; ++bj) {
                    f32x4 v0 = acc[ai][bj][m][0], v1 = acc[ai][bj][m][1];
                    if (ropetile && (u.pn < 2 || bj == 0)) {
                        f32x4 p0, p1;
#pragma unroll
                        for (int i = 0; i < 4; ++i) { p0[i] = other_half(v0[i], fq >> 1); p1[i] = other_half(v1[i], fq >> 1); }
                        v0 = v0 * c0[m] + (p0 * s0[m]) * sgn; v1 = v1 * c1[m] + (p1 * s1[m]) * sgn;
                    }
                    v0 = v0 * sc; v1 = v1 * sc;
                    u32x4 w; w.x = cvt_pk_bf16(v0[0], v0[1]); w.y = cvt_pk_bf16(v0[2], v0[3]); w.z = cvt_pk_bf16(v1[0], v1[1]); w.w = cvt_pk_bf16(v1[2], v1[3]);
                    *(u32x4*)(rowp + bj * HALF) = w;
                }
            }
        }
    }
};
struct EpiSwiGLU {
    static constexpr bool ROWVEC = false;
    unsigned char* O;
    __device__ __forceinline__ void operator()(const f32x4 (&acc)[2][2][4][2], const Unit& u, int wr, int wc, int fr, int fq, int ui) const {
        const int row0 = u.am * BM + wr * 64 + fr, col0 = u.pn * HALF + wc * 32 + 8 * fq;
#pragma unroll
        for (int ai = 0; ai < 2; ++ai)
#pragma unroll
            for (int m = 0; m < 4; ++m) { unsigned char* rowp = O + (size_t)(row0 + ai * HALF + m * 16) * FF + col0;
                float h[8];
#pragma unroll
                for (int n = 0; n < 2; ++n)
#pragma unroll
                    for (int i = 0; i < 4; ++i) { const float g = acc[ai][0][m][n][i], up = acc[ai][1][m][n][i];
                        const float sg = g * __builtin_amdgcn_rcpf(1.0f + __builtin_amdgcn_exp2f(-g * LOG2E)); h[n * 4 + i] = sg * up; }
                u32x2 w; w.x = pk4_fp8(h[0], h[1], h[2], h[3]); w.y = pk4_fp8(h[4], h[5], h[6], h[7]);
                *(u32x2*)rowp = w; }
    }
};
struct EpiRowScale {
    static constexpr bool ROWVEC = true;
    unsigned char* O; const float* gw; const LAS float* lgw;
    __device__ __forceinline__ void operator()(const f32x4 (&acc)[2][2][4][2], const Unit& u, int wr, int wc, int fr, int fq, int ui) const {
        const int row0 = u.am * BM + wr * 64 + fr, col0 = u.pn * BM + wc * 32 + 8 * fq;
#pragma unroll
        for (int ai = 0; ai < 2; ++ai)
#pragma unroll
            for (int m = 0; m < 4; ++m) { const int row = row0 + ai * HALF + m * 16; const float g = lgw[(ui & 1) * BM + wr * 64 + fr + ai * HALF + m * 16] * 16.0f; unsigned char* rowp = O + (size_t)row * D + col0;
#pragma unroll
                for (int bj = 0; bj < 2; ++bj) { const f32x4 v0 = acc[ai][bj][m][0] * g, v1 = acc[ai][bj][m][1] * g;
                    u32x2 w; w.x = pk4_fp8(v0[0], v0[1], v0[2], v0[3]); w.y = pk4_fp8(v1[0], v1[1], v1[2], v1[3]);
                    *(u32x2*)(rowp + bj * HALF) = w; } }
    }
};

typedef int v8i_t __attribute__((ext_vector_type(8)));
template <class Epi, bool GATHER, bool FP8>
__device__ __forceinline__ void gemm_phase(const int tid, LAS unsigned char* lds, LAS unsigned char* lds_ridx, const Gemm g, const TileOrder& S, const Epi& E) {
    const int wid = __builtin_amdgcn_readfirstlane(tid >> 6), lane = tid & 63, wr = wid >> 2, wc = wid & 3, fr = lane & 15, fq = lane >> 4;
    constexpr int ESZ = FP8 ? 1 : 2;
    const int K = g.K, nt = K * ESZ / (BK * 2);
    int RA[2], CA[2]; unsigned voffB[2];
#pragma unroll
    for (int i = 0; i < 2; ++i) { int Rr, C; stage_rc(tid * 16 + i * 8192, Rr, C); const int Rb = (Rr & ~31) + perm32(Rr & 31);
        RA[i] = Rr; CA[i] = C; voffB[i] = (unsigned)(Rb * K * ESZ + C * 2); }
    const size_t kstep = (size_t)(BK * 2);
    const size_t hstep = (size_t)HALF * K * ESZ;
    const size_t tstep = 2 * hstep;
    const unsigned ldsw = (unsigned)wid * 1024u;
    const int aoff = lds_byte(wr * 64 + fr, fq * 8), boff = lds_byte(wc * 32 + fr, fq * 8);
#define PG8_SA(b, h) (((b) * 2 + (h)) * HTB)
#define PG8_SB(b, h) ((4 + (b) * 2 + (h)) * HTB)
#define PG8_STAGE(bufoff, gbase, voff) do { _Pragma("unroll") for (int _i = 0; _i < 2; ++_i) \
        __builtin_amdgcn_global_load_lds((const unsigned*)((const char*)(gbase) + (voff)[_i]), (LAS unsigned*)(lds + (bufoff) + ldsw + _i * 8192), 16, 0, 0); } while (0)
#define PG8_STAGE_H1(bufoff, gbase) do { if constexpr (GATHER) PG8_STAGE(bufoff, gbase, v1); else PG8_STAGE(bufoff, (gbase) + hstep, v0); } while (0)
#define PG8_LD8(p0_, p1_) __builtin_bit_cast(v8i_t, __builtin_shufflevector(*(const LAS f32x4*)(p0_), *(const LAS f32x4*)(p1_), 0, 1, 2, 3, 4, 5, 6, 7))
#define PG8_LDA(dst, b, h) do { _Pragma("unroll") for (int m = 0; m < 4; ++m) { \
        if constexpr (FP8) dst##8[m] = PG8_LD8(lds + PG8_SA(b, h) + aoff + m * 2048, lds + PG8_SA(b, h) + aoff + 1024 + m * 2048); \
        else { _Pragma("unroll") for (int k = 0; k < 2; ++k) dst[m][k] = *(const LAS bf16x8*)(lds + PG8_SA(b, h) + aoff + k * 1024 + m * 2048); } } } while (0)
#define PG8_LDB(dst, b, h) do { _Pragma("unroll") for (int n = 0; n < 2; ++n) { \
        if constexpr (FP8) dst##8[n] = PG8_LD8(lds + PG8_SB(b, h) + boff + n * 2048, lds + PG8_SB(b, h) + boff + 1024 + n * 2048); \
        else { _Pragma("unroll") for (int k = 0; k < 2; ++k) dst[n][k] = *(const LAS bf16x8*)(lds + PG8_SB(b, h) + boff + k * 1024 + n * 2048); } } } while (0)
#define PG8_MMA(ai, bj, At, Bt) do { __builtin_amdgcn_s_setprio(1); _Pragma("unroll") for (int m = 0; m < 4; ++m) _Pragma("unroll") for (int n = 0; n < 2; ++n) { \
        if constexpr (FP8) acc[ai][bj][m][n] = __builtin_amdgcn_mfma_scale_f32_16x16x128_f8f6f4(Bt##8[n], At##8[m], acc[ai][bj][m][n], 0, 0, 0, mx_sw, 0, mx_sa); \
        else { _Pragma("unroll") for (int k = 0; k < 2; ++k) acc[ai][bj][m][n] = __builtin_amdgcn_mfma_f32_16x16x32_bf16(Bt[n][k], At[m][k], acc[ai][bj][m][n], 0, 0, 0); } } __builtin_amdgcn_s_setprio(0); } while (0)
#define PG8_WAIT_V(n) asm volatile("s_waitcnt vmcnt(" #n ")" ::: "memory")
#define PG8_WAIT_L(n) asm volatile("s_waitcnt lgkmcnt(" #n ")" ::: "memory")
#define PG8_BAR __builtin_amdgcn_s_barrier()
#define PG8_SCHED __builtin_amdgcn_sched_barrier(0)
#define PG8_PIN do { if constexpr (FP8) __builtin_amdgcn_sched_barrier(0); } while (0)
    int mx_sw = 0x79797979, mx_sa = 0x7F7F7F7F;
    if constexpr (FP8) asm volatile("" : "+v"(mx_sw), "+v"(mx_sa));
    Unit cur, nxt; int ui = 0;
    if (!S.next(0, cur)) return;
    f32x4 acc[2][2][4][2];
#pragma unroll
    for (int a = 0; a < 2; ++a)
#pragma unroll
        for (int b = 0; b < 2; ++b)
#pragma unroll
            for (int m = 0; m < 4; ++m)
#pragma unroll
                for (int n = 0; n < 2; ++n) acc[a][b][m][n] = (f32x4){0.f, 0.f, 0.f, 0.f};
    bf16x8 At[4][2], B0[2][2], B1[2][2]; v8i_t At8[4], B08[2], B18[2];
    unsigned v0[2], v1[2];
    const char* cA; const char* cB = (const char*)g.Bt + (size_t)cur.bn * tstep;
    if constexpr (GATHER) {
        cA = (const char*)g.A;
#pragma unroll
        for (int i = 0; i < 2; ++i) { const int r0 = g.ridx[cur.am * BM + RA[i]], r1 = g.ridx[cur.am * BM + HALF + RA[i]];
            v0[i] = (unsigned)(r0 * K * ESZ + CA[i] * 2); v1[i] = (unsigned)(r1 * K * ESZ + CA[i] * 2); }
    } else {
        cA = (const char*)g.A + (size_t)cur.am * tstep;
#pragma unroll
        for (int i = 0; i < 2; ++i) { v0[i] = (unsigned)(RA[i] * K * ESZ + CA[i] * 2); v1[i] = 0u; }
    }
    if constexpr (Epi::ROWVEC) { if (wid >= 4) __builtin_amdgcn_global_load_lds((const unsigned*)(E.gw + cur.am * BM + (tid - 256)), (LAS unsigned*)(lds + ROWVEC_OFF + (wid - 4) * 256), 4, 0, 0); }
    PG8_STAGE(PG8_SB(0, 0), cB, voffB); PG8_STAGE(PG8_SB(0, 1), cB + hstep, voffB); PG8_STAGE(PG8_SA(0, 0), cA, v0); PG8_STAGE_H1(PG8_SA(0, 1), cA);
    if (wr == 1) PG8_BAR;
    PG8_WAIT_V(2); PG8_BAR;
    PG8_STAGE(PG8_SB(1, 0), cB + kstep, voffB); PG8_STAGE(PG8_SA(1, 0), cA + kstep, v0); PG8_STAGE(PG8_SB(1, 1), cB + hstep + kstep, voffB);
    PG8_WAIT_V(6); PG8_BAR;
    for (;;) {
        const bool has_next = S.next(ui + 1, nxt);
        const char* nA; const char* nB = has_next ? (const char*)g.Bt + (size_t)nxt.bn * tstep : cB;
        if constexpr (GATHER) {
            nA = cA;
            if (has_next && wid < 4)
                __builtin_amdgcn_global_load_lds((const unsigned*)(g.ridx + nxt.am * BM + tid), (LAS unsigned*)(lds_ridx + ((ui + 1) & 1) * 1024 + wid * 256), 4, 0, 0);
            if constexpr (Epi::ROWVEC) { if (has_next && wid >= 4)
                __builtin_amdgcn_global_load_lds((const unsigned*)(E.gw + nxt.am * BM + (tid - 256)), (LAS unsigned*)(lds + ROWVEC_OFF + ((ui + 1) & 1) * 1024 + (wid - 4) * 256), 4, 0, 0); }
        } else {
            nA = has_next ? (const char*)g.A + (size_t)nxt.am * tstep : cA;
        }
#pragma unroll 1
        for (int t = 0; t < nt; t += 2) {
            const bool last = (t == nt - 2);
            const char* a1 = cA + (size_t)(t + 1) * kstep;
            const char* a2 = last ? nA : cA + (size_t)(t + 2) * kstep; const char* b2 = last ? nB : cB + (size_t)(t + 2) * kstep;
            const char* a3 = a2 + kstep; const char* b3 = b2 + kstep;
            PG8_LDB(B0, 0, 0); PG8_LDB(B1, 0, 1); PG8_SCHED; PG8_LDA(At, 0, 0); PG8_STAGE_H1(PG8_SA(1, 1), a1);
            if constexpr (GATHER) {
                if (last && has_next) {
                    const LAS int* rp = (const LAS int*)(lds_ridx + ((ui + 1) & 1) * 1024);
#pragma unroll
                    for (int i = 0; i < 2; ++i) { const int r0 = rp[RA[i]], r1 = rp[HALF + RA[i]];
                        v0[i] = (unsigned)(r0 * K * ESZ + CA[i] * 2); v1[i] = (unsigned)(r1 * K * ESZ + CA[i] * 2); }
                }
            }
            PG8_WAIT_V(8); PG8_WAIT_L(0); PG8_BAR; PG8_PIN; PG8_MMA(0, 0, At, B0); PG8_MMA(0, 1, At, B1); PG8_PIN; PG8_BAR; PG8_SCHED;
            PG8_LDA(At, 0, 1); PG8_STAGE(PG8_SB(0, 0), b2, voffB); PG8_STAGE(PG8_SB(0, 1), b2 + hstep, voffB); PG8_STAGE(PG8_SA(0, 0), a2, v0);
            PG8_WAIT_V(8); PG8_WAIT_L(0); PG8_BAR; PG8_PIN; PG8_MMA(1, 0, At, B0); PG8_MMA(1, 1, At, B1); PG8_PIN; PG8_BAR; PG8_SCHED;
            PG8_LDB(B0, 1, 0); PG8_LDB(B1, 1, 1); PG8_SCHED; PG8_LDA(At, 1, 0); PG8_STAGE_H1(PG8_SA(0, 1), a2);
            PG8_WAIT_V(8); PG8_WAIT_L(0); PG8_BAR; PG8_PIN; PG8_MMA(0, 0, At, B0); PG8_MMA(0, 1, At, B1); PG8_PIN; PG8_BAR; PG8_SCHED;
            PG8_LDA(At, 1, 1); PG8_STAGE(PG8_SB(1, 0), b3, voffB); PG8_STAGE(PG8_SB(1, 1), b3 + hstep, voffB); PG8_STAGE(PG8_SA(1, 0), a3, v0);
            PG8_WAIT_V(8); PG8_WAIT_L(0); PG8_BAR; PG8_PIN; PG8_MMA(1, 0, At, B0); PG8_MMA(1, 1, At, B1); PG8_PIN; PG8_BAR; PG8_SCHED;
        }
        if (wr == 0) PG8_BAR;
        E(acc, cur, wr, wc, fr, fq, ui);
        if (!has_next) break;
#pragma unroll
        for (int a = 0; a < 2; ++a)
#pragma unroll
            for (int b = 0; b < 2; ++b)
#pragma unroll
                for (int m = 0; m < 4; ++m)
#pragma unroll
                    for (int n = 0; n < 2; ++n) acc[a][b][m][n] = (f32x4){0.f, 0.f, 0.f, 0.f};
        cur = nxt; cA = nA; cB = nB; ++ui;
        if (wr == 1) PG8_BAR;
    }
    PG8_WAIT_V(0);
    PG8_BAR;
#undef PG8_SA
#undef PG8_SB
#undef PG8_STAGE
#undef PG8_LDA
#undef PG8_LDB
#undef PG8_MMA
#undef PG8_LD8
#undef PG8_STAGE_H1
#undef PG8_WAIT_V
#undef PG8_WAIT_L
#undef PG8_BAR
#undef PG8_SCHED
#undef PG8_PIN
}
static_assert(lds_byte(9, 16) + 16 == lds_byte(9, 24) && lds_byte(3, 48) + 16 == lds_byte(3, 56) && lds_byte(12, 0) + 16 == lds_byte(12, 8), "fp8 fragment halves are adjacent");
}

struct Args { const float* in[22]; float* out; unsigned char* ws; int ph_lo, ph_hi; };
struct Frame {
    LAS unsigned char* lds;
    int lane, wave, vcu, G, bx;
    __device__ __forceinline__ int tid_() const { return wave * 64 + lane; }
    unsigned char* ws;
};
__device__ __forceinline__ const float* inp(const Frame& F, int k) {
    const unsigned long long v = ((const LAS unsigned long long*)(F.lds + PTR_OFF))[k];
    const unsigned lo = __builtin_amdgcn_readfirstlane((unsigned)v), hi = __builtin_amdgcn_readfirstlane((unsigned)(v >> 32));
    return (const float*)(((unsigned long long)hi << 32) | lo);
}
#define F_x (inp(F, 0))
#define F_c (inp(F, 1))
#define F_ctx (inp(F, 2))
#define F_c_ctx (inp(F, 3))
#define F_w_mod (inp(F, 4))
#define F_b_mod (inp(F, 5))
#define F_w_in (inp(F, 6))
#define F_a_sink (inp(F, 7))
#define F_nat_bias (inp(F, 8))
#define F_conv_w (inp(F, 9))
#define F_conv_b (inp(F, 10))
#define F_conv_ln_g (inp(F, 11))
#define F_conv_ln_b (inp(F, 12))
#define F_w_out (inp(F, 13))
#define F_ln1_g (inp(F, 14))
#define F_ln1_b (inp(F, 15))
#define F_w_router (inp(F, 16))
#define F_w_gate (inp(F, 17))
#define F_w_up (inp(F, 18))
#define F_w_down (inp(F, 19))
#define F_ln2_g (inp(F, 20))
#define F_ln2_b (inp(F, 21))
#define F_out ((float*)inp(F, 22))
__device__ __forceinline__ const float* modp(const Frame& F, int l, int cond, int which) { return (const float*)(F.ws + WS_MOD) + ((size_t)(l * 5 + cond) * 6 + which) * D; }
__device__ __forceinline__ int row_cond(int m) { return m < RL ? (m >> 13) : 4; }

__device__ __forceinline__ void conv_item_load(const float* W, int N, int k0, int n0, int lane, f32x4 (&t)[8]) {
    const float* src = W + (size_t)(k0 + (lane >> 3)) * N + n0 + (lane & 7) * 4;
#pragma unroll
    for (int i = 0; i < 8; ++i) t[i] = __builtin_nontemporal_load((const GAS f32x4*)(src + (size_t)(8 * i) * N));
}
__device__ __forceinline__ void conv_item_to_lds(const f32x4 (&t)[8], LAS float* scr, int lane) {
#pragma unroll
    for (int i = 0; i < 8; ++i) { LAS float* d = scr + (8 * i + (lane >> 3)) * 33 + (lane & 7) * 4; d[0] = t[i][0]; d[1] = t[i][1]; d[2] = t[i][2]; d[3] = t[i][3]; }
    LDS_WAIT(); asm volatile("" ::: "memory");
}
__device__ __forceinline__ void conv_item_store_bf16(bf16_t* WT, int Kd, int trow, LAS float* scr, int k0, int lane) {
    const int c = lane & 7;
#pragma unroll
    for (int j = 0; j < 4; ++j) { const int n = (lane >> 3) + 8 * j; const LAS float* sp = scr + (8 * c) * 33 + n;
        u32x4 o; o.x = pk2(sp[0 * 33], sp[1 * 33]); o.y = pk2(sp[2 * 33], sp[3 * 33]); o.z = pk2(sp[4 * 33], sp[5 * 33]); o.w = pk2(sp[6 * 33], sp[7 * 33]);
        *(GAS u32x4*)(WT + (size_t)(trow + n) * Kd + k0 + 8 * c) = o; }
    LDS_WAIT(); asm volatile("" ::: "memory");
}
__device__ __forceinline__ void conv_item_store_fp8(unsigned char* WT, int Kd, int trow, LAS float* scr, int k0, int lane) {
    const int n = lane >> 1, kh = (lane & 1) * 32; const LAS float* sp = scr + kh * 33 + n;
    unsigned w[8];
#pragma unroll
    for (int q = 0; q < 8; ++q) w[q] = pk4_fp8(sp[(4 * q) * 33] * 64.0f, sp[(4 * q + 1) * 33] * 64.0f, sp[(4 * q + 2) * 33] * 64.0f, sp[(4 * q + 3) * 33] * 64.0f);
    unsigned char* dst = WT + (size_t)(trow + n) * Kd + k0 + kh;
    *(GAS u32x4*)dst = (u32x4){w[0], w[1], w[2], w[3]}; *(GAS u32x4*)(dst + 16) = (u32x4){w[4], w[5], w[6], w[7]};
    LDS_WAIT(); asm volatile("" ::: "memory");
}
constexpr int CONV_NITEMS = 16 * 64 + 16 * 32 + 3 * NE * 16 * 32, CONV_S1 = (CONV_NITEMS * 56) / 100, CONV_S2 = (CONV_NITEMS * 74) / 100;
__device__ __forceinline__ void conv_decode(const Frame& F, int l, int it, const float*& W, int& N, int& k0, int& n0, int& kind, unsigned char*& WT, int& Kd, int& trow) {
    constexpr int I_IN = 16 * 64, I_OUT = 16 * 32, I_E = 16 * 32;
    int r = it;
    if (r < I_IN) { const int kb = r / 64, nb = r % 64; n0 = 32 * nb; k0 = 64 * kb; trow = n0;
        if (n0 >= OFF_C) { const int c = n0 - OFF_C, gate = c >> 8, ch = c & 255; trow = OFF_C + (ch >> 7) * 256 + gate * 128 + (ch & 127); }
        W = F_w_in + (size_t)l * D * INW; N = INW; kind = 0; WT = F.ws + wsw(l, WS_WIN); Kd = D; return; }
    r -= I_IN;
    if (r < I_OUT) { const int kb = r / 32, nb = r % 32; n0 = 32 * nb; k0 = 64 * kb; trow = n0; W = F_w_out + (size_t)l * D * D; N = D; kind = 0; WT = F.ws + wsw(l, WS_WOUT); Kd = D; return; }
    r -= I_OUT;
    const int mat = r / (NE * I_E); r -= mat * (NE * I_E);
    const int e = r / I_E; r -= e * I_E;
    const int kb = r / 32, nb = r % 32; n0 = 32 * nb; k0 = 64 * kb;
    const size_t woff = ((size_t)l * NE + e) * (size_t)D * FF;
    kind = 1; N = (mat == 2) ? D : FF; Kd = (mat == 2) ? FF : D;
    W = (mat == 0 ? F_w_gate : mat == 1 ? F_w_up : F_w_down) + woff;
    WT = (mat == 2) ? F.ws + wsw(l, WS_WD) : F.ws + wsw(l, WS_WGU);
    trow = (mat == 0) ? e * 2048 + (n0 >> 7) * 256 + (n0 & 127) : (mat == 1) ? e * 2048 + (n0 >> 7) * 256 + 128 + (n0 & 127) : e * 1024 + n0;
}
constexpr int LATE_DN = 16 * 64 + 16 * 32 + 2 * NE * 16 * 32  , LATE_X0 = 14700, LATE_D0 = LATE_DN, LATE_D1 = LATE_DN + 3188, LATE_G0 = 3700, LATE_G1 = 10700;
__device__ __forceinline__ void convert_weights(Frame& F, int l, int it_lo, int it_hi, int worker, int nworkers) {
    LAS float* scr = (LAS float*)(F.lds + F.wave * 16384);
    const int gw = worker * NWAVES + F.wave, NGW = nworkers * NWAVES;
    f32x4 ta[8], tb[8];
#pragma unroll
    for (int i = 0; i < 8; ++i) { ta[i] = (f32x4){0.f, 0.f, 0.f, 0.f}; tb[i] = ta[i]; }
#pragma unroll 1
    for (int it = it_lo + gw - NGW; it < it_hi; it += NGW) {
        const float* W; int N, k0, n0, kind, Kd, trow; unsigned char* WT;
        if (it + NGW < it_hi) { conv_decode(F, l, it + NGW, W, N, k0, n0, kind, WT, Kd, trow); conv_item_load(W, N, k0, n0, F.lane, tb); }
        if (it >= it_lo) { conv_decode(F, l, it, W, N, k0, n0, kind, WT, Kd, trow);
            conv_item_to_lds(ta, scr, F.lane);
            if (kind == 0) conv_item_store_bf16((bf16_t*)WT, Kd, trow, scr, k0, F.lane); else conv_item_store_fp8(WT, Kd, trow, scr, k0, F.lane); }
        __builtin_amdgcn_sched_barrier(0);
#pragma unroll
        for (int i = 0; i < 8; ++i) ta[i] = tb[i];
        __builtin_amdgcn_sched_barrier(0);
    }
}

__device__ __forceinline__ void mod_items(Frame& F) {
    LAS float* sl = (LAS float*)F.lds;
    LAS float* part = sl + 5 * 1024;
    bool have = false;
    for (int it = F.vcu; it < 96; it += F.G) {
        if (!have) {
            for (int i = F.tid_(); i < 5 * 1024; i += NTHR) { const int cd = i >> 10, k = i & 1023; const float v = cd < 4 ? F_c[cd * D + k] : F_c_ctx[k];
                sl[i] = v / (1.0f + __builtin_amdgcn_exp2f(-v * LOG2E)); }
            have = true;
        }
        __syncthreads();
        const int l = it / 48, ch = it % 48, hl = F.lane >> 5, cl = F.lane & 31;
        const float* W = F_w_mod + (size_t)l * D * 6 * D + ch * 128 + 4 * cl;
        f32x4 a[5];
#pragma unroll
        for (int cd = 0; cd < 5; ++cd) a[cd] = (f32x4){0.f, 0.f, 0.f, 0.f};
        const int kbase = F.wave * 128 + hl;
#pragma unroll 16
        for (int kk = 0; kk < 64; ++kk) { const int k = kbase + 2 * kk; const f32x4 w = __builtin_nontemporal_load((const GAS f32x4*)(W + (size_t)k * 6 * D));
#pragma unroll
            for (int cd = 0; cd < 5; ++cd) a[cd] += w * sl[cd * 1024 + k]; }
#pragma unroll
        for (int cd = 0; cd < 5; ++cd) {
#pragma unroll
            for (int i = 0; i < 4; ++i) a[cd][i] = sum_halves(a[cd][i]);
            if (hl == 0) *(LAS f32x4*)(part + (F.wave * 5 + cd) * 128 + 4 * cl) = a[cd]; }
        __syncthreads();
        for (int i = F.tid_(); i < 5 * 128; i += NTHR) { const int cd = i >> 7, cc = i & 127; float s = F_b_mod[(size_t)l * 6 * D + ch * 128 + cc];
#pragma unroll
            for (int w = 0; w < 8; ++w) s += part[(w * 5 + cd) * 128 + cc];
            ((float*)(F.ws + WS_MOD))[(size_t)(l * 5 + cd) * 6 * D + ch * 128 + cc] = s; }
        __syncthreads();
    }
}
__device__ __forceinline__ void rope_table(Frame& F) {
    if (F.vcu != F.G - 1) return;
    float* rc = (float*)(F.ws + WS_ROPE); float* rs = rc + 128 * 16;
    for (int i = F.tid_(); i < 128 * 16; i += NTHR) { const int pos = i >> 4, f = i & 15;
        const float inv = exp2f(-(float)f * (13.287712379549449f / 16.0f)), ang = (float)pos * inv;
        const float kq = rintf(ang * 0.63661977236758134f); const int kqi = (int)kq;
        const float rr = (ang - kq * 1.5707855225e+00f) - kq * 1.0804334124e-05f, z = rr * rr;
        float s3_ = -1.9841270114e-04f, c2_ = -1.3888889225e-03f; asm volatile("" : "+v"(s3_), "+v"(c2_));
        const float sn = rr + rr * z * (-1.6666667163e-01f + z * (8.3333337680e-03f + z * (s3_ + z * 2.7557314297e-06f)));
        const float cn = 1.0f - 0.5f * z + z * z * (4.1666667908e-02f + z * (c2_ + z * 2.4801587642e-05f));
        rc[i] = (kqi & 1) ? ((kqi & 2) ? sn : -sn) : ((kqi & 2) ? -cn : cn);
        rs[i] = (kqi & 1) ? ((kqi & 2) ? -cn : cn) : ((kqi & 2) ? -sn : sn); }
}

struct RowVec { f32x4 v[4]; };
__device__ __forceinline__ void st_wt8(const void* p, u32x2 w) { asm volatile("global_store_dwordx2 %0, %1, off sc1" :: "v"(p), "v"(w) : "memory"); }
__device__ __forceinline__ void st_wt4(const void* p, unsigned w) { asm volatile("global_store_dword %0, %1, off sc1" :: "v"(p), "v"(w) : "memory"); }
__device__ __forceinline__ void st_wt8nt(const void* p, u32x2 w) { asm volatile("global_store_dwordx2 %0, %1, off sc1 nt" :: "v"(p), "v"(w) : "memory"); }
__device__ __forceinline__ void st_wt16(const void* p, f32x4 w) { asm volatile("global_store_dwordx4 %0, %1, off sc1" :: "v"(p), "v"(w) : "memory"); }
__device__ __forceinline__ void ld_vec(const float* p, int lane, RowVec& r) {
#pragma unroll
    for (int j = 0; j < 4; ++j) r.v[j] = *(const GAS f32x4*)(p + 4 * lane + 256 * j);
}
__device__ __forceinline__ void ld_row_f32(const float* p, int lane, f32x4 (&v)[4]) {
#pragma unroll
    for (int j = 0; j < 4; ++j) v[j] = __builtin_nontemporal_load((const GAS f32x4*)(p + 4 * lane + 256 * j));
}
__device__ __forceinline__ void st_row_f32(float* p, int lane, const f32x4 (&v)[4]) {
#pragma unroll
    for (int j = 0; j < 4; ++j) st_wt16(p + 4 * lane + 256 * j, v[j]);
}
__device__ __forceinline__ void ld_row_bf16raw(const bf16_t* p, int lane, u32x2 (&w)[4]) {
#pragma unroll
    for (int j = 0; j < 4; ++j) w[j] = __builtin_nontemporal_load((const GAS u32x2*)(p + 4 * lane + 256 * j));
}
typedef _Float16 h16x2 __attribute__((ext_vector_type(2)));
__device__ __forceinline__ void ld_row_f16raw(const _Float16* p, int lane, u32x2 (&w)[4]) {
#pragma unroll
    for (int j = 0; j < 4; ++j) w[j] = __builtin_nontemporal_load((const GAS u32x2*)(p + 4 * lane + 256 * j));
}
__device__ __forceinline__ f32x4 h4(u32x2 w) { const unsigned wx = w.x, wy = w.y;
    const h16x2 a = __builtin_bit_cast(h16x2, wx), b = __builtin_bit_cast(h16x2, wy); return (f32x4){(float)a[0], (float)a[1], (float)b[0], (float)b[1]}; }
__device__ __forceinline__ void st_row_f16(_Float16* p, int lane, const f32x4 (&v)[4]) {
#pragma unroll
    for (int j = 0; j < 4; ++j) { const h16x2 a = {(_Float16)v[j][0], (_Float16)v[j][1]}, b = {(_Float16)v[j][2], (_Float16)v[j][3]};
        u32x2 w; w.x = __builtin_bit_cast(unsigned, a); w.y = __builtin_bit_cast(unsigned, b); st_wt8nt(p + 4 * lane + 256 * j, w); }
}
__device__ __forceinline__ f32x4 fp8x4(unsigned w) { const f32x2 lo = __builtin_amdgcn_cvt_pk_f32_fp8((int)w, false), hi = __builtin_amdgcn_cvt_pk_f32_fp8((int)w, true); return (f32x4){lo[0], lo[1], hi[0], hi[1]}; }
__device__ __forceinline__ f32x4 bf4(u32x2 w) { return (f32x4){bflo(w.x), bfhi(w.x), bflo(w.y), bfhi(w.y)}; }
__device__ __forceinline__ void st_row_bf16(bf16_t* p, int lane, const f32x4 (&v)[4]) {
#pragma unroll
    for (int j = 0; j < 4; ++j) { u32x2 w; w.x = cvt_pk_bf16(v[j][0], v[j][1]); w.y = cvt_pk_bf16(v[j][2], v[j][3]); st_wt8(p + 4 * lane + 256 * j, w); }
}
__device__ __forceinline__ void ln_stats(const f32x4 (&v)[4], float& mean, float& rstd) {
    float s = 0.f, q = 0.f;
#pragma unroll
    for (int j = 0; j < 4; ++j) { s += (v[j][0] + v[j][1]) + (v[j][2] + v[j][3]); q += (v[j][0] * v[j][0] + v[j][1] * v[j][1]) + (v[j][2] * v[j][2] + v[j][3] * v[j][3]); }
    wave_sum2(s, q);
    mean = s * (1.0f / D);
    rstd = __builtin_amdgcn_rsqf(fmaxf(q * (1.0f / D) - mean * mean, 0.f) + LN_EPS);
}
__device__ __forceinline__ const float* xsrc_row(const Frame& F, int l, int m) {
    (void)l; return m < RL ? F_x + (size_t)m * D : F_ctx + (size_t)(m - RL) * D;
}

constexpr int CW_CIA = 8192;
__device__ __forceinline__ void row_segment(const Frame& F, int nc, int nrows, int seg, int& m0, int& m1) {
    if (nc == 0) { const int gw = F.vcu * NWAVES + F.wave, NGW = F.G * NWAVES, per = (nrows + NGW - 1) / NGW; m0 = seg == 0 ? nrows : gw * per; m1 = seg == 0 ? nrows : min(nrows, m0 + per); return; }
    const int wid = (F.vcu - nc) * NWAVES + F.wave, NW = (F.G - nc) * NWAVES;
    if (seg == 0) { m0 = RL + wid; m1 = (nrows > RL && m0 < R) ? m0 + 1 : m0; }
    else { const int per = (RL + NW - 1) / NW; m0 = wid * per; m1 = min(RL, m0 + per); }
}
__device__ __forceinline__ void cia_publish(const Frame& F, int nc, int which) {
    asm volatile("s_waitcnt vmcnt(0)" ::: "memory");
    __syncthreads();
    if (F.tid_() == 0) { const int w0 = (F.vcu - nc) * NWAVES, cnt = min(max(RC - w0, 0), NWAVES);
        if (cnt > 0) { __builtin_amdgcn_fence(__ATOMIC_RELEASE, "agent"); asm volatile("s_waitcnt vmcnt(0)" ::: "memory");
            __hip_atomic_fetch_add((unsigned*)(F.ws + WS_CTL) + CW_CIA + 64 * which, (unsigned)cnt, __ATOMIC_RELAXED, __HIP_MEMORY_SCOPE_AGENT); } }
}
__device__ __forceinline__ void cia_wait(const Frame& F, int which) {
    if (F.tid_() == 0) { unsigned* p = (unsigned*)(F.ws + WS_CTL) + CW_CIA + 64 * which; unsigned sp = 0;
        while (__hip_atomic_load(p, __ATOMIC_RELAXED, __HIP_MEMORY_SCOPE_AGENT) < (unsigned)RC) { __builtin_amdgcn_s_sleep(2); if (++sp > (1u << 24)) break; }
        __builtin_amdgcn_fence(__ATOMIC_ACQUIRE, "agent"); asm volatile("s_waitcnt vmcnt(0)" ::: "memory"); }
    __syncthreads();
}

__device__ __forceinline__ void phase_h0(Frame& F, bf16_t* H, int nc) {
    int cur = -1; RowVec sh, sc; f32x4 xa0[4], xa1[4], xb0[4], xb1[4];
#pragma unroll 1
    for (int seg = 0; seg < 2; ++seg) {
        int m0, m1; row_segment(F, nc, R, seg, m0, m1);
        constexpr int S = NWAVES;
        if (seg == 1) { const int tot = nc > 0 ? RL : R, NW = (F.G - nc) * NWAVES, per = (tot + NW - 1) / NW, b0 = (F.vcu - nc) * NWAVES * per; m0 = b0 + F.wave; m1 = min(tot, b0 + NWAVES * per); }
        if (m0 < m1) {
#pragma unroll
            for (int j = 0; j < 4; ++j) { xa0[j] = (f32x4){0.f, 0.f, 0.f, 0.f}; xa1[j] = xa0[j]; xb0[j] = xa0[j]; xb1[j] = xa0[j]; }
#pragma unroll 1
            for (int m = m0 - 2 * S; m < m1; m += 2 * S) {
                if (m >= m0) { const int cd = row_cond(m), cd1 = (m + S < m1) ? row_cond(m + S) : cd;
                    if (cd != cur) { cur = cd; ld_vec(modp(F, 0, cd, 0), F.lane, sh); ld_vec(modp(F, 0, cd, 1), F.lane, sc);
                        asm volatile("" :: "v"(sh.v[0]), "v"(sh.v[1]), "v"(sh.v[2]), "v"(sh.v[3]), "v"(sc.v[0]), "v"(sc.v[1]), "v"(sc.v[2]), "v"(sc.v[3])); }
                    (void)cd1; }
                if (m + 2 * S < m1) ld_row_f32(xsrc_row(F, 0, m + 2 * S), F.lane, xb0);
                if (m + 3 * S < m1) ld_row_f32(xsrc_row(F, 0, m + 3 * S), F.lane, xb1);
                if (m >= m0) {
                    { float mean, rstd; ln_stats(xa0, mean, rstd); f32x4 h[4];
#pragma unroll
                      for (int j = 0; j < 4; ++j) h[j] = ((xa0[j] - mean) * rstd) * (sc.v[j] + 1.0f) + sh.v[j];
                      st_row_bf16(H + (size_t)m * D, F.lane, h); }
                    if (m + S < m1) {
                        const int cd1 = row_cond(m + S);
                        if (cd1 != cur) { cur = cd1; ld_vec(modp(F, 0, cd1, 0), F.lane, sh); ld_vec(modp(F, 0, cd1, 1), F.lane, sc);
                            asm volatile("" :: "v"(sh.v[0]), "v"(sh.v[1]), "v"(sh.v[2]), "v"(sh.v[3]), "v"(sc.v[0]), "v"(sc.v[1]), "v"(sc.v[2]), "v"(sc.v[3])); }
                        float mean, rstd; ln_stats(xa1, mean, rstd); f32x4 h[4];
#pragma unroll
                        for (int j = 0; j < 4; ++j) h[j] = ((xa1[j] - mean) * rstd) * (sc.v[j] + 1.0f) + sh.v[j];
                        st_row_bf16(H + (size_t)(m + S) * D, F.lane, h); }
                }
                __builtin_amdgcn_sched_barrier(0);
#pragma unroll
                for (int j = 0; j < 4; ++j) { xa0[j] = xb0[j]; xa1[j] = xb1[j]; }
                __builtin_amdgcn_sched_barrier(0);
            }
        }
        if (seg == 0 && nc > 0) cia_publish(F, nc, 0);
    }
}

typedef float f32x4_t __attribute__((ext_vector_type(4)));
constexpr int RP1_LD = 1028;
template <bool L0>
__device__ __forceinline__ void phase_rowpass1(Frame& F, int l, const bf16_t* O, unsigned char* H2, int nrows) {
    LAS float* Wl = (LAS float*)F.lds;
    LAS float* Hs = Wl + 16 * RP1_LD;
    LAS float* Pt = Hs + 16 * RP1_LD;
    { const f32x4* wr4 = (const f32x4*)(F_w_router + (size_t)l * D * NE); f32x4 t[8];
#pragma unroll
      for (int k = 0; k < 8; ++k) t[k] = wr4[F.tid_() + k * NTHR];
#pragma unroll
      for (int k = 0; k < 8; ++k) { const int i = 4 * (F.tid_() + k * NTHR);
#pragma unroll
          for (int q = 0; q < 4; ++q) Wl[((i & 15) + q) * RP1_LD + (i >> 4)] = t[k][q]; } }
    __syncthreads();
    const int lane = F.lane, wv = F.wave;
    const int perwg = (nrows + F.G - 1) / F.G, r0 = F.vcu * perwg, r1 = min(nrows, r0 + perwg);
    const int niter = r0 < r1 ? 2 * ((r1 - r0 + 15) / 16) : 0;
    _Float16* XA = (_Float16*)(F.ws + WS_XA); int* inv = (int*)(F.ws + WS_INV);
    RowVec lg, lb, g1, sh2, sc2;
    ld_vec(F_ln1_g + (size_t)l * D, lane, lg); ld_vec(F_ln1_b + (size_t)l * D, lane, lb);
    int cur = -1;
    f32x4 xa[4], xb[4]; u32x2 ha[4], hb[4]; u32x2 oa[4], ob[4];
#define RP1_LOAD(X, H_, O_, m_) do { if ((m_) < r1) { if (L0) ld_row_f32(xsrc_row(F, 0, (m_)), lane, X); else ld_row_f16raw(XA + (size_t)(m_) * D, lane, H_); ld_row_bf16raw(O + (size_t)(m_) * D, lane, O_); } } while (0)
#pragma unroll 1
    for (int it = -1; it < niter; ++it) {
        const int m = r0 + 8 * it + wv;
        if (it >= 0 && m < r1) { const int cd = row_cond(m); if (cd != cur) { cur = cd; ld_vec(modp(F, l, cd, 2), lane, g1); ld_vec(modp(F, l, cd, 3), lane, sh2); ld_vec(modp(F, l, cd, 4), lane, sc2);
            asm volatile("" :: "v"(g1.v[0]), "v"(g1.v[1]), "v"(g1.v[2]), "v"(g1.v[3]), "v"(sh2.v[0]), "v"(sh2.v[1]), "v"(sh2.v[2]), "v"(sh2.v[3]), "v"(sc2.v[0]), "v"(sc2.v[1]), "v"(sc2.v[2]), "v"(sc2.v[3])); } }
        RP1_LOAD(xb, hb, ob, m + 8);
        LAS float* hrow = Hs + ((it & 1) * 8 + wv) * RP1_LD;
        if (it >= 0) {
        if (m < r1) {
            if (!L0) {
#pragma unroll
                for (int j = 0; j < 4; ++j) xa[j] = h4(ha[j]); }
            f32x4 v[4];
#pragma unroll
            for (int j = 0; j < 4; ++j) v[j] = xa[j] * ALPHA + g1.v[j] * bf4(oa[j]);
            float mean, rstd; ln_stats(v, mean, rstd);
#pragma unroll
            for (int j = 0; j < 4; ++j) v[j] = ((v[j] - mean) * rstd) * lg.v[j] + lb.v[j];
            st_row_f16(XA + (size_t)m * D, lane, v);
            ln_stats(v, mean, rstd);
#pragma unroll
            for (int j = 0; j < 4; ++j) { const f32x4 h = ((v[j] - mean) * rstd) * (sc2.v[j] + 1.0f) + sh2.v[j];
                st_wt4(H2 + (size_t)m * D + 4 * lane + 256 * j, pk4_fp8(h[0], h[1], h[2], h[3]));
                *(LAS f32x4*)(hrow + 4 * lane + 256 * j) = h; }
        } else {
#pragma unroll
            for (int j = 0; j < 4; ++j) *(LAS f32x4*)(hrow + 4 * lane + 256 * j) = (f32x4){0.f, 0.f, 0.f, 0.f};
        }
        if (it & 1) {
            __syncthreads();
            f32x4_t acc = {0.f, 0.f, 0.f, 0.f};
            { const LAS float* ap = Hs + (lane & 15) * RP1_LD + 128 * wv + 4 * (lane >> 4); const LAS float* bp = Wl + (lane & 15) * RP1_LD + 128 * wv + 4 * (lane >> 4);
#pragma unroll
              for (int ks = 0; ks < 8; ++ks) { const f32x4 a = *(const LAS f32x4*)(ap + 16 * ks), w = *(const LAS f32x4*)(bp + 16 * ks);
#pragma unroll
                  for (int i = 0; i < 4; ++i) acc = __builtin_amdgcn_mfma_f32_16x16x4f32(a[i], w[i], acc, 0, 0, 0); } }
#pragma unroll
            for (int r = 0; r < 4; ++r) Pt[(wv * 16 + 4 * (lane >> 4) + r) * 16 + (lane & 15)] = acc[r];
            __syncthreads();
            const int t = F.tid_();
            if (t < 256) { const int ri = t >> 4, e = t & 15; float lgt = 0.f;
#pragma unroll
                for (int w8 = 0; w8 < 8; ++w8) lgt += Pt[(w8 * 16 + ri) * 16 + e];
                const float mx = row16_max(lgt), ex = __builtin_amdgcn_exp2f((lgt - mx) * LOG2E), den = row16_sum(ex), aff = ex / den;
                const int mr = r0 + 8 * (it - 1) + (ri & 7) + 8 * (ri >> 3);
                if (mr < r1) {
                    if (mr < RL) ((float*)(F.ws + WS_AFF))[((size_t)((mr >> 13) * 16 + e)) * SEQ + (mr & (SEQ - 1))] = aff;
                    else { const int mc = mr - RL; ((float*)(F.ws + WS_AFFC))[((size_t)((mc >> 8) * 16 + e)) * NCTX + (mc & (NCTX - 1))] = aff; }
                    inv[(size_t)mr * 16 + e] = -1; } }
        }
        }
        __builtin_amdgcn_sched_barrier(0);
#pragma unroll
        for (int j = 0; j < 4; ++j) { if (L0) xa[j] = xb[j]; else ha[j] = hb[j]; oa[j] = ob[j]; }
        __builtin_amdgcn_sched_barrier(0);
    }
#undef RP1_LOAD
    __syncthreads();
}

template <int PER>
__device__ __forceinline__ void topk_item(Frame& F, const float* aff, int nact, int cap, int rowbase, int slotbase, int e) {
    LAS unsigned* hist = (LAS unsigned*)F.lds;
    LAS unsigned* wt = hist + 256;
    LAS unsigned* ctl = wt + 16;
    int* rowidx = (int*)(F.ws + WS_RIDX) + e * EROWS; float* gatew = (float*)(F.ws + WS_GATEW) + e * EROWS; int* inv = (int*)(F.ws + WS_INV);
    const int tid = F.tid_(), lane = F.lane, wave = F.wave;
    const bool act = tid * PER < nact;
    unsigned key[PER];
    if constexpr (PER == 16) {
#pragma unroll
        for (int q = 0; q < 4; ++q) { const u32x4 w = *(const u32x4*)(aff + tid * 16 + q * 4); key[q * 4 + 0] = w.x; key[q * 4 + 1] = w.y; key[q * 4 + 2] = w.z; key[q * 4 + 3] = w.w; }
    } else {
        key[0] = act ? __builtin_bit_cast(unsigned, aff[tid]) : 0u;
    }
    unsigned prefix = 0u, mask = 0u, remaining = (unsigned)cap;
    if (tid < 256) hist[tid] = 0u;
    __syncthreads();
#pragma unroll 1
    for (int pass = 0; pass < 4; ++pass) {
        const int shift = 24 - 8 * pass;
        LAS unsigned* cp = ctl + 2 * (pass & 1);
        if (act) {
#pragma unroll
            for (int i = 0; i < PER; ++i) if ((key[i] & mask) == prefix) __hip_atomic_fetch_add(&hist[(key[i] >> shift) & 255u], 1u, __ATOMIC_RELAXED, __HIP_MEMORY_SCOPE_WORKGROUP);
        }
        __syncthreads();
        unsigned hv = 0u, sfx = 0u;
        if (tid < 256) { hv = hist[tid]; hist[tid] = 0u; sfx = hv;
#pragma unroll
            for (int o = 1; o < 64; o <<= 1) { const unsigned t2 = lane_get(sfx, (lane + o) & 63); if (lane + o < 64) sfx += t2; }
            if (lane == 0) wt[wave] = sfx; }
        __syncthreads();
        if (tid < 256) { for (int w = wave + 1; w < 4; ++w) sfx += wt[w];
            if (sfx >= remaining && sfx - hv < remaining) { cp[0] = (unsigned)tid; cp[1] = remaining - (sfx - hv); } }
        __syncthreads();
        prefix |= cp[0] << shift; mask |= 255u << shift; remaining = cp[1];
    }
    const unsigned T = prefix, need_eq = remaining;
    unsigned cgt = 0u, ceq = 0u;
    if (act) {
#pragma unroll
        for (int i = 0; i < PER; ++i) { cgt += key[i] > T ? 1u : 0u; ceq += key[i] == T ? 1u : 0u; }
    }
    unsigned v = cgt | (ceq << 16), inc = v;
#pragma unroll
    for (int o = 1; o < 64; o <<= 1) { const unsigned t2 = lane_get(inc, (lane - o) & 63); if (lane >= o) inc += t2; }
    if (lane == 63) wt[wave] = inc;
    __syncthreads();
    unsigned base = 0u, total = 0u;
    for (int w = 0; w < 8; ++w) { const unsigned t2 = wt[w]; if (w < wave) base += t2; total += t2; }
    unsigned pgt = (base + inc - v) & 0xffffu, peq = (base + inc - v) >> 16;
    const unsigned total_gt = total & 0xffffu;
    if (act) {
#pragma unroll
        for (int i = 0; i < PER; ++i) {
            int slot = -1;
            if (key[i] > T) { slot = (int)pgt; ++pgt; }
            else if (key[i] == T) { if (peq < need_eq) slot = (int)(total_gt + peq); ++peq; }
            if (slot >= 0) { const int n = tid * PER + i; rowidx[slotbase + slot] = rowbase + n; gatew[slotbase + slot] = __builtin_bit_cast(float, key[i]); inv[(size_t)(rowbase + n) * 16 + e] = slotbase + slot; }
        }
    }
    __syncthreads();
}
__device__ __forceinline__ void phase_topk(Frame& F, bool with_ctx) {
    const int nitems = with_ctx ? 128 : 64;
    for (int it = F.vcu; it < nitems; it += F.G) {
        if (it < 64) { const int b = it >> 4, e = it & 15;
            topk_item<16>(F, (const float*)(F.ws + WS_AFF) + (size_t)(b * 16 + e) * SEQ, SEQ, CAP_L, b * SEQ, b * CAP_L, e);
        } else { const int b = (it - 64) >> 4, e = it & 15;
            topk_item<1>(F, (const float*)(F.ws + WS_AFFC) + (size_t)(b * 16 + e) * NCTX, NCTX, CAP_C, RL + b * NCTX, 4096 + b * CAP_C, e);
            if (b == 0 && F.tid_() < 128) { ((int*)(F.ws + WS_RIDX))[e * EROWS + 4224 + F.tid_()] = 0; ((float*)(F.ws + WS_GATEW))[e * EROWS + 4224 + F.tid_()] = 0.f; }
        }
    }
}

template <bool L0>
__device__ __forceinline__ void phase_rowpass2(Frame& F, int l, const unsigned char* slab, bf16_t* Hn, int nrows, int nc) {
    const int lane = F.lane;
    _Float16* XA = (_Float16*)(F.ws + WS_XA); const int* inv = (const int*)(F.ws + WS_INV);
    RowVec lg, lb, g2, sh, sc;
    ld_vec(F_ln2_g + (size_t)l * D, lane, lg); ld_vec(F_ln2_b + (size_t)l * D, lane, lb);
    int cur = -1;
#pragma unroll 1
    for (int seg = 0; seg < 2; ++seg) {
    int m0, m1; row_segment(F, nc, nrows, seg, m0, m1);
    if (m0 < m1) {
    u32x2 ha[4], hb[4]; int inva = -1, invb = -1, invc = -1;
    unsigned ya0[4], ya1[4], yb0[4], yb1[4];
#pragma unroll
    for (int j = 0; j < 4; ++j) { ha[j] = (u32x2){0u, 0u}; hb[j] = (u32x2){0u, 0u}; ya0[j] = 0u; ya1[j] = 0u; yb0[j] = 0u; yb1[j] = 0u; }
#pragma unroll 1
    for (int m = m0 - 2; m < m1; ++m) {
        if (m >= m0) { const int cd = row_cond(m);
            if (cd != cur) { cur = cd; ld_vec(modp(F, l, cd, 5), lane, g2);
                if (L0) { ld_vec(modp(F, 1, cd, 0), lane, sh); ld_vec(modp(F, 1, cd, 1), lane, sc);
                    asm volatile("" :: "v"(sh.v[0]), "v"(sh.v[1]), "v"(sh.v[2]), "v"(sh.v[3]), "v"(sc.v[0]), "v"(sc.v[1]), "v"(sc.v[2]), "v"(sc.v[3])); }
                asm volatile("" :: "v"(g2.v[0]), "v"(g2.v[1]), "v"(g2.v[2]), "v"(g2.v[3])); } }
        if (m + 2 < m1) invc = (lane < 16) ? inv[(size_t)(m + 2) * 16 + lane] : -1;
        if (m + 1 >= m0 && m + 1 < m1) {
            ld_row_f16raw(XA + (size_t)(m + 1) * D, lane, hb);
            unsigned long long mk = __ballot(invb >= 0);
            if (mk) { const int e0 = __builtin_ctzll(mk); mk &= mk - 1; const bool two = mk != 0ull; const int e1 = two ? __builtin_ctzll(mk) : e0;
                const int s0 = __builtin_amdgcn_readlane(invb, e0), s1 = __builtin_amdgcn_readlane(invb, e1);
                { const unsigned char* p0 = slab + ((size_t)e0 * EROWS + s0) * D + 4 * lane;
#pragma unroll
                  for (int j = 0; j < 4; ++j) yb0[j] = __builtin_nontemporal_load((const GAS unsigned*)(p0 + 256 * j)); }
                if (two) { const unsigned char* p1 = slab + ((size_t)e1 * EROWS + s1) * D + 4 * lane;
#pragma unroll
                  for (int j = 0; j < 4; ++j) yb1[j] = __builtin_nontemporal_load((const GAS unsigned*)(p1 + 256 * j)); } }
        }
        if (m >= m0) {
        f32x4 xa[4];
#pragma unroll
        for (int j = 0; j < 4; ++j) xa[j] = h4(ha[j]);
        f32x4 acc[4];
#pragma unroll
        for (int j = 0; j < 4; ++j) acc[j] = (f32x4){0.f, 0.f, 0.f, 0.f};
        unsigned long long msk = __ballot(inva >= 0);
        if (msk) { msk &= msk - 1; const bool two = msk != 0ull; if (two) msk &= msk - 1;
#pragma unroll
            for (int j = 0; j < 4; ++j) acc[j] += fp8x4(ya0[j]);
            if (two) {
#pragma unroll
                for (int j = 0; j < 4; ++j) acc[j] += fp8x4(ya1[j]); } }
#pragma unroll 1
        while (msk) {
            const int e0 = __builtin_ctzll(msk); msk &= msk - 1;
            const bool two = msk != 0ull; const int e1 = two ? __builtin_ctzll(msk) : e0; if (two) msk &= msk - 1;
            const int s0 = __builtin_amdgcn_readlane(inva, e0), s1 = __builtin_amdgcn_readlane(inva, e1);
            unsigned y0[4], y1[4];
            { const unsigned char* p0 = slab + ((size_t)e0 * EROWS + s0) * D + 4 * lane;
#pragma unroll
              for (int j = 0; j < 4; ++j) y0[j] = *(const GAS unsigned*)(p0 + 256 * j); }
            if (two) { const unsigned char* p1 = slab + ((size_t)e1 * EROWS + s1) * D + 4 * lane;
#pragma unroll
              for (int j = 0; j < 4; ++j) y1[j] = *(const GAS unsigned*)(p1 + 256 * j); }
#pragma unroll
            for (int j = 0; j < 4; ++j) acc[j] += fp8x4(y0[j]);
            if (two) {
#pragma unroll
                for (int j = 0; j < 4; ++j) acc[j] += fp8x4(y1[j]); }
        }
        f32x4 v[4];
#pragma unroll
        for (int j = 0; j < 4; ++j) v[j] = xa[j] * ALPHA + g2.v[j] * (acc[j] * 0.0625f);
        float mean, rstd; ln_stats(v, mean, rstd);
#pragma unroll
        for (int j = 0; j < 4; ++j) v[j] = ((v[j] - mean) * rstd) * lg.v[j] + lb.v[j];
        if (L0) st_row_f16(XA + (size_t)m * D, lane, v);
        else st_row_f32(F_out + (size_t)m * D, lane, v);
        if (L0) { ln_stats(v, mean, rstd); f32x4 h[4];
#pragma unroll
            for (int j = 0; j < 4; ++j) h[j] = ((v[j] - mean) * rstd) * (sc.v[j] + 1.0f) + sh.v[j];
            st_row_bf16(Hn + (size_t)m * D, lane, h); }
        }
        __builtin_amdgcn_sched_barrier(0);
#pragma unroll
        for (int j = 0; j < 4; ++j) { ha[j] = hb[j]; ya0[j] = yb0[j]; ya1[j] = yb1[j]; }
        inva = invb; invb = invc;
        __builtin_amdgcn_sched_barrier(0);
    }
    }
    if (seg == 0 && nc > 0) cia_publish(F, nc, 1);
    }
}

__device__ __forceinline__ void conv_unit_rows(int un, int& rowbase, int& t0, int& slen) {
    if (un < RL / 64) { const int b = un / (SEQ / 64); t0 = (un % (SEQ / 64)) * 64; rowbase = b * SEQ; slen = SEQ; }
    else { const int uc = un - RL / 64; const int b = uc / (NCTX / 64); t0 = (uc % (NCTX / 64)) * 64; rowbase = RL + b * NCTX; slen = NCTX; }
}
__device__ __forceinline__ void conv_fetch(const bf16_t* U, int un, int tid, u32x4 (&pf)[6]) {
    int rowbase, t0, slen; conv_unit_rows(un, rowbase, t0, slen);
#pragma unroll
    for (int q = 0; q < 6; ++q) { const int i = tid + q * NTHR, tt = i >> 5, c8 = (i & 31) * 8, t = t0 - 15 + tt;
        pf[q] = (u32x4){0u, 0u, 0u, 0u};
        if (tt < 94 && t >= 0 && t < slen) pf[q] = *(const GAS u32x4*)(U + (size_t)(rowbase + t) * INW + OFF_C + c8); }
}
typedef float cf32x2_t __attribute__((ext_vector_type(2)));
__device__ __forceinline__ void phase_conv(Frame& F, int l, const bf16_t* U, bf16_t* MIX, bool with_ctx) {
    LAS float* g = (LAS float*)F.lds;
    const int nunits = (RL / 64) + (with_ctx ? RC / 64 : 0);
    const int ch = F.tid_() & 255, half = F.tid_() >> 8;
    float w[31];
    { const float* cw = F_conv_w + (size_t)l * 31 * 256;
#pragma unroll
      for (int j = 0; j < 31; ++j) w[j] = cw[j * 256 + ch]; }
    const float cb = F_conv_b[l * 256 + ch];
    const f32x4 lng = *(const f32x4*)(F_conv_ln_g + l * 256 + 4 * F.lane), lnb = *(const f32x4*)(F_conv_ln_b + l * 256 + 4 * F.lane);
    u32x4 pf[6];
    const int cv0 = F.G - 1 - F.vcu;
    if (cv0 < nunits) conv_fetch(U, cv0, F.tid_(), pf);
#pragma unroll 1
    for (int un = cv0; un < nunits; un += F.G) {
        int rowbase, t0, slen; conv_unit_rows(un, rowbase, t0, slen);
        __syncthreads();
#pragma unroll
        for (int q = 0; q < 6; ++q) { const int i = F.tid_() + q * NTHR, tt = i >> 5, c8 = (i & 31) * 8;
            if (tt < 94) { *(LAS f32x4*)(g + tt * 256 + c8) = (f32x4){bflo(pf[q].x), bfhi(pf[q].x), bflo(pf[q].y), bfhi(pf[q].y)};
                           *(LAS f32x4*)(g + tt * 256 + c8 + 4) = (f32x4){bflo(pf[q].z), bfhi(pf[q].z), bflo(pf[q].w), bfhi(pf[q].w)}; } }
        if (un + F.G < nunits) conv_fetch(U, un + F.G, F.tid_(), pf);
        __syncthreads();
        float out[32];
        { const LAS float* gp = g + (32 * half) * 256 + ch;
          float in[62];
#pragma unroll
          for (int i = 0; i < 62; ++i) in[i] = gp[i * 256];
          cf32x2_t E[31], O[30];
#pragma unroll
          for (int k = 0; k < 31; ++k) E[k] = (cf32x2_t){in[2 * k], in[2 * k + 1]};
#pragma unroll
          for (int k = 0; k < 30; ++k) O[k] = (cf32x2_t){in[2 * k + 1], in[2 * k + 2]};
#pragma unroll
          for (int u = 0; u < 16; ++u) { cf32x2_t acc = {cb, cb};
#pragma unroll
              for (int j = 0; j < 31; ++j) { const cf32x2_t wv = {w[j], w[j]}; acc = __builtin_elementwise_fma(wv, (j & 1) ? O[u + (j >> 1)] : E[u + (j >> 1)], acc); }
              out[2 * u] = acc[0]; out[2 * u + 1] = acc[1]; } }
        __syncthreads();
#pragma unroll
        for (int t = 0; t < 32; ++t) g[(32 * half + t) * 256 + ch] = out[t];
        __syncthreads();
#pragma unroll 1
        for (int q = 0; q < 8; ++q) { const int tl = F.wave * 8 + q;
            const f32x4 v = *(const LAS f32x4*)(g + tl * 256 + 4 * F.lane);
            float s1 = (v[0] + v[1]) + (v[2] + v[3]), s2 = (v[0] * v[0] + v[1] * v[1]) + (v[2] * v[2] + v[3] * v[3]);
            wave_sum2(s1, s2);
            const float mean = s1 * (1.0f / 256.0f), rstd = __builtin_amdgcn_rsqf(fmaxf(s2 * (1.0f / 256.0f) - mean * mean, 0.f) + LN_EPS);
            f32x4 y = ((v - mean) * rstd) * lng + lnb;
#pragma unroll
            for (int i = 0; i < 4; ++i) y[i] = y[i] * __builtin_amdgcn_rcpf(1.0f + __builtin_amdgcn_exp2f(-y[i] * LOG2E));
            u32x2 o; o.x = cvt_pk_bf16(y[0], y[1]); o.y = cvt_pk_bf16(y[2], y[3]);
            *(GAS u32x2*)(MIX + (size_t)(rowbase + t0 + tl) * D + 768 + 4 * F.lane) = o; }
    }
    __syncthreads();
}

namespace att {
typedef float f32x16 __attribute__((ext_vector_type(16)));
typedef short s16x4 __attribute__((ext_vector_type(4)));
typedef short v4i16_t __attribute__((ext_vector_type(4)));
typedef float f32x2_t __attribute__((ext_vector_type(2)));
typedef __bf16 bf16x2_t __attribute__((ext_vector_type(2)));
constexpr int SLOTB = 16384, LDS_WS = 2 * SLOTB, LDS_OST = LDS_WS + 2048, LDS_BIAS = LDS_OST + 8 * 4096, LDS_ULIST = 137728, LDS_TOTAL = LDS_ULIST + 2048;
constexpr float THR = 8.0f;
__device__ __forceinline__ int crow(int r, int hi) { return (r & 3) + 8 * (r >> 2) + 4 * hi; }
__device__ __forceinline__ unsigned cvtpk_s(float lo, float hi) { f32x2_t v = {lo, hi}; bf16x2_t b = __builtin_convertvector(v, bf16x2_t); return __builtin_bit_cast(unsigned, b); }
__device__ __forceinline__ s16x4 vtr(const LAS unsigned char* p) { return __builtin_bit_cast(s16x4, __builtin_amdgcn_ds_read_tr16_b64_v4i16((LAS v4i16_t*)p)); }

struct AGeo { int qrow, qcol, kcol, vcol, ocol, nt, wrow0, jlo, R0, ctxrow0, alo, ahi, blk, hd, sinkh, ctxq; };
template <int TYPE>
__device__ __forceinline__ AGeo att_geo(int wid, int u) {
    AGeo g; int b, hd, blk; bool ctxq;
    if (TYPE == 0) { ctxq = u >= 1024; const int uc = u - 1024; b = ctxq ? uc >> 3 : u >> 8; hd = ctxq ? (uc >> 2) & 1 : (u >> 7) & 1; blk = ctxq ? uc & 3 : u & 127; }
    else { ctxq = u >= 512; const int uc = u - 512; b = ctxq ? uc >> 2 : u >> 7; hd = ctxq ? uc & 3 : (u >> 5) & 3; blk = ctxq ? 0 : u & 31; }
    if (TYPE == 0) { const int qh = hd * 4 + (wid >> 1); g.qcol = OFF_AQ + qh * 64; g.kcol = OFF_AK + hd * 64; g.vcol = OFF_AV + hd * 64; g.ocol = qh * 64; g.sinkh = qh;
        const int tok = 64 * blk + 32 * (wid & 1); g.qrow = ctxq ? RL + b * NCTX + tok : b * SEQ + tok; }
    else { g.qcol = OFF_BQ + hd * 64; g.kcol = OFF_BK + hd * 64; g.vcol = OFF_BV + hd * 64; g.ocol = 512 + hd * 64; g.sinkh = 0;
        const int tok = ctxq ? 32 * wid : (4 * blk + (wid >> 1)) * 64 + 32 * (wid & 1); g.qrow = ctxq ? RL + b * NCTX + tok : b * SEQ + tok; }
    int nwin = 0, wrow0 = 0, jlo = 0, R0 = 0;
    if (!ctxq) {
        if (TYPE == 0) { const int s0 = 64 * blk; jlo = s0 >= 128 ? 0 : (128 - s0) >> 6; const int jhi = min(4, (SEQ + 64 - s0) >> 6); nwin = jhi - jlo + 1; wrow0 = b * SEQ + s0 - 128 + 64 * jlo; }
        else { R0 = min(max(4 * blk - 4, 0), 120); const int R1 = min(max(4 * blk - 1, 0), 120) + 7; nwin = R1 - R0 + 1; wrow0 = b * SEQ + R0 * 64; }
    }
    g.nt = 4 + nwin; g.wrow0 = wrow0; g.jlo = jlo; g.R0 = R0; g.ctxrow0 = RL + b * NCTX; g.blk = blk; g.hd = hd; g.ctxq = ctxq ? 1 : 0;
    int alo = 4, ahi = g.nt;
    if (TYPE == 1 && !ctxq) { const int qg = 4 * blk + (wid >> 1), rs = min(max(qg - 4, 0), 120); alo = 4 + rs - R0; ahi = alo + 8; }
    g.alo = alo; g.ahi = ahi;
    return g;
}

constexpr int U2_SLOT = 8192, U2_K = 0, U2_V = 3 * U2_SLOT, U2_WS = 6 * U2_SLOT, U2_OST = U2_WS + 8 * 256, U2_BIAS = U2_OST + 8 * 4096, U2_END = U2_BIAS + 15 * 16 * 56 * 4, U2_ULIST = U2_END;
static_assert(U2_ULIST == LDS_ULIST && U2_ULIST + 2048 <= 143360, "attention LDS map");
typedef LAS const char* lds_cptr;
__device__ __forceinline__ void glds16(const void* g, unsigned lds_base) {
    unsigned sv; asm volatile("s_mov_b32 %0, m0\n\ts_mov_b32 m0, %2\n\ts_nop 0\n\tglobal_load_lds_dwordx4 %1, off\n\ts_mov_b32 m0, %0" : "=&s"(sv) : "v"(g), "s"(lds_base) : "memory"); }
__device__ __forceinline__ void glds16s(const void* sbase, unsigned voff, unsigned lds_base) {
    unsigned sv; asm volatile("s_mov_b32 %0, m0\n\ts_mov_b32 m0, %3\n\ts_nop 0\n\tglobal_load_lds_dwordx4 %1, %2\n\ts_mov_b32 m0, %0" : "=&s"(sv) : "v"(voff), "s"(sbase), "s"(lds_base) : "memory"); }
__device__ __forceinline__ void kload2(bf16x8* kf, lds_cptr kp, int d0) { kf[2 * d0] = *(const LAS bf16x8*)(kp + d0 * 2048); kf[2 * d0 + 1] = *(const LAS bf16x8*)(kp + d0 * 2048 + 512); }
__device__ __forceinline__ s16x4 vtr2(lds_cptr p) { return __builtin_bit_cast(s16x4, __builtin_amdgcn_ds_read_tr16_b64_v4i16((LAS v4i16_t*)p)); }
#define U2_MX3(a, b, c) __builtin_fmaxf(__builtin_fmaxf((a), (b)), (c))
__device__ __forceinline__ float lanemax32(const f32x16& p0, const f32x16& p1) {
    float a = U2_MX3(p0[0], p0[1], p1[0]), b = U2_MX3(p0[2], p0[3], p1[1]); a = U2_MX3(a, p1[2], p1[3]);
#pragma unroll
    for (int r = 4; r < 16; r += 4) { a = U2_MX3(a, p0[r], p0[r + 1]); b = U2_MX3(b, p0[r + 2], p0[r + 3]); a = U2_MX3(a, p1[r], p1[r + 1]); b = U2_MX3(b, p1[r + 2], p1[r + 3]); }
    return __builtin_fmaxf(a, b); }
#define U2_SBAR() __builtin_amdgcn_sched_barrier(0)
#define U2_PIN(x) asm volatile("" : "+v"(x))
#define U2_MFMA(a, b, c) __builtin_amdgcn_mfma_f32_32x32x16_bf16(a, b, c, 0, 0, 0)
#define U2_WAIT_BAR(N) asm volatile("s_waitcnt vmcnt(" #N ") lgkmcnt(0)\n\ts_barrier" ::: "memory")

template <int TYPE>
__device__ __forceinline__ void attn_stream2(const Frame& F, int l, const bf16_t* U, bf16_t* MIX, LAS unsigned char* shm, int nun, int uloff) {
    const int wid = F.wave;
    const LAS int* ul = (const LAS int*)(shm + LDS_ULIST + uloff) + 1;
    const char* Ub = (const char*)U;
    int v0 = 0, tblh = -1;
    bf16x8 qr[4];
    AGeo g = att_geo<TYPE>(wid, __builtin_amdgcn_readfirstlane(ul[0]));
#pragma unroll 1
    for (int ui = 0; ui < nun; ++ui) {
    const bool hasn = ui + 1 < nun;
    const bool pre = ui > 0;
    const AGeo gn = att_geo<TYPE>(wid, __builtin_amdgcn_readfirstlane(ul[ui + 1 < nun ? ui + 1 : ui]));
    unsigned z0_ = 0u; asm volatile("" : "+v"(z0_));
    const int lane = (int)__builtin_amdgcn_mbcnt_hi(~0u, __builtin_amdgcn_mbcnt_lo(~0u, z0_));
    const int r32 = lane & 31, hi = lane >> 5;
    if (TYPE == 1) {
        if (!g.ctxq && tblh != g.hd) { tblh = g.hd; const float* nb = F_nat_bias + (size_t)(l * 4 + g.hd) * 15 * 31; LAS float* bl = (LAS float*)(shm + U2_BIAS); LAS float* raw = (LAS float*)(shm + U2_OST);
            int tid_ = wid * 64 + lane; asm volatile("" : "+v"(tid_));
            for (int k = tid_; k < 15 * 31; k += NTHR) raw[k] = nb[k] * LOG2E;
            __syncthreads();
            for (int k = tid_; k < 15 * 16 * 56; k += NTHR) { const int dr = k / 896, rem = k - dr * 896, dl_ = rem / 56, w = rem - dl_ * 56 - 20;
                bl[k] = (w >= 0 && w < 16) ? raw[dr * 31 + (w - dl_ + 15)] : -1e30f; }
            __syncthreads(); } }
    const int nt = g.nt;
    float NEGBIG = -1e30f; asm volatile("" : "+v"(NEGBIG));
    const unsigned lds0 = (unsigned)(size_t)shm; LAS float* wsf = (LAS float*)(shm + U2_WS) + wid * 64;
    const unsigned koff = (unsigned)(lane * INW + g.kcol + wid * 8) * 2u;
    const unsigned voff = (unsigned)((16 * (wid & 3) + (lane >> 2)) * INW + g.vcol + (wid >> 2) * 32 + (lane & 3) * 8) * 2u;
    const unsigned kdst = lds0 + U2_K + wid * 1024, vdst = lds0 + U2_V + wid * 1024;
#define U2_TROW(ti_) ((ti_) < 4 ? g.ctxrow0 + 64 * (ti_) : g.wrow0 + 64 * ((ti_) - 4))
#define U2_DMA_K(t_, slot_) glds16s(Ub + (size_t)U2_TROW(t_) * (INW * 2), koff, (unsigned)__builtin_amdgcn_readfirstlane(kdst + (slot_)))
#define U2_DMA_V(t_, slot_) glds16s(Ub + (size_t)U2_TROW(t_) * (INW * 2), voff, (unsigned)__builtin_amdgcn_readfirstlane(vdst + (slot_)))
#define U2_DMA_KN(t_, slot_) glds16s(Ub + (size_t)(gn.ctxrow0 + 64 * (t_)) * (INW * 2), (unsigned)(lane * INW + gn.kcol + wid * 8) * 2u, (unsigned)__builtin_amdgcn_readfirstlane(kdst + (slot_)))
#define U2_DMA_VN(t_, slot_) glds16s(Ub + (size_t)(gn.ctxrow0 + 64 * (t_)) * (INW * 2), (unsigned)((16 * (wid & 3) + (lane >> 2)) * INW + gn.vcol + (wid >> 2) * 32 + (lane & 3) * 8) * 2u, (unsigned)__builtin_amdgcn_readfirstlane(vdst + (slot_)))
    int u2v_ = U2_V; asm volatile("" : "+s"(u2v_));
    const lds_cptr vp0 = (lds_cptr)shm + u2v_ + ((lane >> 4) & 1) * 32 + (lane & 3) * 8 + (4 * hi + ((lane & 15) >> 2)) * 64;
    const lds_cptr kp0 = (lds_cptr)shm + U2_K + hi * 1024 + r32 * 16;
    if (!pre) { U2_DMA_K(0, 0); U2_DMA_V(0, 0); U2_DMA_K(1, U2_SLOT);
      const char* qb_ = Ub + (size_t)g.qrow * (INW * 2) + (unsigned)(r32 * INW + g.qcol + hi * 8) * 2u;
#pragma unroll
      for (int d0 = 0; d0 < 4; ++d0) qr[d0] = *(const GAS bf16x8*)(qb_ + d0 * 32); }
    float sinkv = 0.f; if (TYPE == 0) sinkv = ((const __attribute__((address_space(4))) float*)F_a_sink)[l * 8 + g.sinkh] * LOG2E;
    float mrun = 0.f, lrun = 0.f; f32x16 o[2], negm;
    float zero_ = 0.f; asm volatile("" : "+v"(zero_));
#pragma unroll
    for (int r = 0; r < 16; ++r) { o[0][r] = zero_; o[1][r] = zero_; negm[r] = zero_; }
    U2_PIN(negm);
    bool resc = false;
    f32x16 pA0, pA1, pB0, pB1; bf16x8 kf[8]; s16x4 vlo[8], vhi[8]; u32x4 pw0, pw1, pw2, pw3;
    int sl_prev = 0, sl_cur = 0, sl_next = U2_SLOT;
    int vs_prev = v0, vs_cur = v0, vs_next = (v0 == 2 * U2_SLOT) ? 0 : v0 + U2_SLOT;
#define U2_ROT() do { sl_prev = sl_cur; sl_cur = sl_next; sl_next = (sl_next == 2 * U2_SLOT) ? 0 : sl_next + U2_SLOT; vs_prev = vs_cur; vs_cur = vs_next; vs_next = (vs_next == 2 * U2_SLOT) ? 0 : vs_next + U2_SLOT; } while (0)
#define U2_EX(v) __builtin_amdgcn_exp2f(v)
#define U2_RESC() do { if (resc) { int lr_ = lane; asm volatile("" : "+v"(lr_)); const int hr_ = lr_ >> 5; _Pragma("unroll") for (int d_ = 0; d_ < 2; ++d_) _Pragma("unroll") for (int r = 0; r < 16; ++r) o[d_][r] *= wsf[crow(r, hr_)]; } } while (0)
#define U2_MASK(C0, C1, t_) do { if ((t_) >= 4) { \
        if (TYPE == 0) { const int j_ = g.jlo + ((t_) - 4); if (j_ == 0 || j_ == 4) { int lm_ = lane; asm volatile("" : "+v"(lm_)); const int dbase = 64 * j_ - 128 - 32 * (wid & 1) - (lm_ & 31) + 4 * (lm_ >> 5);     \
            _Pragma("unroll") for (int r = 0; r < 16; ++r) { const int d0_ = dbase + (r & 3) + 8 * (r >> 2); if (abs(d0_) > 128) C0[r] = NEGBIG; if (abs(d0_ + 32) > 128) C1[r] = NEGBIG; } } } \
        else { const int aux = ((t_) >= g.alo && (t_) < g.ahi) ? (g.R0 + ((t_) - 4)) - (4 * g.blk + (wid >> 1)) + 7 : -1, auxc = min(max(aux, 0), 14);        \
            const int qc = 32 * (wid & 1) + r32, cs = min(max(qc - 8, 0), 48); \
            const LAS float* tb = (const LAS float*)(shm + U2_BIAS) + auxc * 896 + (qc - cs) * 56 + 4; const int off = (aux == auxc) ? 16 - cs + 4 * hi : -64;     \
              \
              \
            f32x4 ta_, tb_; \
            U2_TLD(ta_, 0, 0); U2_SBAR(); U2_TLD(tb_, 1, 0); U2_TADD(C0, 0, ta_); U2_SBAR(); U2_TLD(ta_, 2, 0); U2_TADD(C0, 1, tb_); U2_SBAR(); U2_TLD(tb_, 3, 0); U2_TADD(C0, 2, ta_); U2_SBAR(); \
            U2_TLD(ta_, 0, 32); U2_TADD(C0, 3, tb_); U2_SBAR(); U2_TLD(tb_, 1, 32); U2_TADD(C1, 0, ta_); U2_SBAR(); U2_TLD(ta_, 2, 32); U2_TADD(C1, 1, tb_); U2_SBAR(); U2_TLD(tb_, 3, 32); U2_TADD(C1, 2, ta_); U2_SBAR(); \
            U2_TADD(C1, 3, tb_); } } } while (0)
#define U2_TLD(T_, j, kadd) do { const LAS float* p_ = tb + min(max(off + 8 * (j) + (kadd), -4), 48); T_ = (f32x4){p_[0], p_[1], p_[2], p_[3]}; } while (0)
#define U2_TADD(P, j, T_) do { P[4 * (j)] += T_[0]; P[4 * (j) + 1] += T_[1]; P[4 * (j) + 2] += T_[2]; P[4 * (j) + 3] += T_[3]; } while (0)
    if (!pre) { U2_DMA_K(2, 2 * U2_SLOT); U2_WAIT_BAR(3); }
    else { U2_WAIT_BAR(0); }
#pragma unroll
    for (int d0 = 0; d0 < 4; ++d0) kload2(kf, kp0, d0);
    pA0 = U2_MFMA(kf[0], qr[0], negm); pA1 = U2_MFMA(kf[1], qr[0], negm); pA0 = U2_MFMA(kf[2], qr[1], pA0); pA1 = U2_MFMA(kf[3], qr[1], pA1);
    pA0 = U2_MFMA(kf[4], qr[2], pA0); pA1 = U2_MFMA(kf[5], qr[2], pA1); pA0 = U2_MFMA(kf[6], qr[3], pA0); pA1 = U2_MFMA(kf[7], qr[3], pA1);
    { const float rm = max_halves(lanemax32(pA0, pA1)); mrun = rm;
#pragma unroll
      for (int r = 0; r < 16; ++r) { pA0[r] = U2_EX(pA0[r] - rm); pA1[r] = U2_EX(pA1[r] - rm); negm[r] = -rm; } }
    U2_WAIT_BAR(0);
    U2_DMA_K(3, 0); U2_DMA_V(1, vs_next); U2_ROT();
#pragma unroll
    for (int d0 = 0; d0 < 4; ++d0) kload2(kf, kp0 + sl_cur, d0);
    U2_WAIT_BAR(2);
#define U2_PKW(P, i) cvtpk_s(P[i], P[i + 1])
#define U2_PAF(k) __builtin_bit_cast(bf16x8, pw##k)
#define U2_VFR(i) (bf16x8){vlo[i][0], vlo[i][1], vlo[i][2], vlo[i][3], vhi[i][0], vhi[i][1], vhi[i][2], vhi[i][3]}
#define U2_VRD(i) do { vlo[i] = vtr2(vp_ + (((i) >> 2) * 4096 + ((i) & 3) * 1024)); vhi[i] = vtr2(vp_ + (((i) >> 2) * 4096 + ((i) & 3) * 1024 + 512)); } while (0)
#define U2_KRD(G, d0) do { if (G) { kload2(kf, kp0 + sl_next, d0); U2_SBAR(); } } while (0)
#define U2_GAPA(MF, a0, a1, a2, a3, W0, W1, PW) do { MF; sacc += a0; sacc += a1; sacc += a2; sacc += a3; W0; W1; U2_PIN(PW); U2_PIN(sacc); U2_SBAR(); } while (0)
#define U2_GAPB(MF, X, i) do { MF; X[i] = U2_EX(X[i]); X[i + 1] = U2_EX(X[i + 1]); X[i + 2] = U2_EX(X[i + 2]); X[i + 3] = U2_EX(X[i + 3]); U2_PIN(X); U2_SBAR(); } while (0)
#define U2_STEP(C0, C1, P0, P1, t, GK, GV, GL, PF) do { U2_SBAR(); \
    const lds_cptr vp_ = vp0 + vs_prev; \
    U2_VRD(0); U2_SBAR(); float sacc = P0[0] + P0[1]; \
                       U2_GAPA(C0 = U2_MFMA(kf[0], qr[0], negm), P0[2], P0[3], P0[4], P0[5],     pw0[0] = U2_PKW(P0, 0),  pw0[1] = U2_PKW(P0, 2),  pw0); \
    U2_VRD(4); U2_SBAR(); U2_GAPA(C1 = U2_MFMA(kf[1], qr[0], negm), P0[6], P0[7], P0[8], P0[9],     pw0[2] = U2_PKW(P0, 4),  pw0[3] = U2_PKW(P0, 6),  pw0); \
    U2_VRD(1); U2_SBAR(); U2_GAPA(C0 = U2_MFMA(kf[2], qr[1], C0),   P0[10], P0[11], P0[12], P0[13], pw1[0] = U2_PKW(P0, 8),  pw1[1] = U2_PKW(P0, 10), pw1); \
    U2_VRD(5); U2_SBAR(); U2_GAPA(C1 = U2_MFMA(kf[3], qr[1], C1),   P0[14], P0[15], P1[0], P1[1],   pw1[2] = U2_PKW(P0, 12), pw1[3] = U2_PKW(P0, 14), pw1); \
    U2_VRD(2); U2_SBAR(); U2_GAPA(C0 = U2_MFMA(kf[4], qr[2], C0),   P1[2], P1[3], P1[4], P1[5],     pw2[0] = U2_PKW(P1, 0),  pw2[1] = U2_PKW(P1, 2),  pw2); \
    U2_VRD(6); U2_SBAR(); U2_GAPA(C1 = U2_MFMA(kf[5], qr[2], C1),   P1[6], P1[7], P1[8], P1[9],     pw2[2] = U2_PKW(P1, 4),  pw2[3] = U2_PKW(P1, 6),  pw2); \
    U2_VRD(3); U2_SBAR(); U2_GAPA(C0 = U2_MFMA(kf[6], qr[3], C0),   P1[10], P1[11], P1[12], P1[13], pw3[0] = U2_PKW(P1, 8),  pw3[1] = U2_PKW(P1, 10), pw3); \
    U2_VRD(7); U2_SBAR(); U2_GAPA(C1 = U2_MFMA(kf[7], qr[3], C1),   P1[14], P1[15], 0.f, 0.f,       pw3[2] = U2_PKW(P1, 12), pw3[3] = U2_PKW(P1, 14), pw3); \
    lrun += sacc; \
    if (GK) U2_DMA_K((t) + 3, sl_cur); if (GV) U2_DMA_V((t) + 1, vs_next);                      \
    if (PF) { U2_DMA_KN(0, 0); U2_DMA_VN(0, vs_next); U2_DMA_KN(1, U2_SLOT); U2_DMA_KN(2, 2 * U2_SLOT); }     \
    U2_MASK(C0, C1, (t)); \
    { const float rml = lanemax32(C0, C1); resc = false;                                         \
      if (__builtin_expect(__any(rml > THR), 0)) { const float dl = fmaxf(max_halves(rml), 0.f); mrun += dl; \
          _Pragma("unroll") for (int r = 0; r < 16; ++r) { C0[r] -= dl; C1[r] -= dl; negm[r] = -mrun; } \
          const float f = __builtin_amdgcn_exp2f(-dl); lrun *= f; { int lr_ = lane; asm volatile("" : "+v"(lr_)); if ((lr_ >> 5) == 0) wsf[lr_ & 31] = f; } resc = true; } } \
    U2_SBAR(); \
    U2_GAPB(o[0] = U2_MFMA(U2_PAF(0), U2_VFR(0), o[0]), C0, 0);              U2_GAPB(o[1] = U2_MFMA(U2_PAF(0), U2_VFR(4), o[1]), C0, 4); \
    U2_KRD(GL, 0); U2_GAPB(o[0] = U2_MFMA(U2_PAF(1), U2_VFR(1), o[0]), C0, 8);  U2_KRD(GL, 1); U2_GAPB(o[1] = U2_MFMA(U2_PAF(1), U2_VFR(5), o[1]), C0, 12); \
    U2_KRD(GL, 2); U2_GAPB(o[0] = U2_MFMA(U2_PAF(2), U2_VFR(2), o[0]), C1, 0);  U2_KRD(GL, 3); U2_GAPB(o[1] = U2_MFMA(U2_PAF(2), U2_VFR(6), o[1]), C1, 4); \
    U2_GAPB(o[0] = U2_MFMA(U2_PAF(3), U2_VFR(3), o[0]), C1, 8);              U2_GAPB(o[1] = U2_MFMA(U2_PAF(3), U2_VFR(7), o[1]), C1, 12); \
    } while (0)
#define U2_ENDW(tt) do { if ((tt) + 3 < nt) { U2_WAIT_BAR(2); } else if ((tt) + 2 < nt) { U2_WAIT_BAR(1); } else { U2_WAIT_BAR(0); } } while (0)
#define U2_DRAIN(P0, P1) do { float sacc = P0[0] + P0[1]; \
      _Pragma("unroll") for (int r = 2; r < 16; ++r) sacc += P0[r]; \
      _Pragma("unroll") for (int r = 0; r < 16; ++r) sacc += P1[r]; \
      lrun += sacc; \
      pw0 = (u32x4){U2_PKW(P0, 0), U2_PKW(P0, 2), U2_PKW(P0, 4), U2_PKW(P0, 6)}; pw1 = (u32x4){U2_PKW(P0, 8), U2_PKW(P0, 10), U2_PKW(P0, 12), U2_PKW(P0, 14)}; \
      pw2 = (u32x4){U2_PKW(P1, 0), U2_PKW(P1, 2), U2_PKW(P1, 4), U2_PKW(P1, 6)}; pw3 = (u32x4){U2_PKW(P1, 8), U2_PKW(P1, 10), U2_PKW(P1, 12), U2_PKW(P1, 14)}; \
      const lds_cptr vp_ = vp0 + vs_cur; _Pragma("unroll") for (int i = 0; i < 8; ++i) U2_VRD(i); \
      o[0] = U2_MFMA(U2_PAF(0), U2_VFR(0), o[0]); o[1] = U2_MFMA(U2_PAF(0), U2_VFR(4), o[1]); o[0] = U2_MFMA(U2_PAF(1), U2_VFR(1), o[0]); o[1] = U2_MFMA(U2_PAF(1), U2_VFR(5), o[1]); \
      o[0] = U2_MFMA(U2_PAF(2), U2_VFR(2), o[0]); o[1] = U2_MFMA(U2_PAF(2), U2_VFR(6), o[1]); o[0] = U2_MFMA(U2_PAF(3), U2_VFR(3), o[0]); o[1] = U2_MFMA(U2_PAF(3), U2_VFR(7), o[1]); } while (0)
    int t = 1;
#pragma unroll 1
    for (; t + 5 < nt; t += 2) {
        U2_STEP(pB0, pB1, pA0, pA1, t, true, true, true, false);     U2_WAIT_BAR(2); U2_RESC(); U2_ROT();
        U2_STEP(pA0, pA1, pB0, pB1, t + 1, true, true, true, false); U2_WAIT_BAR(2); U2_RESC(); U2_ROT();
    }
#pragma unroll 1
    for (; t + 1 < nt; t += 2) {
        U2_STEP(pB0, pB1, pA0, pA1, t, (t + 3 < nt), (t + 1 < nt), (t + 1 < nt), false);         U2_ENDW(t); U2_RESC(); U2_ROT();
        U2_STEP(pA0, pA1, pB0, pB1, t + 1, (t + 4 < nt), (t + 2 < nt), (t + 2 < nt), (hasn && t + 2 == nt));     if (t + 2 < nt) { U2_ENDW(t + 1); } U2_RESC(); if (t + 2 < nt) U2_ROT();
    }
    const int v0n = vs_next;
    const bool oddfinal = t < nt;
    if (oddfinal) { U2_STEP(pB0, pB1, pA0, pA1, t, false, false, false, hasn); U2_RESC(); }
    if (hasn) { const char* qb_ = Ub + (size_t)gn.qrow * (INW * 2) + (unsigned)(r32 * INW + gn.qcol + hi * 8) * 2u;
#pragma unroll
        for (int d0 = 0; d0 < 4; ++d0) qr[d0] = *(const GAS bf16x8*)(qb_ + d0 * 32); }
    if (oddfinal) { U2_DRAIN(pB0, pB1); } else { U2_DRAIN(pA0, pA1); }
    lrun = sum_halves(lrun);
    if (TYPE == 0) lrun += __builtin_amdgcn_exp2f(sinkv - mrun);
    if (hi == 0) wsf[32 + r32] = 1.0f / lrun;
    LAS bf16_t* stg3 = (LAS bf16_t*)(shm + U2_OST) + wid * 2048;
    f32x4 rl4[4];
#pragma unroll
    for (int j = 0; j < 4; ++j) rl4[j] = *(const LAS f32x4*)(wsf + 32 + 8 * j + 4 * hi);
#pragma unroll
    for (int r = 0; r < 16; ++r) { const int orow = crow(r, hi); const float rl_ = rl4[r >> 2][r & 3];
        stg3[orow * 64 + r32] = (bf16_t)cvtpk_s(o[0][r] * rl_, 0.f); stg3[orow * 64 + 32 + r32] = (bf16_t)cvtpk_s(o[1][r] * rl_, 0.f); }
    asm volatile("s_waitcnt lgkmcnt(0)" ::: "memory");
    { char* ob_ = (char*)MIX + (size_t)g.qrow * (D * 2) + g.ocol * 2;
#pragma unroll
      for (int i = 0; i < 4; ++i) { const int row = i * 8 + (lane >> 3), ch = lane & 7; const u32x4 v = *(const LAS u32x4*)(stg3 + row * 64 + ch * 8); *(u32x4*)(ob_ + (unsigned)(row * D + ch * 8) * 2u) = v; } }
    asm volatile("s_waitcnt lgkmcnt(0)\n\ts_barrier" ::: "memory");
    g = gn; v0 = v0n;
    }
#undef U2_TROW
#undef U2_DMA_K
#undef U2_DMA_V
#undef U2_DMA_KN
#undef U2_DMA_VN
#undef U2_ROT
#undef U2_EX
#undef U2_RESC
#undef U2_MASK
#undef U2_TLD
#undef U2_TADD
#undef U2_PKW
#undef U2_PAF
#undef U2_VFR
#undef U2_VRD
#undef U2_KRD
#undef U2_GAPA
#undef U2_GAPB
#undef U2_STEP
#undef U2_ENDW
#undef U2_DRAIN
}
}

__device__ __forceinline__ void phase_attn(Frame& F, int l, const bf16_t* U, bf16_t* MIX, bool with_ctx) {
    LAS unsigned char* shm = F.lds;
    const int nA = 1024 + (with_ctx ? 32 : 0), nB = 512 + (with_ctx ? 16 : 0);
#ifndef DBG_MIX
#define DBG_MIX 0
#endif
    LAS int* ul = (LAS int*)(shm + att::LDS_ULIST);
    LAS int* ulb = (LAS int*)(shm + att::LDS_ULIST + 1024);
    if (F.tid_() == 0) { int n = 0;
#pragma unroll 1
        for (int j = 0; j < ((DBG_MIX & 1) ? 10 : 5); ++j) { const int jj = j % 5;
#pragma unroll 1
            for (int ua = (jj < 4 ? F.vcu * 4 + jj : 1024 + F.vcu); ua < (jj < 4 ? min(1024, nA) : nA); ua += (jj < 4 ? F.G * 4 : F.G)) ul[1 + n++] = ua; }
        ul[0] = n; n = 0;
#pragma unroll 1
        for (int j = 0; j < ((DBG_MIX & 2) ? 6 : 3); ++j) { const int jj = j % 3;
#pragma unroll 1
            for (int ub = (jj < 2 ? F.vcu * 2 + jj : 512 + ((F.vcu + F.G - 32) % F.G)); ub < (jj < 2 ? min(512, nB) : nB); ub += (jj < 2 ? F.G * 2 : F.G)) ulb[1 + n++] = ub; }
        ulb[0] = n; }
    __syncthreads();
    { const int n = __builtin_amdgcn_readfirstlane(ul[0]); if (n > 0) att::attn_stream2<0>(F, l, U, MIX, shm, n, 0); }
    __syncthreads();
    { const int n = __builtin_amdgcn_readfirstlane(ulb[0]); if (n > 0) att::attn_stream2<1>(F, l, U, MIX, shm, n, 1024); }
    { unsigned z_ = 0u; asm volatile("" : "+v"(z_)); F.lane = (int)__builtin_amdgcn_mbcnt_hi(~0u, __builtin_amdgcn_mbcnt_lo(~0u, z_)); }
    __syncthreads();
}


constexpr int NPHASE = 18;
__global__ void __launch_bounds__(NTHR, 2) hybrid_fwd(Args args) {
    extern __shared__ __attribute__((aligned(16))) unsigned char lds_raw[];
    Frame F;
    F.lds = (LAS unsigned char*)lds_raw;
    F.lane = threadIdx.x & 63; F.wave = __builtin_amdgcn_readfirstlane(threadIdx.x >> 6);
    F.G = gridDim.x; { const int bx = blockIdx.x; F.vcu = (F.G % 8 == 0) ? (bx % 8) * (F.G / 8) + bx / 8 : bx; }
    F.ws = args.ws;
    for (int u = F.tid_(); u < (LDS_BYTES - LDSCTL_OFF) / 4; u += NTHR) ((LAS unsigned*)(F.lds + LDSCTL_OFF))[u] = 0u;
    __syncthreads();
    if (F.tid_() < 24) ((LAS unsigned long long*)(F.lds + PTR_OFF))[F.tid_()] = ((const unsigned long long*)&args)[F.tid_()];
    __syncthreads();
    volatile LAS unsigned* MISC = (volatile LAS unsigned*)(F.lds + MISC_OFF);
    XcdBarrier bar; bar.bar = (unsigned*)(F.ws + WS_CTL) + CW_BAR; bar.x = 0; bar.st = nullptr;
    if (!MK_PER_PHASE) bar = xcd_barrier_post((unsigned*)(F.ws + WS_CTL) + CW_BAR, MISC + 8);
    const int lo = args.ph_lo, hi = args.ph_hi;
    const int wave0 = F.wave; LAS unsigned char* const lds_base = F.lds;
    bool repeated = false;
#pragma unroll 1
    for (int ph = lo; ph < hi; ++ph) {
        { unsigned char* w = (unsigned char*)inp(F, 23); asm volatile("" : "+s"(w)); F.ws = w;
          unsigned z_ = 0u; asm volatile("" : "+v"(z_));
          int w_ = wave0, l_ = (int)__builtin_amdgcn_mbcnt_hi(~0u, __builtin_amdgcn_mbcnt_lo(~0u, z_)); asm volatile("" : "+s"(w_), "+v"(l_)); F.wave = w_; F.lane = l_;
          unsigned lb_ = (unsigned)(uintptr_t)lds_base; asm volatile("" : "+s"(lb_)); F.lds = (LAS unsigned char*)(uintptr_t)lb_;
          int bx_ = blockIdx.x, g_ = gridDim.x; asm volatile("" : "+s"(bx_), "+s"(g_)); F.G = g_; F.bx = bx_; F.vcu = (g_ % 8 == 0) ? (bx_ % 8) * (g_ / 8) + bx_ / 8 : bx_; }
#ifndef DBG_REP
#define DBG_REP 0
#endif
        const int ptype = ph == 0 ? 8 : ph == 1 ? 9 : ((ph - 2) & 7);
        const bool cia = F.G >= 64;
        const int NC0 = cia ? 32 : 0, NC1 = cia ? 12 : 0;
        int inproj = 0, il = 0;
        const int l = ph >= 2 ? (ph - 2) >> 3 : 0, p = ph >= 2 ? (ph - 2) & 7 : -1;
        unsigned char* rA = F.ws + (l == 0 ? WS_P : WS_Q); unsigned char* rB = F.ws + (l == 0 ? WS_Q : WS_P);
        const bool wc = (l == 0);
        const int nrows = wc ? R : RL, mt = wc ? 17 : 16;
        const bool late = F.G >= 192;
        if (ph == 0) { mod_items(F); __syncthreads(); rope_table(F);
            { int* rid = (int*)(F.ws + WS_RIDENT); for (int i = F.vcu * NTHR + F.tid_(); i < NE * EROWS; i += F.G * NTHR) rid[i] = i; }
            { const int x0 = late ? LATE_X0 : CONV_NITEMS;
              const int nmod = F.G > 192 ? 96 : 0, cut = (x0 * 30) / 100;
              convert_weights(F, 0, 0, cut, F.vcu, F.G); if (F.vcu >= nmod) convert_weights(F, 0, cut, x0, F.vcu - nmod, F.G - nmod); } }
        else if (ph == 1) { if (F.vcu >= NC0) phase_h0(F, (bf16_t*)(F.ws + WS_P), NC0); else { inproj = 2; il = 0; } }
        else if (p == 0) { inproj = 1; il = l; }
        else if (p == 1) {
            phase_attn(F, l, (const bf16_t*)rB, (bf16_t*)(rA + HALFREG), wc); phase_conv(F, l, (const bf16_t*)rB, (bf16_t*)(rA + HALFREG), wc);
        } else if (p == 2) {
            pg8::Gemm g{(const bf16_t*)(rA + HALFREG), (const bf16_t*)(F.ws + wsw(l, WS_WOUT)), D, nullptr}; pg8::TileOrder S; S.init(nrows / 256, D / 256, F.G, F.bx, 0);
            pg8::EpiBf16 E{(bf16_t*)rA, D};
            pg8::gemm_phase<pg8::EpiBf16, false, false>(F.tid_(), F.lds, F.lds + RIDX_OFF, g, S, E);
            if (l == 0) { const int nu = (nrows / 256) * (D / 256), nlast = nu - (nu / F.G) * F.G; if (F.bx >= nlast) { __syncthreads(); if (late) { convert_weights(F, 0, LATE_X0, CONV_NITEMS, F.bx - nlast, F.G - nlast); convert_weights(F, 1, LATE_D0, LATE_D1, F.bx - nlast, F.G - nlast); } else convert_weights(F, 1, 0, CONV_S1, F.bx - nlast, F.G - nlast); } }
        } else if (p == 3) { if (l == 0) phase_rowpass1<true>(F, l, (const bf16_t*)rA, rA + HALFREG, nrows); else phase_rowpass1<false>(F, l, (const bf16_t*)rA, rA + HALFREG, nrows);
        } else if (p == 4) { phase_topk(F, wc);
            if (late) { const int busy = 64;
                if (F.vcu >= busy) { if (l == 0) convert_weights(F, 1, LATE_D1, CONV_NITEMS, F.vcu - busy, F.G - busy); else convert_weights(F, 1, LATE_G1, LATE_DN, F.vcu - busy, F.G - busy); } }
        } else if (p == 5) {
            pg8::Gemm g{(const bf16_t*)(rA + HALFREG), (const bf16_t*)(F.ws + wsw(l, WS_WGU)), D, (const int*)(F.ws + WS_RIDX)}; pg8::TileOrder S; S.init(NE * mt, 8, F.G, F.bx, mt);
            pg8::EpiSwiGLU E{rB};
            pg8::gemm_phase<pg8::EpiSwiGLU, true, true>(F.tid_(), F.lds, F.lds + RIDX_OFF, g, S, E);
            if (l == 0) { const int nu = NE * mt * 8, nlast = nu - (nu / F.G) * F.G; if (nlast > 0 && F.bx >= nlast) { __syncthreads(); convert_weights(F, 1, late ? 0 : CONV_S1, late ? LATE_G0 : CONV_S2, F.bx - nlast, F.G - nlast); } }
        } else if (p == 6) {
            pg8::Gemm g{(const bf16_t*)rB, (const bf16_t*)(F.ws + wsw(l, WS_WD)), FF, (const int*)(F.ws + WS_RIDENT)}; pg8::TileOrder S; S.init(NE * mt, 4, F.G, F.bx, mt);
            pg8::EpiRowScale E{rA, (const float*)(F.ws + WS_GATEW), (const LAS float*)(F.lds + pg8::ROWVEC_OFF)};
            pg8::gemm_phase<pg8::EpiRowScale, true, true>(F.tid_(), F.lds, F.lds + RIDX_OFF, g, S, E);
            if (l == 0) { const int nu = NE * mt * 4, nlast = nu - (nu / F.G) * F.G; if (nlast > 0 && F.bx >= nlast) { __syncthreads(); convert_weights(F, 1, late ? LATE_G0 : CONV_S2, late ? LATE_G1 : CONV_NITEMS, F.bx - nlast, F.G - nlast); } }
        } else {
            if (l == 0 && F.vcu < NC1) { inproj = 3; il = 1; } else { if (l == 0) phase_rowpass2<true>(F, l, rA, (bf16_t*)rB, nrows, NC1); else phase_rowpass2<false>(F, l, rA, (bf16_t*)rB, nrows, 0); }
        }
        if (inproj) {
            unsigned char* hA = F.ws + (il == 0 ? WS_P : WS_Q); unsigned char* uB = F.ws + (il == 0 ? WS_Q : WS_P);
            pg8::Gemm g{(const bf16_t*)hA, (const bf16_t*)(F.ws + wsw(il, WS_WIN)), D, nullptr}; pg8::TileOrder S;
            if (inproj == 1) S.init((cia ? RL : R) / 256, INW / 256, F.G, F.bx, 0); else { S.init_special(inproj - 1, F.vcu); cia_wait(F, inproj - 2); }
            pg8::EpiInProj E{(bf16_t*)uB, (const float*)(F.ws + WS_ROPE), (const float*)(F.ws + WS_ROPE) + 128 * 16};
            pg8::gemm_phase<pg8::EpiInProj, false, false>(F.tid_(), F.lds, F.lds + RIDX_OFF, g, S, E);
        }
        if (DBG_REP && ((DBG_REP >> ptype) & 1) && !repeated) { repeated = true; __syncthreads(); --ph; continue; }
        repeated = false;
#ifdef DBG_BAR2
        if (ph + 1 < hi) xcd_barrier(bar, F.tid_());
#endif
        if (ph + 1 < hi) xcd_barrier(bar, F.tid_());
    }
}

extern "C" void kernel_launch(void* const* d_in, const int* in_sizes, int n_in, void* d_out, int out_size, void* d_ws, size_t ws_size, hipStream_t stream) {
    static int grid = 0;
    if (grid == 0) {
        if (n_in != 22 || out_size != RL * D || ws_size < WS_END) { fprintf(stderr, "kernel_launch: unexpected shapes (n_in %d out %d ws %zu)\n", n_in, out_size, ws_size); grid = -1; return; }
        int dev = 0, cus = 0, per_cu = 0;
        if (hipGetDevice(&dev) != hipSuccess || hipDeviceGetAttribute(&cus, hipDeviceAttributeMultiprocessorCount, dev) != hipSuccess) { grid = -1; return; }
        if (hipFuncSetAttribute((const void*)hybrid_fwd, hipFuncAttributeMaxDynamicSharedMemorySize, LDS_BYTES) != hipSuccess) { fprintf(stderr, "kernel_launch: hipFuncSetAttribute failed\n"); grid = -1; return; }
        if (hipOccupancyMaxActiveBlocksPerMultiprocessor(&per_cu, (const void*)hybrid_fwd, NTHR, LDS_BYTES) != hipSuccess || per_cu < 1) { fprintf(stderr, "kernel_launch: occupancy query says %d blocks/CU\n", per_cu); grid = -1; (void)hipGetLastError(); return; }
        grid = cus;
    }
    if (grid < 0) return;
    (void)hipMemsetAsync((char*)d_ws + WS_CTL, 0, CTL_ZERO_BYTES, stream);
    Args a{};
    for (int i = 0; i < 22; ++i) a.in[i] = (const float*)d_in[i];
    a.out = (float*)d_out; a.ws = (unsigned char*)d_ws;
#if MK_PER_PHASE
    for (int p = 0; p < NPHASE; ++p) { a.ph_lo = p; a.ph_hi = p + 1; hipLaunchKernelGGL(hybrid_fwd, dim3(grid), dim3(NTHR), LDS_BYTES, stream, a); }
#else
    a.ph_lo = 0; a.ph_hi = NPHASE;
    hipLaunchKernelGGL(hybrid_fwd, dim3(grid), dim3(NTHR), LDS_BYTES, stream, a);
#endif
}
```
